# Optimizing an MI355X kernel written in HIP

```python
import math
import jax, jax.numpy as jnp
from jax import lax
import numpy as np


D_MODEL = 1024
BATCH = 16
SEQ = 2048
DEPTH = 2
DEC_BATCH = 8
DEC_SEQ = 8192
PAST_LEN = 128

GRID_W = 64
N_BRANCH = 4
BRANCH_W = 256
HEAD_DIM = 64
ATT_Q_HEADS = 4
ATT_KV_HEADS = 2
ATT_GROUP = ATT_Q_HEADS // ATT_KV_HEADS
Q_BLOCK = 128
ROPE_BASE = 10000.0
ROPE_FREQS = HEAD_DIM // 4
HY_WIDTH = BRANCH_W
HY_EMB = 33
HY_BANDS = (HY_EMB - 1) // 2
HY_FILTER_HIDDEN = 64
HY_FAST_DECAY = 0.3
HY_SLOW_DECAY = 1.5
HY_TARGET = 1e-2
RET_HEADS = 4
RET_W = RET_HEADS * HEAD_DIM
RET_CHUNK = 128
SC_WIDTH = BRANCH_W
D_FF = ((-(-8 * D_MODEL // 3)) + 255) // 256 * 256
NORM_EPS = 1e-6

ATT_Q_W = ATT_Q_HEADS * HEAD_DIM
ATT_KV_W = ATT_KV_HEADS * HEAD_DIM
A_K_OFF = ATT_Q_W
A_V_OFF = A_K_OFF + ATT_KV_W
HY_OFF = A_V_OFF + ATT_KV_W
RET_OFF = HY_OFF + 3 * HY_WIDTH
SC_OFF = RET_OFF + 4 * RET_W
GATE_OFF = SC_OFF + 3 * SC_WIDTH
IN_COLS = GATE_OFF + N_BRANCH * D_MODEL

kernel_name = 'hybrid_gated_parallel_encoder'

F32 = jnp.float32


def rms_norm(x, gain=None):
    x32 = x.astype(F32)
    y = x32 * lax.rsqrt(jnp.mean(x32 * x32, axis=-1, keepdims=True) + NORM_EPS)
    if gain is not None:
        y = y * gain.astype(F32)
    return y.astype(x.dtype)


def axial_rope_tables(L):
    rows = L // GRID_W
    r = jnp.repeat(jnp.arange(rows, dtype=F32), GRID_W)
    c = jnp.tile(jnp.arange(GRID_W, dtype=F32), rows)
    inv = ROPE_BASE ** (-jnp.arange(ROPE_FREQS, dtype=F32) / ROPE_FREQS)
    ang = jnp.stack([r[:, None] * inv, c[:, None] * inv], axis=1)
    return jnp.cos(ang), jnp.sin(ang)


def apply_rope(x, cos, sin):
    B, L, H, _ = x.shape
    xr = x.astype(F32).reshape(B, L, H, 2, 2, ROPE_FREQS)
    a = xr[..., 0, :]
    b = xr[..., 1, :]
    c = cos[None, :, None]
    s = sin[None, :, None]
    out = jnp.stack([a * c - b * s, b * c + a * s], axis=-2)
    return out.reshape(B, L, H, HEAD_DIM).astype(x.dtype)


def conv3(x, w, b=None):
    xp = jnp.pad(x, ((0, 0), (1, 1), (0, 0)))
    y = xp[:, :-2] * w[0] + xp[:, 1:-1] * w[1] + xp[:, 2:] * w[2]
    if b is not None:
        y = y + b
    return y


def block_attention(q, k, v):
    B, L = q.shape[0], q.shape[1]
    nb = L // Q_BLOCK
    qg = q.reshape(B, nb, Q_BLOCK, ATT_KV_HEADS, ATT_GROUP, HEAD_DIM).transpose(1, 0, 2, 3, 4, 5)
    scale = HEAD_DIM ** -0.5

    def one_block(qb):
        s = jnp.einsum('bqkgd,bskd->bkgqs', qb, k).astype(F32) * scale
        p = jax.nn.softmax(s, axis=-1).astype(v.dtype)
        return jnp.einsum('bkgqs,bskd->bqkgd', p, v)

    o = lax.map(one_block, qg)
    return o.transpose(1, 0, 2, 3, 4, 5).reshape(B, L, ATT_Q_W)


def hyena_filter(L, w1, b1, w2, b2, w3, freq):
    t = jnp.linspace(0.0, 1.0, L, dtype=F32)[:, None]
    f = jnp.linspace(1e-4, HY_BANDS - 1, HY_BANDS, dtype=F32)
    ang = (2.0 * math.pi / L) * jnp.arange(L, dtype=F32)[:, None] * f[None, :]
    z = jnp.concatenate([t, jnp.cos(ang), -jnp.sin(ang)], axis=-1)
    h = jnp.sin(freq[0].astype(F32) * (z @ w1.astype(F32) + b1.astype(F32)))
    h = jnp.sin(freq[1].astype(F32) * (h @ w2.astype(F32) + b2.astype(F32)))
    h = (h @ w3.astype(F32)).reshape(L, 2, HY_WIDTH)
    deltas = jnp.abs(jnp.linspace(math.log(HY_TARGET) / HY_SLOW_DECAY,
                                  math.log(HY_TARGET) / HY_FAST_DECAY, HY_WIDTH, dtype=F32))
    h = h * jnp.exp(-t * deltas)[:, None, :]
    k2 = jnp.concatenate([h[:, 0], jnp.zeros((1, HY_WIDTH), F32), h[:0:-1, 1]], axis=0)
    return k2 * lax.rsqrt(jnp.sum(k2 * k2, axis=0, keepdims=True) + NORM_EPS)


def long_conv(u, k2):
    L = u.shape[1]
    n = 2 * L
    uf = jnp.fft.rfft(u, n=n, axis=1)
    kf = jnp.fft.rfft(k2, n=n, axis=0)
    return jnp.fft.irfft(uf * kf[None], n=n, axis=1)[:, :L]


def retention_scan(q, k, v, log_g, inclusive):
    B, L, H, D = q.shape
    C = RET_CHUNK
    nc = L // C
    qc = q.reshape(B, nc, C, H, D)
    kc = k.reshape(B, nc, C, H, D)
    vc = v.reshape(B, nc, C, H, D)
    i = jnp.arange(C, dtype=F32)
    diff = i[:, None] - i[None, :]
    mask = (diff >= 0) if inclusive else (diff > 0)
    decay = jnp.where(mask[None], jnp.exp(jnp.where(mask, diff, 0.0)[None] * log_g[:, None, None]), 0.0)
    s = jnp.einsum('bnihd,bnjhd->bnhij', qc, kc) * decay[None, None]
    o_intra = jnp.einsum('bnhij,bnjhd->bnihd', s, vc)
    w_k = jnp.exp((C - 1 - i)[None, :] * log_g[:, None])
    kv = jnp.einsum('bnjhd,bnjhe,hj->nbhde', kc, vc, w_k)
    g_chunk = jnp.exp(C * log_g)[None, :, None, None]

    def step(S, kv_n):
        return g_chunk * S + kv_n, S

    _, states = lax.scan(step, jnp.zeros((B, H, D, D), F32), kv)
    w_q = jnp.exp((i + 1)[None, :] * log_g[:, None])
    o_cross = jnp.einsum('bnihd,nbhde,hi->bnihe', qc, states, w_q)
    return (o_intra + o_cross).reshape(B, L, H, D)


def layer(x, cos, sin, k2, ng, w_in, qkn, hcw, hcb, hbias, rde, scw, wb, wo, wfi, wfo):
    B, L, _ = x.shape
    dt = x.dtype
    xn = rms_norm(x, ng[0])
    p = xn @ w_in

    q = p[..., 0:ATT_Q_W].reshape(B, L, ATT_Q_HEADS, HEAD_DIM)
    k = p[..., A_K_OFF:A_V_OFF].reshape(B, L, ATT_KV_HEADS, HEAD_DIM)
    v = p[..., A_V_OFF:HY_OFF].reshape(B, L, ATT_KV_HEADS, HEAD_DIM)
    q = apply_rope(rms_norm(q, qkn[0]), cos, sin)
    k = apply_rope(rms_norm(k, qkn[1]), cos, sin)
    out_a = block_attention(q, k, v)

    u = conv3(p[..., HY_OFF:RET_OFF], hcw, hcb)
    x0 = u[..., 0:HY_WIDTH]
    x1 = u[..., HY_WIDTH:2 * HY_WIDTH]
    hv = u[..., 2 * HY_WIDTH:3 * HY_WIDTH]
    z = (hv * x1).astype(F32)
    z = long_conv(z, k2) + z * hbias.astype(F32)
    out_b = (x0.astype(F32) * z).astype(dt)

    rq = p[..., RET_OFF:RET_OFF + RET_W].reshape(B, L, RET_HEADS, HEAD_DIM)
    rk = p[..., RET_OFF + RET_W:RET_OFF + 2 * RET_W].reshape(B, L, RET_HEADS, HEAD_DIM)
    rv = p[..., RET_OFF + 2 * RET_W:RET_OFF + 3 * RET_W].reshape(B, L, RET_HEADS, HEAD_DIM)
    rg = p[..., RET_OFF + 3 * RET_W:SC_OFF]
    rq = apply_rope(rq, cos, sin).astype(F32)
    rk = apply_rope(rk, cos, sin).astype(F32) * (HEAD_DIM ** -0.5)
    rv = rv.astype(F32)
    log_g = jnp.log1p(-jnp.exp2(-rde.astype(F32)))
    fwd = retention_scan(rq, rk, rv, log_g[0], True)
    bwd = jnp.flip(retention_scan(jnp.flip(rq, 1), jnp.flip(rk, 1), jnp.flip(rv, 1), log_g[1], False), 1)
    ret = rms_norm(fwd + bwd).reshape(B, L, RET_W).astype(dt)
    out_c = ret * jax.nn.silu(rg)

    sb = p[..., SC_OFF:SC_OFF + SC_WIDTH]
    sc = p[..., SC_OFF + SC_WIDTH:SC_OFF + 2 * SC_WIDTH]
    sh = p[..., SC_OFF + 2 * SC_WIDTH:GATE_OFF]
    out_d = sb * conv3(sc * sh, scw)

    merged = None
    for n, br in enumerate((out_a, out_b, out_c, out_d)):
        gate = jax.nn.sigmoid(p[..., GATE_OFF + n * D_MODEL:GATE_OFF + (n + 1) * D_MODEL])
        term = gate * (br @ wb[n])
        merged = term if merged is None else merged + term
    h = x + rms_norm(merged @ wo, ng[1])

    gu = rms_norm(h, ng[2]) @ wfi
    f = (jax.nn.silu(gu[..., :D_FF]) * gu[..., D_FF:]) @ wfo
    return h + rms_norm(f, ng[3])


def trunk(x, norm_gains, w_in, qk_norm, hy_conv_w, hy_conv_b, hy_w1, hy_b1, hy_w2, hy_b2, hy_w3,
          hy_freq, hy_bias, ret_decay_exp, sc_conv_w, w_branch, w_out, w_ffn_in, w_ffn_out):
    L = x.shape[1]
    cos, sin = axial_rope_tables(L)
    for l in range(DEPTH):
        k2 = hyena_filter(L, hy_w1[l], hy_b1[l], hy_w2[l], hy_b2[l], hy_w3[l], hy_freq[l])
        x = layer(x, cos, sin, k2, norm_gains[l], w_in[l], qk_norm[l], hy_conv_w[l], hy_conv_b[l],
                  hy_bias[l], ret_decay_exp[l], sc_conv_w[l], w_branch[l], w_out[l], w_ffn_in[l], w_ffn_out[l])
    return x


def setup_inputs(seed: int = 0) -> dict:
    key = jax.random.key(seed)
    ks = jax.random.split(key, 22)
    nrm = lambda k, shape, s: jax.random.normal(k, shape, F32) * s
    return {
        'x_prompt': nrm(ks[0], (BATCH, SEQ, D_MODEL), 1.0),
        'x_sample': nrm(ks[1], (DEC_BATCH, DEC_SEQ, D_MODEL), 1.0),
        'norm_gains': 1.0 + nrm(ks[2], (DEPTH, 4, D_MODEL), 0.01),
        'w_in': nrm(ks[3], (DEPTH, D_MODEL, IN_COLS), D_MODEL ** -0.5),
        'qk_norm': 1.0 + nrm(ks[4], (DEPTH, 2, HEAD_DIM), 0.01),
        'hy_conv_w': nrm(ks[5], (DEPTH, 3, 3 * HY_WIDTH), 3 ** -0.5),
        'hy_conv_b': nrm(ks[6], (DEPTH, 3 * HY_WIDTH), 0.01),
        'hy_w1': nrm(ks[7], (DEPTH, HY_EMB, HY_FILTER_HIDDEN), HY_EMB ** -0.5),
        'hy_b1': nrm(ks[8], (DEPTH, HY_FILTER_HIDDEN), 0.01),
        'hy_w2': nrm(ks[9], (DEPTH, HY_FILTER_HIDDEN, HY_FILTER_HIDDEN), HY_FILTER_HIDDEN ** -0.5),
        'hy_b2': nrm(ks[10], (DEPTH, HY_FILTER_HIDDEN), 0.01),
        'hy_w3': nrm(ks[11], (DEPTH, HY_FILTER_HIDDEN, 2 * HY_WIDTH), HY_FILTER_HIDDEN ** -0.5),
        'hy_freq': 1.0 + nrm(ks[12], (DEPTH, 2, HY_FILTER_HIDDEN), 0.01),
        'hy_bias': nrm(ks[13], (DEPTH, HY_WIDTH), 0.1),
        'ret_decay_exp': 5.0 + jnp.arange(RET_HEADS, dtype=F32)[None, None, :] + nrm(ks[14], (DEPTH, 2, RET_HEADS), 0.1),
        'sc_conv_w': nrm(ks[15], (DEPTH, 3, SC_WIDTH), 3 ** -0.5),
        'w_branch': nrm(ks[16], (DEPTH, N_BRANCH, BRANCH_W, D_MODEL), BRANCH_W ** -0.5),
        'w_out': nrm(ks[17], (DEPTH, D_MODEL, D_MODEL), D_MODEL ** -0.5),
        'w_ffn_in': nrm(ks[18], (DEPTH, D_MODEL, 2 * D_FF), D_MODEL ** -0.5),
        'w_ffn_out': nrm(ks[19], (DEPTH, D_FF, D_MODEL), D_FF ** -0.5),
    }


def reference(x_prompt, x_sample, norm_gains, w_in, qk_norm, hy_conv_w, hy_conv_b, hy_w1, hy_b1, hy_w2, hy_b2,
              hy_w3, hy_freq, hy_bias, ret_decay_exp, sc_conv_w, w_branch, w_out, w_ffn_in, w_ffn_out):
    y_prompt = trunk(x_prompt, norm_gains, w_in, qk_norm, hy_conv_w, hy_conv_b, hy_w1, hy_b1, hy_w2, hy_b2,
                     hy_w3, hy_freq, hy_bias, ret_decay_exp, sc_conv_w, w_branch, w_out, w_ffn_in, w_ffn_out)
    y_sample = trunk(x_sample, norm_gains, w_in, qk_norm, hy_conv_w, hy_conv_b, hy_w1, hy_b1, hy_w2, hy_b2,
                     hy_w3, hy_freq, hy_bias, ret_decay_exp, sc_conv_w, w_branch, w_out, w_ffn_in, w_ffn_out)
    return (y_prompt, y_sample)
```

```cpp
#include <hip/hip_runtime.h>
#include <hip/hip_cooperative_groups.h>
#include <cstdio>
#include <cstdint>
namespace pg8 {
#define PG8_LAS __attribute__((address_space(3)))
typedef unsigned short bf16_t;
typedef short bf16x8 __attribute__((ext_vector_type(8)));
typedef float f32x4 __attribute__((ext_vector_type(4)));
typedef unsigned u32x4 __attribute__((ext_vector_type(4)));
__device__ __forceinline__ int opq(int x) { asm volatile("" : "+v"(x)); return x; }
__device__ __forceinline__ int lane_now() { int l; asm volatile("v_mbcnt_lo_u32_b32 %0, -1, 0\n\tv_mbcnt_hi_u32_b32 %0, -1, %0" : "=v"(l)); return l; }
constexpr int BM = 256, BK = 64, HALF = 128, HTB = HALF * BK * 2  , STAGE_BYTES = 8 * HTB, NXCD = 8, WGM = 8;

__host__ __device__ __forceinline__ int lds_byte(int r, int c) { const int st = (r >> 4) * 2 + (c >> 5), rr = r & 15, cc = c & 31, ob = rr * 64 + cc * 2; return st * 1024 + (ob ^ (((ob >> 9) & 1) << 5)); }
__host__ __device__ __forceinline__ void stage_rc(int b, int& R, int& C) { const int st = b / 1024, sb = b % 1024, swz = sb ^ (((sb >> 9) & 1) << 5); R = (st >> 1) * 16 + swz / 64; C = (st & 1) * 32 + (swz % 64) / 2; }
__host__ __device__ __forceinline__ int perm32(int rho) { const int n = rho >> 4, i = rho & 15; return 8 * (i >> 2) + 4 * n + (i & 3); }

struct Unit { int pm, pn; };
struct Gemm { const bf16_t* A; const bf16_t* Bt; int M, N, K, lda, ldb; };

struct StaticOrder {
    int nM, nN, nwg, G, c;
    __host__ __device__ void init(int M, int N, int G_, int c_) { nM = M / BM; nN = N / BM; nwg = nM * nN; G = G_; c = c_; }
    __host__ __device__ bool next(int i, Unit& u) const {
        const long L = (long)i * G + c; if (L >= nwg) return false;
        int wgid = (int)L; { const int q = nwg / NXCD, r = nwg % NXCD, xcd = wgid % NXCD, off = wgid / NXCD; wgid = (xcd < r ? xcd * (q + 1) : r * (q + 1) + (xcd - r) * q) + off; }
        const int nig = WGM * nN, gid = wgid / nig, fm = gid * WGM, gsz = (nM - fm) < WGM ? (nM - fm) : WGM;
        u.pm = fm + ((wgid % nig) % gsz); u.pn = (wgid % nig) / gsz; return true;
    }
    __device__ __forceinline__ void a_ready(const Unit&) const {}
    __device__ __forceinline__ void done(const Unit&) const {}
};

typedef float f32x2 __attribute__((ext_vector_type(2)));
typedef __bf16 bf16x2_t __attribute__((ext_vector_type(2)));
__device__ __forceinline__ unsigned cvt_pk_bf16(float lo, float hi) { f32x2 v = {lo, hi}; bf16x2_t b = __builtin_convertvector(v, bf16x2_t); return __builtin_bit_cast(unsigned, b); }
typedef float f32x16 __attribute__((ext_vector_type(16)));
__device__ __forceinline__ f32x4 ldg4(const float* p) { return *(const f32x4*)p; }
__device__ __forceinline__ u32x4 pack8(const f32x4 a, const f32x4 b) { u32x4 w; w.x = cvt_pk_bf16(a[0], a[1]); w.y = cvt_pk_bf16(a[2], a[3]); w.z = cvt_pk_bf16(b[0], b[1]); w.w = cvt_pk_bf16(b[2], b[3]); return w; }
__device__ __forceinline__ float bf2f(unsigned h) { return __uint_as_float(h << 16); }
__device__ __forceinline__ f32x4 unpack_lo(const u32x4 w) { return (f32x4){__uint_as_float(w.x << 16), __uint_as_float(w.x & 0xffff0000u), __uint_as_float(w.y << 16), __uint_as_float(w.y & 0xffff0000u)}; }
__device__ __forceinline__ f32x4 unpack_hi(const u32x4 w) { return (f32x4){__uint_as_float(w.z << 16), __uint_as_float(w.z & 0xffff0000u), __uint_as_float(w.w << 16), __uint_as_float(w.w & 0xffff0000u)}; }
__device__ __forceinline__ float sigm(float v) { return 1.0f / (1.0f + __expf(-v)); }

struct EpiIn {
    static constexpr bool PERM = true, AFTER_DRAIN = false;
    bf16_t* P; int row_base; const float* qkn; const float* rcos; const float* rsin; float qscale;
    __device__ __forceinline__ void operator()(const f32x4 (&acc)[2][2][4][2], const Unit& u, int wr, int wc, int fr_, int fq_) const {
        const int fr = opq(fr_), fq = opq(fq_);
        const int pn = u.pn;
        const bool is_k = (pn == 1 && wc < 2);
        const bool do_norm = (pn == 0) || is_k;
        const bool do_rope = do_norm || pn == 5 || pn == 6;
        const float scale = (pn == 0) ? qscale : (pn == 6 ? 0.125f : 1.0f);
        const bool do_silu = (pn == 8);
        const float* gp = qkn + (is_k ? 64 : 0) + 4 * fq;
#pragma unroll
        for (int ai = 0; ai < 2; ++ai)
#pragma unroll
            for (int m = 0; m < 4; ++m) {
                const int row = row_base + u.pm * BM + ai * HALF + wr * 64 + m * 16 + fr;
                f32x4 v[2][2];
#pragma unroll
                for (int bj = 0; bj < 2; ++bj)
#pragma unroll
                    for (int n = 0; n < 2; ++n) v[bj][n] = acc[ai][bj][m][n];
                if (do_norm) {
                    float ss = 0.f;
#pragma unroll
                    for (int bj = 0; bj < 2; ++bj)
#pragma unroll
                        for (int n = 0; n < 2; ++n) ss += (v[bj][n][0] * v[bj][n][0] + v[bj][n][1] * v[bj][n][1]) + (v[bj][n][2] * v[bj][n][2] + v[bj][n][3] * v[bj][n][3]);
                    ss += __shfl_xor(ss, 16); ss += __shfl_xor(ss, 32);
                    const float rn = 1.0f / sqrtf(ss * (1.0f / 64.0f) + 1e-6f);
#pragma unroll
                    for (int bj = 0; bj < 2; ++bj)
#pragma unroll
                        for (int n = 0; n < 2; ++n) v[bj][n] = v[bj][n] * rn * ldg4(gp + 32 * bj + 16 * n);
                }
                if (do_rope) {
                    const int L = row < 32768 ? 2048 : 8192; const int t = row & (L - 1);
#pragma unroll
                    for (int bj = 0; bj < 2; ++bj) {
                        const int pos = bj == 0 ? (t >> 6) : (t & 63);
                        const f32x4 c = ldg4(rcos + pos * 16 + 4 * fq), s = ldg4(rsin + pos * 16 + 4 * fq);
                        const f32x4 a = v[bj][0], b = v[bj][1];
                        v[bj][0] = a * c - b * s; v[bj][1] = b * c + a * s;
                    }
                }
#pragma unroll
                for (int bj = 0; bj < 2; ++bj) {
                    f32x4 x0 = v[bj][0] * scale, x1 = v[bj][1] * scale;
                    if (do_silu) {
#pragma unroll
                        for (int i = 0; i < 4; ++i) { x0[i] = x0[i] * sigm(x0[i]); x1[i] = x1[i] * sigm(x1[i]); }
                    }
                    *(u32x4*)(P + ((unsigned)row * 3072u + (unsigned)(pn * 256 + 64 * wc + 32 * bj + 8 * fq))) = pack8(x0, x1);
                }
                asm volatile("" ::: "memory");
            }
    }
};
struct EpiGate {
    static constexpr bool PERM = true, AFTER_DRAIN = false;
    bf16_t* O; int ldc;
    __device__ __forceinline__ void operator()(const f32x4 (&acc)[2][2][4][2], const Unit& u, int wr, int wc, int fr_, int fq_) const {
        const int fr = opq(fr_), fq = opq(fq_);
#pragma unroll
        for (int ai = 0; ai < 2; ++ai)
#pragma unroll
            for (int m = 0; m < 4; ++m) {
                const int row = u.pm * BM + ai * HALF + wr * 64 + m * 16 + fr;
#pragma unroll
                for (int bj = 0; bj < 2; ++bj) {
                    f32x4 x0 = acc[ai][bj][m][0], x1 = acc[ai][bj][m][1];
#pragma unroll
                    for (int i = 0; i < 4; ++i) { x0[i] = sigm(x0[i]); x1[i] = sigm(x1[i]); }
                    *(u32x4*)(O + ((unsigned)row * (unsigned)ldc + (unsigned)(u.pn * BM + bj * HALF + wc * 32 + 8 * fq))) = pack8(x0, x1);
                }
            }
    }
};
struct EpiBranch {
    static constexpr bool PERM = true, AFTER_DRAIN = false;
    const bf16_t* G; float* MF; bf16_t* MB; int nbr;
    __device__ __forceinline__ void operator()(const f32x4 (&acc)[2][2][4][2], const Unit& u, int wr, int wc, int fr_, int fq_) const {
        const int fr = opq(fr_), fq = opq(fq_);
#pragma unroll
        for (int ai = 0; ai < 2; ++ai)
#pragma unroll
            for (int m = 0; m < 4; ++m) {
                const int row = u.pm * BM + ai * HALF + wr * 64 + m * 16 + fr;
#pragma unroll
                for (int bj = 0; bj < 2; ++bj) {
                    const int col = u.pn * BM + bj * HALF + wc * 32 + 8 * fq;
                    const u32x4 gw = *(const u32x4*)(G + ((unsigned)row * 4096u + (unsigned)(nbr * 1024 + col)));
                    f32x4 x0 = acc[ai][bj][m][0] * unpack_lo(gw), x1 = acc[ai][bj][m][1] * unpack_hi(gw);
                    float* mp = MF + ((unsigned)row * 1024u + (unsigned)col);
                    if (nbr != 0) { x0 = x0 + ldg4(mp); x1 = x1 + ldg4(mp + 4); }
                    if (nbr == 3) *(u32x4*)(MB + ((unsigned)row * 1024u + (unsigned)col)) = pack8(x0, x1);
                    else { *(f32x4*)mp = x0; *(f32x4*)(mp + 4) = x1; }
                    asm volatile("" ::: "memory");
                }
            }
    }
};
struct EpiF32 {
    static constexpr bool PERM = true, AFTER_DRAIN = false;
    float* O; int ldc;
    __device__ __forceinline__ void operator()(const f32x4 (&acc)[2][2][4][2], const Unit& u, int wr, int wc, int fr_, int fq_) const {
        const int fr = opq(fr_), fq = opq(fq_);
#pragma unroll
        for (int ai = 0; ai < 2; ++ai)
#pragma unroll
            for (int m = 0; m < 4; ++m) {
                const int row = u.pm * BM + ai * HALF + wr * 64 + m * 16 + fr;
#pragma unroll
                for (int bj = 0; bj < 2; ++bj) {
                    float* op = O + ((unsigned)row * (unsigned)ldc + (unsigned)(u.pn * BM + bj * HALF + wc * 32 + 8 * fq));
                    *(f32x4*)op = acc[ai][bj][m][0]; *(f32x4*)(op + 4) = acc[ai][bj][m][1];
                }
            }
    }
};
struct EpiSwiglu {
    static constexpr bool PERM = true, AFTER_DRAIN = false;
    bf16_t* O;
    __device__ __forceinline__ void operator()(const f32x4 (&acc)[2][2][4][2], const Unit& u, int wr, int wc, int fr_, int fq_) const {
        const int fr = opq(fr_), fq = opq(fq_);
#pragma unroll
        for (int ai = 0; ai < 2; ++ai)
#pragma unroll
            for (int m = 0; m < 4; ++m) {
                const int row = u.pm * BM + ai * HALF + wr * 64 + m * 16 + fr;
                f32x4 x0 = acc[ai][0][m][0], x1 = acc[ai][0][m][1];
                const f32x4 u0 = acc[ai][1][m][0], u1 = acc[ai][1][m][1];
#pragma unroll
                for (int i = 0; i < 4; ++i) { x0[i] = x0[i] * sigm(x0[i]) * u0[i]; x1[i] = x1[i] * sigm(x1[i]) * u1[i]; }
                *(u32x4*)(O + ((unsigned)row * 2816u + (unsigned)(u.pn * HALF + wc * 32 + 8 * fq))) = pack8(x0, x1);
            }
    }
};
template <class Epi, class Sched, bool ALIGN_EPI = false, bool SP2 = false>
__device__ __forceinline__ void gemm_phase(PG8_LAS unsigned char* lds, const Gemm g, const Sched& S, const Epi& E, const int wave0) {
    const int tid = wave0 * 64 + lane_now(), wid = wave0, lane = tid & 63, wr = wid >> 2, wc = wid & 3, fr = lane & 15, fq = lane >> 4;
    const int K = g.K, nt = K / BK, lda = g.lda, ldb = g.ldb;
    unsigned voffA[2], voffB[2];
#pragma unroll
    for (int i = 0; i < 2; ++i) { int R, C; stage_rc(tid * 16 + i * 8192, R, C); const int Rb = Epi::PERM ? ((R & ~31) + perm32(R & 31)) : R;
        voffA[i] = (unsigned)(R * lda + C) * 2u; voffB[i] = (unsigned)(Rb * ldb + C) * 2u; }
    const size_t kstep = (size_t)(BK * 2);
    const size_t hstepA = (size_t)HALF * lda * 2, hstepB = (size_t)HALF * ldb * 2;
    const size_t tstepA = 2 * hstepA, tstepB = 2 * hstepB;
    const unsigned ldsw = (unsigned)wid * 1024u;
    const int aoff = lds_byte(wr * 64 + fr, fq * 8), boff = lds_byte(wc * 32 + fr, fq * 8);
#define PG8_SA(b, h) (((b) * 2 + (h)) * HTB)
#define PG8_SB(b, h) ((4 + (b) * 2 + (h)) * HTB)
#define PG8_STAGE(bufoff, gbase, voff) do { _Pragma("unroll") for (int _i = 0; _i < 2; ++_i) \
        __builtin_amdgcn_global_load_lds((const unsigned*)((const char*)(gbase) + (voff)[_i]), (PG8_LAS unsigned*)(lds + (bufoff) + ldsw + _i * 8192), 16, 0, 0); } while (0)
#define PG8_LDA(dst, b, h) do { _Pragma("unroll") for (int m = 0; m < 4; ++m) _Pragma("unroll") for (int k = 0; k < 2; ++k) dst[m][k] = *(const PG8_LAS bf16x8*)(lds + PG8_SA(b, h) + aoff + m * 2048 + k * 1024); } while (0)
#define PG8_LDB(dst, b, h) do { _Pragma("unroll") for (int n = 0; n < 2; ++n) _Pragma("unroll") for (int k = 0; k < 2; ++k) dst[n][k] = *(const PG8_LAS bf16x8*)(lds + PG8_SB(b, h) + boff + n * 2048 + k * 1024); } while (0)
#define PG8_MMA(ai, bj, At, Bt) do { __builtin_amdgcn_s_setprio(1); _Pragma("unroll") for (int m = 0; m < 4; ++m) _Pragma("unroll") for (int n = 0; n < 2; ++n) _Pragma("unroll") for (int k = 0; k < 2; ++k) \
        acc[ai][bj][m][n] = __builtin_amdgcn_mfma_f32_16x16x32_bf16(Bt[n][k], At[m][k], acc[ai][bj][m][n], 0, 0, 0); __builtin_amdgcn_s_setprio(0); } while (0)
#define PG8_WAIT_V(n) asm volatile("s_waitcnt vmcnt(" #n ")" ::: "memory")
#define PG8_WAIT_L(n) asm volatile("s_waitcnt lgkmcnt(" #n ")" ::: "memory")
#define PG8_BAR __builtin_amdgcn_s_barrier()
#define PG8_SCHED __builtin_amdgcn_sched_barrier(0)
    Unit cur, nxt; int ui = 0;
    if (!S.next(0, cur)) return;
    f32x4 acc[2][2][4][2];
#pragma unroll
    for (int a = 0; a < 2; ++a)
#pragma unroll
        for (int b = 0; b < 2; ++b)
#pragma unroll
            for (int m = 0; m < 4; ++m)
#pragma unroll
                for (int n = 0; n < 2; ++n) acc[a][b][m][n] = (f32x4){0.f, 0.f, 0.f, 0.f};
    bf16x8 At[4][2], B0[2][2], B1[2][2];
    const char* cA = (const char*)g.A + (size_t)cur.pm * tstepA; const char* cB = (const char*)g.Bt + (size_t)cur.pn * tstepB;
    S.a_ready(cur);
    if constexpr (SP2) {
        PG8_STAGE(PG8_SB(0, 0), cB, voffB); PG8_STAGE(PG8_SB(0, 1), cB + hstepB, voffB); PG8_STAGE(PG8_SA(0, 0), cA, voffA); PG8_STAGE(PG8_SA(0, 1), cA + hstepA, voffA);
        if (wr == 1) PG8_BAR;
        PG8_WAIT_V(2); PG8_BAR;
        PG8_STAGE(PG8_SB(1, 0), cB + kstep, voffB); PG8_STAGE(PG8_SA(1, 0), cA + kstep, voffA); PG8_STAGE(PG8_SB(1, 1), cB + hstepB + kstep, voffB);
        PG8_WAIT_V(6); PG8_BAR;
    } else {
        PG8_STAGE(PG8_SB(0, 0), cB, voffB); PG8_STAGE(PG8_SA(0, 0), cA, voffA); PG8_STAGE(PG8_SB(0, 1), cB + hstepB, voffB); PG8_STAGE(PG8_SA(0, 1), cA + hstepA, voffA);
        if (wr == 1) PG8_BAR;
        PG8_WAIT_V(4); PG8_BAR;
        PG8_STAGE(PG8_SB(1, 0), cB + kstep, voffB); PG8_STAGE(PG8_SA(1, 0), cA + kstep, voffA); PG8_STAGE(PG8_SB(1, 1), cB + hstepB + kstep, voffB);
        PG8_WAIT_V(6); PG8_BAR;
    }
    for (;;) {
        const bool has_next = S.next(ui + 1, nxt);
        const char* nA = has_next ? (const char*)g.A + (size_t)nxt.pm * tstepA : cA; const char* nB = has_next ? (const char*)g.Bt + (size_t)nxt.pn * tstepB : cB;
        for (int t = 0; t < nt; t += 2) {
            const bool last = (t == nt - 2);
            const char* a1 = cA + (size_t)(t + 1) * kstep;
            const char* a2 = last ? nA : cA + (size_t)(t + 2) * kstep; const char* b2 = last ? nB : cB + (size_t)(t + 2) * kstep;
            const char* a3 = a2 + kstep; const char* b3 = b2 + kstep;
            if (last && has_next) S.a_ready(nxt);
            if constexpr (SP2) {
            PG8_LDB(B0, 0, 0); PG8_LDB(B1, 0, 1); PG8_SCHED; PG8_LDA(At, 0, 0); PG8_STAGE(PG8_SA(1, 1), a1 + hstepA, voffA);
            PG8_WAIT_V(8); PG8_WAIT_L(0); PG8_BAR; PG8_MMA(0, 0, At, B0); PG8_MMA(0, 1, At, B1); PG8_BAR; PG8_SCHED;
            PG8_LDA(At, 0, 1); PG8_STAGE(PG8_SB(0, 0), b2, voffB); PG8_STAGE(PG8_SB(0, 1), b2 + hstepB, voffB); PG8_STAGE(PG8_SA(0, 0), a2, voffA);
            PG8_WAIT_V(8); PG8_WAIT_L(0); PG8_BAR; PG8_MMA(1, 0, At, B0); PG8_MMA(1, 1, At, B1); PG8_BAR; PG8_SCHED;
            PG8_LDB(B0, 1, 0); PG8_LDB(B1, 1, 1); PG8_SCHED; PG8_LDA(At, 1, 0); PG8_STAGE(PG8_SA(0, 1), a2 + hstepA, voffA);
            PG8_WAIT_V(8); PG8_WAIT_L(0); PG8_BAR; PG8_MMA(0, 0, At, B0); PG8_MMA(0, 1, At, B1); PG8_BAR; PG8_SCHED;
            PG8_LDA(At, 1, 1); PG8_STAGE(PG8_SB(1, 0), b3, voffB); PG8_STAGE(PG8_SB(1, 1), b3 + hstepB, voffB); PG8_STAGE(PG8_SA(1, 0), a3, voffA);
            PG8_WAIT_V(8); PG8_WAIT_L(0); PG8_BAR; PG8_MMA(1, 0, At, B0); PG8_MMA(1, 1, At, B1); PG8_BAR; PG8_SCHED;
            } else {
            PG8_LDB(B0, 0, 0); PG8_SCHED; PG8_LDA(At, 0, 0); PG8_STAGE(PG8_SA(1, 1), a1 + hstepA, voffA);
            PG8_WAIT_L(8); PG8_BAR; PG8_WAIT_L(0); PG8_MMA(0, 0, At, B0); PG8_BAR; PG8_SCHED;
            PG8_LDB(B1, 0, 1); PG8_STAGE(PG8_SB(0, 0), b2, voffB);
            PG8_BAR; PG8_WAIT_L(0); PG8_MMA(0, 1, At, B1); PG8_BAR;
            PG8_LDA(At, 0, 1); PG8_STAGE(PG8_SA(0, 0), a2, voffA);
            PG8_BAR; PG8_WAIT_L(0); PG8_MMA(1, 0, At, B0); PG8_BAR; PG8_SCHED;
            PG8_STAGE(PG8_SB(0, 1), b2 + hstepB, voffB);
            PG8_WAIT_V(6); PG8_BAR; PG8_MMA(1, 1, At, B1); PG8_BAR;
            PG8_LDB(B0, 1, 0); PG8_SCHED; PG8_LDA(At, 1, 0); PG8_STAGE(PG8_SA(0, 1), a2 + hstepA, voffA);
            PG8_WAIT_L(8); PG8_BAR; PG8_WAIT_L(0); PG8_MMA(0, 0, At, B0); PG8_BAR; PG8_SCHED;
            PG8_LDB(B1, 1, 1); PG8_STAGE(PG8_SB(1, 0), b3, voffB);
            PG8_BAR; PG8_WAIT_L(0); PG8_MMA(0, 1, At, B1); PG8_BAR;
            PG8_LDA(At, 1, 1); PG8_STAGE(PG8_SA(1, 0), a3, voffA);
            PG8_BAR; PG8_WAIT_L(0); PG8_MMA(1, 0, At, B0); PG8_BAR; PG8_SCHED;
            PG8_STAGE(PG8_SB(1, 1), b3 + hstepB, voffB);
            PG8_WAIT_V(6); PG8_BAR; PG8_MMA(1, 1, At, B1); PG8_BAR;
            }
        }
        if constexpr (ALIGN_EPI) { if (wr == 0) PG8_BAR; }
        if constexpr (!Epi::AFTER_DRAIN) { E(acc, cur, wr, wc, fr, fq); S.done(cur); }
        if (!has_next) break;
#pragma unroll
        for (int a = 0; a < 2; ++a)
#pragma unroll
            for (int b = 0; b < 2; ++b)
#pragma unroll
                for (int m = 0; m < 4; ++m)
#pragma unroll
                    for (int n = 0; n < 2; ++n) acc[a][b][m][n] = (f32x4){0.f, 0.f, 0.f, 0.f};
        cur = nxt; cA = nA; cB = nB; ++ui;
        if constexpr (ALIGN_EPI) { if (wr == 1) PG8_BAR; }
    }
    PG8_WAIT_V(0);
    if constexpr (!ALIGN_EPI) { if (wr == 0) PG8_BAR; }
    PG8_BAR;
    if constexpr (Epi::AFTER_DRAIN) { E.fused(acc, cur, wr, wc, fr, fq, lds, wid, lane); S.done(cur); }
#undef PG8_SA
#undef PG8_SB
#undef PG8_STAGE
#undef PG8_LDA
#undef PG8_LDB
#undef PG8_MMA
#undef PG8_WAIT_V
#undef PG8_WAIT_L
#undef PG8_BAR
#undef PG8_SCHED
}
}

namespace cg = cooperative_groups;
using pg8::bf16_t; using pg8::bf16x8; using pg8::f32x4; using pg8::u32x4; using pg8::f32x16;
typedef unsigned u32x2 __attribute__((ext_vector_type(2)));
#define LAS __attribute__((address_space(3)))
constexpr int NTHR = 512, NWAVES = 8;
constexpr int DM = 1024, T_ALL = 98304, T_PROMPT = 32768, GROUP = 16384, NGROUP = 6;
constexpr int PW = 3072;
constexpr int DFF = 2816;
constexpr float EPS = 1e-6f;
constexpr float QSCALE = 0.125f * 1.4426950408889634f;
constexpr size_t MiB = 1u << 20;
constexpr size_t WS_WIN = 0 * MiB, WS_WG = 6 * MiB, WS_WB = 14 * MiB, WS_WO = 16 * MiB, WS_WFI = 18 * MiB, WS_WFO = 29 * MiB, WS_MISC = 35 * MiB;
constexpr size_t WS_XN = 40 * MiB, WS_P = 72 * MiB, WS_S = 648 * MiB;
constexpr size_t S_HRAW = 0, S_HW8 = 20 * MiB, S_HW2 = 84 * MiB, S_KV = 100 * MiB;
constexpr size_t S_GATE = 0, S_ACT = 0, S_MF = 128 * MiB, S_MB = 192 * MiB;
constexpr size_t WS_NEED = 648 * MiB + 224 * MiB;
constexpr int LDS_BYTES = 147456;
#ifndef ENABLE
#define ENABLE 0xffff
#endif
constexpr int EN = ENABLE;

#define GSYNC() do { asm volatile("s_waitcnt vmcnt(0) lgkmcnt(0)" ::: "memory"); grid.sync(); __builtin_amdgcn_fence(__ATOMIC_ACQUIRE, "agent"); asm volatile("s_waitcnt vmcnt(0)" ::: "memory"); } while (0)
struct Args { const float* in[20]; float* out; unsigned char* ws; };

__device__ __forceinline__ float wave_sum(float v) {
#pragma unroll
    for (int o = 1; o < 64; o <<= 1) v += __shfl_xor(v, o);
    return v;
}
__device__ __forceinline__ unsigned cvtpk(float lo, float hi) { return pg8::cvt_pk_bf16(lo, hi); }
__device__ __forceinline__ float bf2f(unsigned h) { return __uint_as_float(h << 16); }
__device__ __forceinline__ unsigned f2bf1(float f) { return cvtpk(f, 0.f) & 0xffffu; }
__device__ __forceinline__ int pi_slot(int s) { return (s & ~31) | (((s >> 2) & 1) << 4) | (((s >> 3) & 3) << 2) | (s & 3); }
__device__ __forceinline__ f32x16 mfma32(bf16x8 a, bf16x8 b, f32x16 c) { return __builtin_amdgcn_mfma_f32_32x32x16_bf16(a, b, c, 0, 0, 0); }
__device__ __forceinline__ int crow(int r, int hi) { return (r & 3) + 8 * (r >> 2) + 4 * hi; }
__device__ __forceinline__ bf16x8 mk8(u32x2 lo, u32x2 hi) { u32x4 w; w.x = lo.x; w.y = lo.y; w.z = hi.x; w.w = hi.y; return __builtin_bit_cast(bf16x8, w); }
__device__ __forceinline__ bf16x8 pack8r(const f32x16& p, int b) { u32x4 w; w.x = cvtpk(p[b], p[b + 1]); w.y = cvtpk(p[b + 2], p[b + 3]); w.z = cvtpk(p[b + 4], p[b + 5]); w.w = cvtpk(p[b + 6], p[b + 7]); return __builtin_bit_cast(bf16x8, w); }
__device__ __forceinline__ unsigned short u16at(const u32x4& w, int e) { return (unsigned short)((w[e >> 1] >> (16 * (e & 1))) & 0xffffu); }

template <int MAP, bool KPERM>
__device__ __forceinline__ void transpose_item(const float* W, int ld, int K, int nblk, bf16_t* WT, float* scr, int item, int lane) {
    const int kb = item / nblk, nb = item % nblk, k0 = 64 * kb, n0 = 32 * nb;
#pragma unroll 8
    for (int i = 0; i < 32; ++i) { const int kk = 2 * i + (lane >> 5); scr[kk * 33 + (lane & 31)] = W[(size_t)(k0 + kk) * ld + n0 + (lane & 31)]; }
    asm volatile("s_waitcnt lgkmcnt(0)" ::: "memory");
    const int c = lane & 7;
#pragma unroll
    for (int j = 0; j < 4; ++j) {
        const int n = (lane >> 3) + 8 * j; const int ns = n0 + n; int dr;
        if (MAP == 0) dr = ns;
        else if (MAP == 1) { const int lc = ns & 255; dr = (ns & ~255) + 128 * ((lc >> 5) & 1) + 32 * ((lc >> 6) & 3) + 8 * ((lc >> 2) & 3) + 4 * ((lc >> 4) & 1) + (lc & 3); }
        else { const int up = ns >= DFF ? 1 : 0; const int jj = ns - DFF * up; dr = (jj >> 7) * 256 + 128 * up + (jj & 127); }
        float s[8];
#pragma unroll
        for (int e = 0; e < 8; ++e) { const int kl = KPERM ? pi_slot(8 * c + e) : (8 * c + e); s[e] = scr[kl * 33 + n]; }
        u32x4 o; o.x = cvtpk(s[0], s[1]); o.y = cvtpk(s[2], s[3]); o.z = cvtpk(s[4], s[5]); o.w = cvtpk(s[6], s[7]);
        *(u32x4*)(WT + (size_t)dr * K + k0 + 8 * c) = o;
    }
    asm volatile("s_waitcnt lgkmcnt(0)" ::: "memory");
}

__device__ __forceinline__ void prep_weights(const Args& a, int layer, unsigned char* lds, const int wave0) {
    const int tid = (wave0 * 64 + pg8::lane_now()), lane = tid & 63, wave = wave0; const int gw = blockIdx.x * NWAVES + wave, NGW = gridDim.x * NWAVES;
    unsigned char* ws = a.ws;
    float* scr = (float*)(lds + wave * 16384);
    const float* w_in = a.in[3] + (size_t)layer * 1024 * 7168;
    const float* wbr = a.in[16] + (size_t)layer * 4 * 256 * 1024;
    const float* wo = a.in[17] + (size_t)layer * 1024 * 1024;
    const float* wfi = a.in[18] + (size_t)layer * 1024 * 5632;
    const float* wfo = a.in[19] + (size_t)layer * 2816 * 1024;
    constexpr int I_IN = 16 * 96, I_G = 16 * 128, I_B = 4 * 32, I_O = 16 * 32, I_FI = 16 * 176, I_FO = 44 * 32;
    constexpr int NIT = I_IN + I_G + 4 * I_B + I_O + I_FI + I_FO;
    for (int it = gw; it < NIT; it += NGW) {
        int r = it;
        if (r < I_IN) { transpose_item<1, false>(w_in, 7168, 1024, 96, (bf16_t*)(ws + WS_WIN), scr, r, lane); continue; } r -= I_IN;
        if (r < I_G) { transpose_item<0, false>(w_in + 3072, 7168, 1024, 128, (bf16_t*)(ws + WS_WG), scr, r, lane); continue; } r -= I_G;
        if (r < 4 * I_B) { const int n = r / I_B; transpose_item<0, true>(wbr + (size_t)n * 256 * 1024, 1024, 256, 32, (bf16_t*)(ws + WS_WB) + (size_t)n * 1024 * 256, scr, r % I_B, lane); continue; } r -= 4 * I_B;
        if (r < I_O) { transpose_item<0, false>(wo, 1024, 1024, 32, (bf16_t*)(ws + WS_WO), scr, r, lane); continue; } r -= I_O;
        if (r < I_FI) { transpose_item<2, false>(wfi, 5632, 1024, 176, (bf16_t*)(ws + WS_WFI), scr, r, lane); continue; } r -= I_FI;
        transpose_item<0, false>(wfo, 1024, 2816, 32, (bf16_t*)(ws + WS_WFO), scr, r, lane);
    }
}

__device__ __forceinline__ const float* xrow_ptr(const Args& a, int layer, int R) {
    if (layer == 0) return R < T_PROMPT ? a.in[0] + (size_t)R * DM : a.in[1] + (size_t)(R - T_PROMPT) * DM;
    return a.out + (size_t)R * DM;
}
__device__ __forceinline__ void norm_x_rows(const Args& a, int layer, int g, const float* gain, bf16_t* XN, const int wave0) {
    const int tid = (wave0 * 64 + pg8::lane_now()), lane = tid & 63, wave = wave0; const int gw = blockIdx.x * NWAVES + wave, NGW = gridDim.x * NWAVES;
    for (int row = gw; row < GROUP; row += NGW) {
        const float* xr = xrow_ptr(a, layer, g * GROUP + row);
        f32x4 v[4]; float ss = 0.f;
#pragma unroll
        for (int j = 0; j < 4; ++j) { v[j] = *(const f32x4*)(xr + 4 * lane + 256 * j); ss += (v[j][0] * v[j][0] + v[j][1] * v[j][1]) + (v[j][2] * v[j][2] + v[j][3] * v[j][3]); }
        const float rn = 1.0f / sqrtf(wave_sum(ss) * (1.0f / DM) + EPS);
#pragma unroll
        for (int j = 0; j < 4; ++j) { const f32x4 gv = *(const f32x4*)(gain + 4 * lane + 256 * j); const f32x4 o = v[j] * rn * gv;
            u32x2 w; w.x = cvtpk(o[0], o[1]); w.y = cvtpk(o[2], o[3]); *(u32x2*)(XN + (size_t)row * DM + 4 * lane + 256 * j) = w; }
    }
}
__device__ __forceinline__ void norm_res_rows(const Args& a, const float* TMP, int g, bool base_is_x0, const float* gain, const float* gain2, bf16_t* HN, const int wave0) {
    const int tid = (wave0 * 64 + pg8::lane_now()), lane = tid & 63, wave = wave0; const int gw = blockIdx.x * NWAVES + wave, NGW = gridDim.x * NWAVES;
    for (int row = gw; row < GROUP; row += NGW) {
        const int R = g * GROUP + row;
        const float* br = base_is_x0 ? xrow_ptr(a, 0, R) : a.out + (size_t)R * DM;
        const float* tr = TMP + (size_t)row * DM;
        f32x4 v[4], b[4]; float ss = 0.f;
#pragma unroll
        for (int j = 0; j < 4; ++j) { v[j] = *(const f32x4*)(tr + 4 * lane + 256 * j); b[j] = *(const f32x4*)(br + 4 * lane + 256 * j); ss += (v[j][0] * v[j][0] + v[j][1] * v[j][1]) + (v[j][2] * v[j][2] + v[j][3] * v[j][3]); }
        const float rn = 1.0f / sqrtf(wave_sum(ss) * (1.0f / DM) + EPS);
        float s2 = 0.f;
#pragma unroll
        for (int j = 0; j < 4; ++j) { const f32x4 gv = *(const f32x4*)(gain + 4 * lane + 256 * j); v[j] = b[j] + v[j] * rn * gv;
            *(f32x4*)(a.out + (size_t)R * DM + 4 * lane + 256 * j) = v[j]; s2 += (v[j][0] * v[j][0] + v[j][1] * v[j][1]) + (v[j][2] * v[j][2] + v[j][3] * v[j][3]); }
        if (HN) {
            const float r2 = 1.0f / sqrtf(wave_sum(s2) * (1.0f / DM) + EPS);
#pragma unroll
            for (int j = 0; j < 4; ++j) { const f32x4 gv = *(const f32x4*)(gain2 + 4 * lane + 256 * j); const f32x4 o = v[j] * r2 * gv;
                u32x2 w; w.x = cvtpk(o[0], o[1]); w.y = cvtpk(o[2], o[3]); *(u32x2*)(HN + (size_t)row * DM + 4 * lane + 256 * j) = w; }
        }
    }
}

__device__ __forceinline__ void rope_table(float* rcos, float* rsin, const int wave0) {
    for (int i = (wave0 * 64 + pg8::lane_now()); i < 128 * 16; i += NTHR) {
        const int pos = i >> 4, f = i & 15;
        const float inv = powf(10000.0f, -(float)f / 16.0f);
        const float ang = (float)pos * inv;
        rcos[i] = cosf(ang); rsin[i] = sinf(ang);
    }
}

__device__ __forceinline__ void hy_filter_item(const Args& a, int layer, int item, unsigned char* lds, const int wave0) {
    const int tid = (wave0 * 64 + pg8::lane_now());
    const bool big = item < 128; const int L = big ? 8192 : 2048; const int t0 = (big ? item : item - 128) * 64;
    float* hraw = (float*)(a.ws + WS_S + S_HRAW) + (big ? 0 : (size_t)2 * 256 * 8192);
    const float* w1 = a.in[7] + layer * 33 * 64; const float* b1 = a.in[8] + layer * 64; const float* w2 = a.in[9] + layer * 64 * 64; const float* b2 = a.in[10] + layer * 64;
    const float* w3 = a.in[11] + (size_t)layer * 64 * 512; const float* fr = a.in[12] + layer * 128;
    float* zf = (float*)lds; float* h1 = zf + 64 * 33; float* h2 = h1 + 64 * 65;
    const int p = tid & 63, kg = tid >> 6; const int t = t0 + p;
    const float tl = (float)t / (float)(L - 1);
    for (int f = kg; f < 33; f += 8) {
        float v;
        if (f == 0) v = tl;
        else { const int k = (f - 1) & 15; const float fk = 1e-4f + (float)k * ((15.0f - 1e-4f) / 15.0f); const float ang = (6.283185307179586f / (float)L) * (float)t * fk; v = f <= 16 ? cosf(ang) : -sinf(ang); }
        zf[p * 33 + f] = v;
    }
    __syncthreads();
    for (int u = kg; u < 64; u += 8) { float s = b1[u];
        for (int f = 0; f < 33; ++f) s += zf[p * 33 + f] * w1[f * 64 + u];
        h1[p * 65 + u] = sinf(fr[u] * s); }
    __syncthreads();
    for (int u = kg; u < 64; u += 8) { float s = b2[u];
        for (int k = 0; k < 64; ++k) s += h1[p * 65 + k] * w2[k * 64 + u];
        h2[p * 65 + u] = sinf(fr[64 + u] * s); }
    __syncthreads();
    const float dlo = -4.605170185988091f / 1.5f, dhi = -4.605170185988091f / 0.3f;
    for (int col = kg; col < 512; col += 8) { float s = 0.f;
        for (int k = 0; k < 64; ++k) s += h2[p * 65 + k] * w3[k * 512 + col];
        const int dir = col >> 8, c = col & 255; const float delta = fabsf(dlo + (float)c * ((dhi - dlo) / 255.0f));
        hraw[((size_t)dir * 256 + c) * L + t] = s * expf(-tl * delta); }
    __syncthreads();
}
__device__ __forceinline__ void hy_window_item(const Args& a, int item, unsigned char* lds, const int wave0) {
    const int tid = (wave0 * 64 + pg8::lane_now()), lane = tid & 63, wave = wave0;
    const bool big = item < 256; const int L = big ? 8192 : 2048; const int c = big ? item : item - 256;
    const float* hraw = (const float*)(a.ws + WS_S + S_HRAW) + (big ? 0 : (size_t)2 * 256 * 8192);
    const float* hf = hraw + (size_t)c * L; const float* hb = hraw + ((size_t)256 + c) * L;
    bf16_t* W = (bf16_t*)(a.ws + WS_S + (big ? S_HW8 : S_HW2)) + (size_t)c * (2 * L * 8);
    float* red = (float*)lds;
    float ss = 0.f;
    for (int t = tid; t < L; t += NTHR) { const float x = hf[t]; ss += x * x; if (t > 0) { const float y = hb[t]; ss += y * y; } }
    ss = wave_sum(ss);
    if (lane == 0) red[wave] = ss;
    __syncthreads();
    float tot = 0.f;
#pragma unroll
    for (int w = 0; w < NWAVES; ++w) tot += red[w];
    const float nrm = 1.0f / sqrtf(tot + EPS);
    for (int idx = tid; idx < 2 * L; idx += NTHR) {
        const int o = idx - L; float s[8];
#pragma unroll
        for (int e = 0; e < 8; ++e) { const int l = o - e; float v = 0.f; if (l >= 0) { if (l < L) v = hf[l]; } else { if (-l < L) v = hb[-l]; } s[e] = v * nrm; }
        u32x4 w; w.x = cvtpk(s[0], s[1]); w.y = cvtpk(s[2], s[3]); w.z = cvtpk(s[4], s[5]); w.w = cvtpk(s[6], s[7]);
        *(u32x4*)(W + (size_t)idx * 8) = w;
    }
    __syncthreads();
}

template <int NQ>
__device__ __forceinline__ void hyena_item(const Args& a, int layer, int row0, int g, unsigned char* lds, const int wave0) {
    constexpr int L = NQ * 1024, nb = L / 32;
    const int tid = (wave0 * 64 + pg8::lane_now()), lane = tid & 63, wave = wave0, r32 = lane & 31, hi = lane >> 5;
    bf16_t* P = (bf16_t*)(a.ws + WS_P);
    bf16_t* zs = (bf16_t*)lds;
    bf16_t* zero = zs + 8 * L;
    float* ptab = (float*)(lds + 8 * L * 2 + 64);
    const float* hcw = a.in[5] + layer * 3 * 768; const float* hcb = a.in[6] + layer * 768; const float* hbias = a.in[13] + layer * 256;
    if (tid < 16) ((unsigned*)zero)[tid] = 0u;
    if (tid < 128) { const int e = tid >> 4, q = tid & 15; const int lc = pi_slot(8 * g + e); float v = 0.f;
        if (q < 9) v = hcw[(q % 3) * 768 + (q / 3) * 256 + lc]; else if (q < 12) v = hcb[(q - 9) * 256 + lc]; else if (q == 12) v = hbias[lc];
        ptab[e * 16 + q] = v; }
    __syncthreads();
    for (int t = tid; t < L; t += NTHR) {
        const bf16_t* pr = P + (size_t)(row0 + t) * PW + 3 * 256 + 8 * g;
        const u32x4 zz = (u32x4){0u, 0u, 0u, 0u};
        const u32x4 x1c = *(const u32x4*)pr, x1m = t > 0 ? *(const u32x4*)(pr - PW) : zz, x1p = t < L - 1 ? *(const u32x4*)(pr + PW) : zz;
        const u32x4 hvc = *(const u32x4*)(pr + 256), hvm = t > 0 ? *(const u32x4*)(pr + 256 - PW) : zz, hvp = t < L - 1 ? *(const u32x4*)(pr + 256 + PW) : zz;
#pragma unroll
        for (int e = 0; e < 8; ++e) { const float* pt = ptab + e * 16;
            const float u1 = pt[3] * bf2f(u16at(x1m, e)) + pt[4] * bf2f(u16at(x1c, e)) + pt[5] * bf2f(u16at(x1p, e)) + pt[10];
            const float uv = pt[6] * bf2f(u16at(hvm, e)) + pt[7] * bf2f(u16at(hvc, e)) + pt[8] * bf2f(u16at(hvp, e)) + pt[11];
            zs[e * L + t] = (bf16_t)f2bf1(uv * u1); }
    }
    __syncthreads();
    {
        const int lc = pi_slot(8 * g + wave);
        const bf16_t* Wc = (const bf16_t*)(a.ws + WS_S + (NQ == 8 ? S_HW8 : S_HW2)) + (size_t)lc * (2 * L * 8);
        const bf16_t* zw = zs + wave * L;
        f32x16 acc[NQ];
#pragma unroll
        for (int q = 0; q < NQ; ++q) acc[q] = f32x16{};
        constexpr int NIT = 2 * (2 * nb - 1), dmin = -(nb - 1);
        const int abase = L + r32 - 8 * hi;
        bf16x8 ar[4];
#pragma unroll
        for (int u = 0; u < 4; ++u) { const int d = dmin + (u >> 1), ks = u & 1; ar[u] = *(const bf16x8*)(Wc + (size_t)(abase + 32 * d - 16 * ks) * 8); }
        for (int it = 0; it < NIT; it += 4) {
#pragma unroll
            for (int u = 0; u < 4; ++u) {
                const bf16x8 cur = ar[u];
                { int itn = it + u + 4; itn = itn < NIT ? itn : NIT - 1; const int dn = dmin + (itn >> 1), ksn = itn & 1; ar[u] = *(const bf16x8*)(Wc + (size_t)(abase + 32 * dn - 16 * ksn) * 8); }
                const int itc = it + u;
                if (itc < NIT) {
                    const int d = dmin + (itc >> 1), ks = itc & 1;
#pragma unroll
                    for (int q = 0; q < NQ; ++q) {
                        if (d >= 32 * q - nb + 1 && d <= 32 * q + 31) {
                            const int j = 32 * q + r32 - d;
                            const bf16_t* bp = ((unsigned)j < (unsigned)nb) ? (zw + 32 * j + 16 * ks + 8 * hi) : zero;
                            const bf16x8 bf = *(const bf16x8*)bp;
                            acc[q] = mfma32(cur, bf, acc[q]);
                        }
                    }
                }
            }
        }
        const float hb_ = ptab[wave * 16 + 12];
        bf16_t* zwm = zs + wave * L;
#pragma unroll
        for (int q = 0; q < NQ; ++q)
#pragma unroll
            for (int rg = 0; rg < 4; ++rg) {
                const int t0 = 32 * (32 * q + r32) + 8 * rg + 4 * hi;
                const u32x2 zz = *(const u32x2*)(zwm + t0);
                const float y0 = acc[q][4 * rg + 0] + hb_ * bf2f(zz.x & 0xffffu), y1 = acc[q][4 * rg + 1] + hb_ * bf2f(zz.x >> 16);
                const float y2 = acc[q][4 * rg + 2] + hb_ * bf2f(zz.y & 0xffffu), y3 = acc[q][4 * rg + 3] + hb_ * bf2f(zz.y >> 16);
                u32x2 w; w.x = cvtpk(y0, y1); w.y = cvtpk(y2, y3); *(u32x2*)(zwm + t0) = w;
            }
    }
    __syncthreads();
    for (int t = tid; t < L; t += NTHR) {
        const bf16_t* pr = P + (size_t)(row0 + t) * PW + 2 * 256 + 8 * g;
        const u32x4 zz = (u32x4){0u, 0u, 0u, 0u};
        const u32x4 xc = *(const u32x4*)pr, xm = t > 0 ? *(const u32x4*)(pr - PW) : zz, xp = t < L - 1 ? *(const u32x4*)(pr + PW) : zz;
        float o[8];
#pragma unroll
        for (int e = 0; e < 8; ++e) { const float* pt = ptab + e * 16;
            const float u0 = pt[0] * bf2f(u16at(xm, e)) + pt[1] * bf2f(u16at(xc, e)) + pt[2] * bf2f(u16at(xp, e)) + pt[9];
            o[e] = u0 * bf2f(zs[e * L + t]); }
        u32x4 w; w.x = cvtpk(o[0], o[1]); w.y = cvtpk(o[2], o[3]); w.z = cvtpk(o[4], o[5]); w.w = cvtpk(o[6], o[7]);
        *(u32x4*)(P + (size_t)(row0 + t) * PW + 3 * 256 + 8 * g) = w;
    }
    __syncthreads();
}

__device__ __forceinline__ void attn_unit(bf16_t* P, int row0, int L, int kvh, int qb, unsigned char* lds, const int wave0) {
    const int tid = (wave0 * 64 + pg8::lane_now()), lane = tid & 63, wave = wave0, r32 = lane & 31, hi = lane >> 5;
    const int head = 2 * kvh + (wave >> 2);
    bf16_t* qp = P + (size_t)(row0 + qb * 128 + (wave & 3) * 32 + r32) * PW + head * 64;
    bf16x8 qf[4];
#pragma unroll
    for (int ks = 0; ks < 4; ++ks) qf[ks] = *(const bf16x8*)(qp + 16 * ks + 8 * hi);
    bf16_t* Ks = (bf16_t*)lds; bf16_t* Vt = Ks + 2 * 64 * 72;
    const int skey = tid >> 3, sch = tid & 7;
    const bf16_t* kg = P + (size_t)(row0 + skey) * PW + 256 + kvh * 64 + sch * 8;
    u32x4 kreg = *(const u32x4*)kg, vreg = *(const u32x4*)(kg + 128);
#define ATT_PUT(buf) do { *(u32x4*)(Ks + (buf) * 64 * 72 + skey * 72 + sch * 8) = kreg; \
        _Pragma("unroll") for (int e = 0; e < 8; ++e) Vt[(buf) * 64 * 72 + (sch * 8 + e) * 72 + skey] = u16at(vreg, e); } while (0)
    ATT_PUT(0);
    __syncthreads();
    const int nt = L / 64;
    float m_run = -1e30f, l_run = 0.f; f32x16 o0 = f32x16{}, o1 = f32x16{};
    for (int kt = 0; kt < nt; ++kt) {
        const int buf = kt & 1;
        if (kt + 1 < nt) { const bf16_t* kn = kg + (size_t)(kt + 1) * 64 * PW; kreg = *(const u32x4*)kn; vreg = *(const u32x4*)(kn + 128); }
        f32x16 s0 = f32x16{}, s1 = f32x16{};
        const bf16_t* kb = Ks + buf * 64 * 72;
#pragma unroll
        for (int ks = 0; ks < 4; ++ks) {
            const bf16x8 a0 = *(const bf16x8*)(kb + r32 * 72 + 16 * ks + 8 * hi), a1 = *(const bf16x8*)(kb + (32 + r32) * 72 + 16 * ks + 8 * hi);
            s0 = mfma32(a0, qf[ks], s0); s1 = mfma32(a1, qf[ks], s1);
        }
        float mx = fmaxf(s0[0], s1[0]);
#pragma unroll
        for (int r = 1; r < 16; ++r) mx = fmaxf(mx, fmaxf(s0[r], s1[r]));
        mx = fmaxf(mx, __shfl_xor(mx, 32));
        const float mnew = fmaxf(m_run, mx); const float alpha = __builtin_amdgcn_exp2f(m_run - mnew); m_run = mnew;
        float ps = 0.f;
#pragma unroll
        for (int r = 0; r < 16; ++r) { s0[r] = __builtin_amdgcn_exp2f(s0[r] - mnew); s1[r] = __builtin_amdgcn_exp2f(s1[r] - mnew); ps += s0[r] + s1[r]; }
        l_run = l_run * alpha + ps;
#pragma unroll
        for (int r = 0; r < 16; ++r) { o0[r] *= alpha; o1[r] *= alpha; }
        bf16x8 pb[4]; pb[0] = pack8r(s0, 0); pb[1] = pack8r(s0, 8); pb[2] = pack8r(s1, 0); pb[3] = pack8r(s1, 8);
        const bf16_t* vb = Vt + buf * 64 * 72;
#pragma unroll
        for (int j = 0; j < 4; ++j) {
            const bf16x8 A0 = mk8(*(const u32x2*)(vb + r32 * 72 + 16 * j + 4 * hi), *(const u32x2*)(vb + r32 * 72 + 16 * j + 8 + 4 * hi));
            const bf16x8 A1 = mk8(*(const u32x2*)(vb + (32 + r32) * 72 + 16 * j + 4 * hi), *(const u32x2*)(vb + (32 + r32) * 72 + 16 * j + 8 + 4 * hi));
            o0 = mfma32(A0, pb[j], o0); o1 = mfma32(A1, pb[j], o1);
        }
        if (kt + 1 < nt) ATT_PUT(buf ^ 1);
        __syncthreads();
    }
#undef ATT_PUT
    const float inv = 1.0f / (l_run + __shfl_xor(l_run, 32));
#pragma unroll
    for (int rg = 0; rg < 4; ++rg) {
        u32x2 w0, w1;
        w0.x = cvtpk(o0[4 * rg] * inv, o0[4 * rg + 1] * inv); w0.y = cvtpk(o0[4 * rg + 2] * inv, o0[4 * rg + 3] * inv);
        w1.x = cvtpk(o1[4 * rg] * inv, o1[4 * rg + 1] * inv); w1.y = cvtpk(o1[4 * rg + 2] * inv, o1[4 * rg + 3] * inv);
        *(u32x2*)(qp + 8 * rg + 4 * hi) = w0; *(u32x2*)(qp + 32 + 8 * rg + 4 * hi) = w1;
    }
}

__device__ __forceinline__ float ret_lg2(const Args& a, int layer, int dir, int head) {
    const float rde = a.in[14][layer * 8 + dir * 4 + head];
    return log1pf(-exp2f(-rde)) * 1.4426950408889634f;
}
__device__ __forceinline__ void ret_kv_item(const Args& a, int layer, int cgi, int hp, unsigned char* lds, const int wave0) {
    const int tid = (wave0 * 64 + pg8::lane_now()), lane = tid & 63, wave = wave0, r32 = lane & 31, hi = lane >> 5;
    const bf16_t* P = (const bf16_t*)(a.ws + WS_P);
    bf16_t* KV = (bf16_t*)(a.ws + WS_S + S_KV);
    constexpr int PT = 136;
    bf16_t* Ktf = (bf16_t*)lds; bf16_t* Ktb = Ktf + 2 * 64 * PT; bf16_t* Vt = Ktb + 2 * 64 * PT;
#pragma unroll
    for (int i = 0; i < 4; ++i) {
        const int pc = tid + NTHR * i; const int h = pc >> 10, j = (pc >> 3) & 127, ch = pc & 7; const int head = 2 * hp + h;
        const bf16_t* src = P + (size_t)(cgi * 128 + j) * PW + 6 * 256 + head * 64 + ch * 8;
        const u32x4 kr = *(const u32x4*)src, vr = *(const u32x4*)(src + 256);
        const float wf = exp2f((float)(127 - j) * ret_lg2(a, layer, 0, head)), wb = exp2f((float)j * ret_lg2(a, layer, 1, head));
#pragma unroll
        for (int e = 0; e < 8; ++e) { const float kv = bf2f(u16at(kr, e)); const int o = (h * 64 + ch * 8 + e) * PT + j;
            Ktf[o] = (bf16_t)f2bf1(kv * wf); Ktb[o] = (bf16_t)f2bf1(kv * wb); Vt[o] = u16at(vr, e); }
    }
    __syncthreads();
    {
        const int h = wave >> 2, sub = wave & 3, dir = sub >> 1, e0 = sub & 1; const int head = 2 * hp + h;
        const bf16_t* kt = (dir ? Ktb : Ktf) + h * 64 * PT; const bf16_t* vt = Vt + h * 64 * PT;
        f32x16 c0 = f32x16{}, c1 = f32x16{};
#pragma unroll
        for (int ks = 0; ks < 8; ++ks) {
            const bf16x8 av = *(const bf16x8*)(vt + (32 * e0 + r32) * PT + 16 * ks + 8 * hi);
            const bf16x8 b0 = *(const bf16x8*)(kt + r32 * PT + 16 * ks + 8 * hi), b1 = *(const bf16x8*)(kt + (32 + r32) * PT + 16 * ks + 8 * hi);
            c0 = mfma32(av, b0, c0); c1 = mfma32(av, b1, c1);
        }
        bf16_t* dst = KV + ((size_t)(cgi * 4 + head) * 2 + dir) * 4096;
#pragma unroll
        for (int r = 0; r < 16; ++r) { const int e = 32 * e0 + crow(r, hi); dst[e * 64 + r32] = (bf16_t)f2bf1(c0[r]); dst[e * 64 + 32 + r32] = (bf16_t)f2bf1(c1[r]); }
    }
    __syncthreads();
}
__device__ __forceinline__ void ret_scan(const Args& a, int layer, const int wave0) {
    const int gtid = blockIdx.x * NTHR + (wave0 * 64 + pg8::lane_now()), gthreads = gridDim.x * NTHR;
    bf16_t* KV = (bf16_t*)(a.ws + WS_S + S_KV);
    for (int idx = gtid; idx < 24 * 4 * 2 * 4096; idx += gthreads) {
        const int el = idx & 4095, dir = (idx >> 12) & 1, head = (idx >> 13) & 3, s = idx >> 15;
        const int chunk0 = s < 16 ? 16 * s : 256 + 64 * (s - 16), nc = s < 16 ? 16 : 64;
        const float gch = exp2f(128.0f * ret_lg2(a, layer, dir, head));
        float S = 0.f;
        for (int n = 0; n < nc; ++n) {
            const int cn = dir == 0 ? n : nc - 1 - n;
            bf16_t* sl = KV + ((size_t)((chunk0 + cn) * 4 + head) * 2 + dir) * 4096 + el;
            const float tmp = bf2f(*sl); *sl = (bf16_t)f2bf1(S); S = gch * S + tmp;
        }
    }
}
__device__ __forceinline__ void ret_out_item(const Args& a, int layer, int cgi, int hp, unsigned char* lds, const int wave0) {
    const int tid = (wave0 * 64 + pg8::lane_now()), lane = tid & 63, wave = wave0, r32 = lane & 31, hi = lane >> 5;
    bf16_t* P = (bf16_t*)(a.ws + WS_P);
    const bf16_t* KV = (const bf16_t*)(a.ws + WS_S + S_KV);
    constexpr int PK = 72, PT = 136;
    bf16_t* Kr = (bf16_t*)lds;
    bf16_t* Vt = Kr + 2 * 128 * PK;
    bf16_t* St = Vt + 2 * 64 * PT;
#pragma unroll
    for (int i = 0; i < 4; ++i) {
        const int pc = tid + NTHR * i; const int h = pc >> 10, j = (pc >> 3) & 127, ch = pc & 7; const int head = 2 * hp + h;
        const bf16_t* src = P + (size_t)(cgi * 128 + j) * PW + 6 * 256 + head * 64 + ch * 8;
        const u32x4 kr = *(const u32x4*)src, vr = *(const u32x4*)(src + 256);
        *(u32x4*)(Kr + (h * 128 + j) * PK + ch * 8) = kr;
#pragma unroll
        for (int e = 0; e < 8; ++e) Vt[(h * 64 + ch * 8 + e) * PT + j] = u16at(vr, e);
        const int hd = pc >> 9, e_ = (pc >> 3) & 63;
        const int h2 = hd >> 1, dir = hd & 1;
        const u32x4 sr = *(const u32x4*)(KV + ((size_t)(cgi * 4 + 2 * hp + h2) * 2 + dir) * 4096 + e_ * 64 + ch * 8);
        *(u32x4*)(St + (hd * 64 + e_) * PK + ch * 8) = sr;
    }
    const int h = wave >> 2, isub = wave & 3; const int head = 2 * hp + h;
    const int irow = cgi * 128 + isub * 32 + r32;
    bf16_t* qp = P + (size_t)irow * PW + 5 * 256 + head * 64;
    bf16x8 qf[4];
#pragma unroll
    for (int ks = 0; ks < 4; ++ks) qf[ks] = *(const bf16x8*)(qp + 16 * ks + 8 * hi);
    __syncthreads();
    const float lgf = ret_lg2(a, layer, 0, head), lgb = ret_lg2(a, layer, 1, head);
    const int ipos = isub * 32 + r32;
    f32x16 o0 = f32x16{}, o1 = f32x16{};
    const bf16_t* kb = Kr + h * 128 * PK; const bf16_t* vb = Vt + h * 64 * PT;
#pragma nounroll
    for (int jt = 0; jt < 4; ++jt) {
        f32x16 s = f32x16{};
#pragma unroll
        for (int ks = 0; ks < 4; ++ks) s = mfma32(*(const bf16x8*)(kb + (32 * jt + r32) * PK + 16 * ks + 8 * hi), qf[ks], s);
#pragma unroll
        for (int r = 0; r < 16; ++r) { const int j = 32 * jt + crow(r, hi); const int dist = ipos - j;
            const float w = dist >= 0 ? __builtin_amdgcn_exp2f((float)dist * lgf) : __builtin_amdgcn_exp2f((float)(-dist) * lgb); s[r] *= w; }
        const bf16x8 pb0 = pack8r(s, 0), pb1 = pack8r(s, 8);
#pragma unroll
        for (int jj = 0; jj < 2; ++jj) {
            const int j16 = 32 * jt + 16 * jj; const bf16x8 pb = jj ? pb1 : pb0;
            const bf16x8 A0 = mk8(*(const u32x2*)(vb + r32 * PT + j16 + 4 * hi), *(const u32x2*)(vb + r32 * PT + j16 + 8 + 4 * hi));
            const bf16x8 A1 = mk8(*(const u32x2*)(vb + (32 + r32) * PT + j16 + 4 * hi), *(const u32x2*)(vb + (32 + r32) * PT + j16 + 8 + 4 * hi));
            o0 = mfma32(A0, pb, o0); o1 = mfma32(A1, pb, o1);
        }
    }
#pragma nounroll
    for (int dir = 0; dir < 2; ++dir) {
        const bf16_t* sb = St + ((h * 2 + dir) * 64) * PK;
        f32x16 x0 = f32x16{}, x1 = f32x16{};
#pragma unroll
        for (int ks = 0; ks < 4; ++ks) {
            x0 = mfma32(*(const bf16x8*)(sb + r32 * PK + 16 * ks + 8 * hi), qf[ks], x0);
            x1 = mfma32(*(const bf16x8*)(sb + (32 + r32) * PK + 16 * ks + 8 * hi), qf[ks], x1);
        }
        const float wq = dir == 0 ? exp2f((float)(ipos + 1) * lgf) : exp2f((float)(128 - ipos) * lgb);
#pragma unroll
        for (int r = 0; r < 16; ++r) { o0[r] += wq * x0[r]; o1[r] += wq * x1[r]; }
    }
    float ss = 0.f;
#pragma unroll
    for (int r = 0; r < 16; ++r) ss += o0[r] * o0[r] + o1[r] * o1[r];
    ss += __shfl_xor(ss, 32);
    const float rn = 1.0f / sqrtf(ss * (1.0f / 64.0f) + EPS);
    const bf16_t* gp = P + (size_t)irow * PW + 8 * 256 + head * 64;
#pragma unroll
    for (int rg = 0; rg < 4; ++rg) {
        const u32x2 g0 = *(const u32x2*)(gp + 8 * rg + 4 * hi), g1 = *(const u32x2*)(gp + 32 + 8 * rg + 4 * hi);
        u32x2 w0, w1;
        w0.x = cvtpk(o0[4 * rg] * rn * bf2f(g0.x & 0xffffu), o0[4 * rg + 1] * rn * bf2f(g0.x >> 16)); w0.y = cvtpk(o0[4 * rg + 2] * rn * bf2f(g0.y & 0xffffu), o0[4 * rg + 3] * rn * bf2f(g0.y >> 16));
        w1.x = cvtpk(o1[4 * rg] * rn * bf2f(g1.x & 0xffffu), o1[4 * rg + 1] * rn * bf2f(g1.x >> 16)); w1.y = cvtpk(o1[4 * rg + 2] * rn * bf2f(g1.y & 0xffffu), o1[4 * rg + 3] * rn * bf2f(g1.y >> 16));
        *(u32x2*)(qp + 8 * rg + 4 * hi) = w0; *(u32x2*)(qp + 32 + 8 * rg + 4 * hi) = w1;
    }
    __syncthreads();
}

__device__ __forceinline__ void sc_rows(const Args& a, int layer, const int wave0) {
    const int gtid = blockIdx.x * NTHR + (wave0 * 64 + pg8::lane_now()), gthreads = gridDim.x * NTHR;
    bf16_t* P = (bf16_t*)(a.ws + WS_P);
    const float* scw = a.in[15] + layer * 3 * 256;
    for (int idx = gtid; idx < T_ALL * 32; idx += gthreads) {
        const int R = idx >> 5, cg8 = idx & 31;
        const int L = R < T_PROMPT ? 2048 : 8192, t = R & (L - 1);
        bf16_t* pr = P + (size_t)R * PW + 9 * 256 + 8 * cg8;
        const u32x4 zz = (u32x4){0u, 0u, 0u, 0u};
        const u32x4 sb = *(const u32x4*)pr;
        const u32x4 cc = *(const u32x4*)(pr + 256), hc = *(const u32x4*)(pr + 512);
        const u32x4 cm = t > 0 ? *(const u32x4*)(pr + 256 - PW) : zz, hm = t > 0 ? *(const u32x4*)(pr + 512 - PW) : zz;
        const u32x4 cp = t < L - 1 ? *(const u32x4*)(pr + 256 + PW) : zz, hp = t < L - 1 ? *(const u32x4*)(pr + 512 + PW) : zz;
        float o[8];
#pragma unroll
        for (int e = 0; e < 8; ++e) { const int lc = pi_slot(8 * cg8 + e);
            const float y = scw[lc] * (bf2f(u16at(cm, e)) * bf2f(u16at(hm, e))) + scw[256 + lc] * (bf2f(u16at(cc, e)) * bf2f(u16at(hc, e))) + scw[512 + lc] * (bf2f(u16at(cp, e)) * bf2f(u16at(hp, e)));
            o[e] = bf2f(u16at(sb, e)) * y; }
        u32x4 w; w.x = cvtpk(o[0], o[1]); w.y = cvtpk(o[2], o[3]); w.z = cvtpk(o[4], o[5]); w.w = cvtpk(o[6], o[7]);
        *(u32x4*)pr = w;
    }
}


#ifndef STOP_AFTER
#define STOP_AFTER 0
#endif
__device__ __forceinline__ void dbg_fold(const Args& a, const bf16_t* src, int ld, int ncol3, const int wave0) {
    const int gtid = blockIdx.x * NTHR + (wave0 * 64 + pg8::lane_now()), gthreads = gridDim.x * NTHR;
    for (int idx = gtid; idx < T_ALL * 1024; idx += gthreads) { const int r = idx >> 10, c = idx & 1023; float v = 0.f;
        for (int k = 0; k < ncol3; ++k) v += bf2f(src[(size_t)r * ld + c + 1024 * k]);
        a.out[idx] = v; }
}
template <class Epi>
__device__ __forceinline__ void run_gemm(unsigned char* lds, const bf16_t* A, const bf16_t* Bt, int M, int N, int K, int lda, int ldb, const Epi& E, const int wave0) {
    pg8::Gemm g{A, Bt, M, N, K, lda, ldb}; pg8::StaticOrder S; S.init(M, N, (int)gridDim.x, (int)blockIdx.x);
    pg8::gemm_phase<Epi, pg8::StaticOrder, true, true>((PG8_LAS unsigned char*)lds, g, S, E, wave0);
}

__global__ void __launch_bounds__(NTHR, 2) fwd_megakernel(Args a) {
    extern __shared__ __attribute__((aligned(16))) unsigned char lds[];
    cg::grid_group grid = cg::this_grid();
    const int wave0 = __builtin_amdgcn_readfirstlane((int)threadIdx.x >> 6);
    const int G = gridDim.x, bx = blockIdx.x;
    unsigned char* ws = a.ws;
    bf16_t* P = (bf16_t*)(ws + WS_P); bf16_t* XN = (bf16_t*)(ws + WS_XN);
    float* rcos = (float*)(ws + WS_MISC); float* rsin = rcos + 2048;
    bf16_t* GATE = (bf16_t*)(ws + WS_S + S_GATE); bf16_t* ACT = (bf16_t*)(ws + WS_S + S_ACT);
    float* MF = (float*)(ws + WS_S + S_MF); bf16_t* MB = (bf16_t*)(ws + WS_S + S_MB);

    for (int layer = 0; layer < 2; ++layer) {
        const float* ng = a.in[2] + layer * 4 * DM;
        if (EN & 1) prep_weights(a, layer, lds, wave0);
        __syncthreads();
        if (layer == 0 && bx == G - 1) rope_table(rcos, rsin, wave0);
        if (EN & 2) for (int it = bx; it < 160; it += G) hy_filter_item(a, layer, it, lds, wave0);
        GSYNC();
        if (EN & 2) for (int it = bx; it < 512; it += G) hy_window_item(a, it, lds, wave0);
        for (int g = 0; g < NGROUP; ++g) {
            norm_x_rows(a, layer, g, ng, XN, wave0);
            GSYNC();
            pg8::EpiIn E{P, g * GROUP, a.in[4] + layer * 128, rcos, rsin, QSCALE};
            if (EN & 4) run_gemm(lds, XN, (const bf16_t*)(ws + WS_WIN), GROUP, PW, DM, DM, DM, E, wave0);
            GSYNC();
        }
        if (STOP_AFTER == 1) { dbg_fold(a, P, PW, 3, wave0); return; }
        if (EN & 8) for (int it = bx; it < 768 * 2; it += G) ret_kv_item(a, layer, it >> 1, it & 1, lds, wave0);
        GSYNC();
        if (EN & 8) ret_scan(a, layer, wave0);
        GSYNC();
        if (EN & 16) for (int it = bx; it < 256; it += G) hyena_item<8>(a, layer, T_PROMPT + (it >> 5) * 8192, it & 31, lds, wave0);
        if (EN & 32) for (int it = bx; it < 512; it += G) hyena_item<2>(a, layer, (it >> 5) * 2048, it & 31, lds, wave0);
        if (EN & 64) for (int it = bx; it < 1024; it += G) { const int pair = it & 15, qb = it >> 4; attn_unit(P, T_PROMPT + (pair >> 1) * 8192, 8192, pair & 1, qb, lds, wave0); }
        if (EN & 64) for (int it = bx; it < 512; it += G) { const int pair = it & 31, qb = it >> 5; attn_unit(P, (pair >> 1) * 2048, 2048, pair & 1, qb, lds, wave0); }
        if (EN & 128) for (int it = bx; it < 768 * 2; it += G) ret_out_item(a, layer, it >> 1, it & 1, lds, wave0);
        if (EN & 256) sc_rows(a, layer, wave0);
        GSYNC();
        if (STOP_AFTER == 2) { dbg_fold(a, P, PW, 3, wave0); return; }
        for (int g = 0; g < NGROUP; ++g) {
            norm_x_rows(a, layer, g, ng, XN, wave0);
            GSYNC();
            if (EN & 512) { pg8::EpiGate E{GATE, 4096}; run_gemm(lds, XN, (const bf16_t*)(ws + WS_WG), GROUP, 4096, DM, DM, DM, E, wave0); }
            GSYNC();
            if (EN & 1024) {
                const bf16_t* Pg = P + (size_t)g * GROUP * PW;
#pragma nounroll
                for (int n = 0; n < 4; ++n) {
                    const int tile = n == 0 ? 0 : (n == 1 ? 3 : (n == 2 ? 5 : 9));
                    pg8::EpiBranch E{GATE, MF, MB, n};
                    run_gemm(lds, Pg + tile * 256, (const bf16_t*)(ws + WS_WB) + (size_t)n * 1024 * 256, GROUP, DM, 256, PW, 256, E, wave0);
                }
            }
            GSYNC();
            if (EN & 2048) { pg8::EpiF32 E{MF, DM}; run_gemm(lds, MB, (const bf16_t*)(ws + WS_WO), GROUP, DM, DM, DM, DM, E, wave0); }
            GSYNC();
            norm_res_rows(a, MF, g, layer == 0, ng + DM, ng + 2 * DM, XN, wave0);
            GSYNC();
            if (EN & 4096) { pg8::EpiSwiglu E{ACT}; run_gemm(lds, XN, (const bf16_t*)(ws + WS_WFI), GROUP, 2 * DFF, DM, DM, DM, E, wave0); }
            GSYNC();
            if (EN & 8192) { pg8::EpiF32 E{MF, DM}; run_gemm(lds, ACT, (const bf16_t*)(ws + WS_WFO), GROUP, DM, DFF, DFF, DFF, E, wave0); }
            GSYNC();
            norm_res_rows(a, MF, g, false, ng + 3 * DM, nullptr, nullptr, wave0);
            GSYNC();
        }
    }
}

extern "C" void kernel_launch(void* const* d_in, const int* in_sizes, int n_in, void* d_out, int out_size, void* d_ws, size_t ws_size, hipStream_t stream) {
    static int grid = 0;
    if (grid == 0) {
        if (n_in != 20 || out_size != T_ALL * DM || ws_size < WS_NEED) { fprintf(stderr, "kernel_launch: unexpected shapes: n_in %d out %d ws %zu (need %zu)\n", n_in, out_size, ws_size, (size_t)WS_NEED); grid = -1; return; }
        int dev = 0, cus = 0, per_cu = 0;
        hipGetDevice(&dev); hipDeviceGetAttribute(&cus, hipDeviceAttributeMultiprocessorCount, dev);
        hipFuncSetAttribute((const void*)fwd_megakernel, hipFuncAttributeMaxDynamicSharedMemorySize, LDS_BYTES);
        hipOccupancyMaxActiveBlocksPerMultiprocessor(&per_cu, (const void*)fwd_megakernel, NTHR, LDS_BYTES);
        (void)hipGetLastError();
        if (per_cu < 1) per_cu = 1;
        grid = cus * 1;
        fprintf(stderr, "kernel_launch: cus %d per_cu %d grid %d\n", cus, per_cu, grid);
    }
    if (grid < 0) return;
    Args a{};
    for (int i = 0; i < 20; ++i) a.in[i] = (const float*)d_in[i];
    a.out = (float*)d_out; a.ws = (unsigned char*)d_ws;
    void* args[] = {&a};
    hipError_t e = hipLaunchCooperativeKernel((const void*)fwd_megakernel, dim3(grid), dim3(NTHR), args, LDS_BYTES, stream);
    if (e != hipSuccess) fprintf(stderr, "cooperative launch failed: %s (grid %d)\n", hipGetErrorString(e), grid);
}
```

```cpp
#include <hip/hip_runtime.h>
#include <hip/hip_cooperative_groups.h>
#include <cstdio>
#include <cstdint>
namespace pg8 {
#define PG8_LAS __attribute__((address_space(3)))
typedef unsigned short bf16_t;
typedef short bf16x8 __attribute__((ext_vector_type(8)));
typedef float f32x4 __attribute__((ext_vector_type(4)));
typedef unsigned u32x4 __attribute__((ext_vector_type(4)));
__device__ __forceinline__ int opq(int x) { asm volatile("" : "+v"(x)); return x; }
__device__ __forceinline__ int lane_now() { int l; asm volatile("v_mbcnt_lo_u32_b32 %0, -1, 0\n\tv_mbcnt_hi_u32_b32 %0, -1, %0" : "=v"(l)); return l; }
__device__ __forceinline__ float shx(float v, int o) { return __builtin_bit_cast(float, __builtin_amdgcn_ds_bpermute((lane_now() ^ o) << 2, __builtin_bit_cast(int, v))); }
constexpr int BM = 256, BK = 64, HALF = 128, HTB = HALF * BK * 2  , STAGE_BYTES = 8 * HTB, NXCD = 8, WGM = 8;

__host__ __device__ __forceinline__ int lds_byte(int r, int c) { const int st = (r >> 4) * 2 + (c >> 5), rr = r & 15, cc = c & 31, ob = rr * 64 + cc * 2; return st * 1024 + (ob ^ (((ob >> 9) & 1) << 5)); }
__host__ __device__ __forceinline__ void stage_rc(int b, int& R, int& C) { const int st = b / 1024, sb = b % 1024, swz = sb ^ (((sb >> 9) & 1) << 5); R = (st >> 1) * 16 + swz / 64; C = (st & 1) * 32 + (swz % 64) / 2; }
__host__ __device__ __forceinline__ int perm32(int rho) { const int n = rho >> 4, i = rho & 15; return 8 * (i >> 2) + 4 * n + (i & 3); }

struct Unit { int pm, pn; };
struct Gemm { const bf16_t* A; const bf16_t* Bt; int M, N, K, lda, ldb; };

struct StaticOrder {
    int nM, nN, nwg, G, c;
    __host__ __device__ void init(int M, int N, int G_, int c_) { nM = M / BM; nN = N / BM; nwg = nM * nN; G = G_; c = c_; }
    __host__ __device__ bool next(int i, Unit& u) const {
        const long L = (long)i * G + c; if (L >= nwg) return false;
        int wgid = (int)L; { const int q = nwg / NXCD, r = nwg % NXCD, xcd = wgid % NXCD, off = wgid / NXCD; wgid = (xcd < r ? xcd * (q + 1) : r * (q + 1) + (xcd - r) * q) + off; }
        const int nig = WGM * nN, gid = wgid / nig, fm = gid * WGM, gsz = (nM - fm) < WGM ? (nM - fm) : WGM;
        u.pm = fm + ((wgid % nig) % gsz); u.pn = (wgid % nig) / gsz; return true;
    }
    __device__ __forceinline__ void a_ready(const Unit&) const {}
    __device__ __forceinline__ void done(const Unit&) const {}
};

typedef float f32x2 __attribute__((ext_vector_type(2)));
typedef __bf16 bf16x2_t __attribute__((ext_vector_type(2)));
__device__ __forceinline__ unsigned cvt_pk_bf16(float lo, float hi) { f32x2 v = {lo, hi}; bf16x2_t b = __builtin_convertvector(v, bf16x2_t); return __builtin_bit_cast(unsigned, b); }
typedef float f32x16 __attribute__((ext_vector_type(16)));
__device__ __forceinline__ f32x4 ldg4(const float* p) { return *(const f32x4*)p; }
__device__ __forceinline__ u32x4 pack8(const f32x4 a, const f32x4 b) { u32x4 w; w.x = cvt_pk_bf16(a[0], a[1]); w.y = cvt_pk_bf16(a[2], a[3]); w.z = cvt_pk_bf16(b[0], b[1]); w.w = cvt_pk_bf16(b[2], b[3]); return w; }
__device__ __forceinline__ float bf2f(unsigned h) { return __uint_as_float(h << 16); }
__device__ __forceinline__ f32x4 unpack_lo(const u32x4 w) { return (f32x4){__uint_as_float(w.x << 16), __uint_as_float(w.x & 0xffff0000u), __uint_as_float(w.y << 16), __uint_as_float(w.y & 0xffff0000u)}; }
__device__ __forceinline__ f32x4 unpack_hi(const u32x4 w) { return (f32x4){__uint_as_float(w.z << 16), __uint_as_float(w.z & 0xffff0000u), __uint_as_float(w.w << 16), __uint_as_float(w.w & 0xffff0000u)}; }
__device__ __forceinline__ int branch_tile(int n) { return n == 0 ? 0 : (n == 1 ? 3 : (n == 2 ? 5 : 9)); }
__device__ __forceinline__ float sigm(float v) { return 1.0f / (1.0f + __expf(-v)); }

struct EpiIn {
    static constexpr bool PERM = true, AFTER_DRAIN = false, BRANCH_A = false;
    bf16_t* P; int row_base; const float* qkn; const float* rcos; const float* rsin; float qscale;
    __device__ __forceinline__ void operator()(const f32x4 (&acc)[2][2][4][2], const Unit& u, int wr, int wc, int fr_, int fq_) const {
        const int ln_ = lane_now(); const int fr = ln_ & 15, fq = ln_ >> 4; (void)fr_; (void)fq_;
        const int pn = u.pn;
        const bool is_k = (pn == 1 && wc < 2);
        const bool do_norm = (pn == 0) || is_k;
        const bool do_rope = do_norm || pn == 5 || pn == 6;
        const float scale = (pn == 0) ? qscale : (pn == 6 ? 0.125f : 1.0f);
        const bool do_silu = (pn == 8);
        const float* gp = qkn + (is_k ? 64 : 0) + 4 * fq;
#pragma unroll
        for (int ai = 0; ai < 2; ++ai)
#pragma unroll
            for (int m = 0; m < 4; ++m) {
                const int row = row_base + u.pm * BM + ai * HALF + wr * 64 + m * 16 + fr;
                f32x4 v[2][2];
#pragma unroll
                for (int bj = 0; bj < 2; ++bj)
#pragma unroll
                    for (int n = 0; n < 2; ++n) v[bj][n] = acc[ai][bj][m][n];
                if (do_norm) {
                    float ss = 0.f;
#pragma unroll
                    for (int bj = 0; bj < 2; ++bj)
#pragma unroll
                        for (int n = 0; n < 2; ++n) ss += (v[bj][n][0] * v[bj][n][0] + v[bj][n][1] * v[bj][n][1]) + (v[bj][n][2] * v[bj][n][2] + v[bj][n][3] * v[bj][n][3]);
                    ss += shx(ss, 16); ss += shx(ss, 32);
                    const float rn = 1.0f / sqrtf(ss * (1.0f / 64.0f) + 1e-6f);
#pragma unroll
                    for (int bj = 0; bj < 2; ++bj)
#pragma unroll
                        for (int n = 0; n < 2; ++n) v[bj][n] = v[bj][n] * rn * ldg4(gp + 32 * bj + 16 * n);
                }
                if (do_rope) {
                    const int L = row < 32768 ? 2048 : 8192; const int t = row & (L - 1);
#pragma unroll
                    for (int bj = 0; bj < 2; ++bj) {
                        const int pos = bj == 0 ? (t >> 6) : (t & 63);
                        const f32x4 c = ldg4(rcos + pos * 16 + 4 * fq), s = ldg4(rsin + pos * 16 + 4 * fq);
                        const f32x4 a = v[bj][0], b = v[bj][1];
                        v[bj][0] = a * c - b * s; v[bj][1] = b * c + a * s;
                    }
                }
#pragma unroll
                for (int bj = 0; bj < 2; ++bj) {
                    f32x4 x0 = v[bj][0] * scale, x1 = v[bj][1] * scale;
                    if (do_silu) {
#pragma unroll
                        for (int i = 0; i < 4; ++i) { x0[i] = x0[i] * sigm(x0[i]); x1[i] = x1[i] * sigm(x1[i]); }
                    }
                    *(u32x4*)(P + ((unsigned)row * 3072u + (unsigned)(pn * 256 + 64 * wc + 32 * bj + 8 * fq))) = pack8(x0, x1);
                }
                asm volatile("" ::: "memory");
            }
    }
};
struct EpiGate {
    static constexpr bool PERM = true, AFTER_DRAIN = false, BRANCH_A = false;
    bf16_t* O; int ldc;
    __device__ __forceinline__ void operator()(const f32x4 (&acc)[2][2][4][2], const Unit& u, int wr, int wc, int fr_, int fq_) const {
        const int ln_ = lane_now(); const int fr = ln_ & 15, fq = ln_ >> 4; (void)fr_; (void)fq_;
#pragma unroll
        for (int ai = 0; ai < 2; ++ai)
#pragma unroll
            for (int m = 0; m < 4; ++m) {
                const int row = u.pm * BM + ai * HALF + wr * 64 + m * 16 + fr;
#pragma unroll
                for (int bj = 0; bj < 2; ++bj) {
                    f32x4 x0 = acc[ai][bj][m][0], x1 = acc[ai][bj][m][1];
#pragma unroll
                    for (int i = 0; i < 4; ++i) { x0[i] = sigm(x0[i]); x1[i] = sigm(x1[i]); }
                    *(u32x4*)(O + ((unsigned)row * (unsigned)ldc + (unsigned)(u.pn * BM + bj * HALF + wc * 32 + 8 * fq))) = pack8(x0, x1);
                }
            }
    }
};
struct EpiBranch {
    static constexpr bool PERM = true, AFTER_DRAIN = false, BRANCH_A = false;
    const bf16_t* G; float* MF; bf16_t* MB; int nbr;
    __device__ __forceinline__ void operator()(const f32x4 (&acc)[2][2][4][2], const Unit& u, int wr, int wc, int fr_, int fq_) const {
        const int ln_ = lane_now(); const int fr = ln_ & 15, fq = ln_ >> 4; (void)fr_; (void)fq_;
#pragma unroll
        for (int ai = 0; ai < 2; ++ai)
#pragma unroll
            for (int m = 0; m < 4; ++m) {
                const int row = u.pm * BM + ai * HALF + wr * 64 + m * 16 + fr;
#pragma unroll
                for (int bj = 0; bj < 2; ++bj) {
                    const int col = u.pn * BM + bj * HALF + wc * 32 + 8 * fq;
                    const u32x4 gw = *(const u32x4*)(G + ((unsigned)row * 4096u + (unsigned)(nbr * 1024 + col)));
                    f32x4 x0 = acc[ai][bj][m][0] * unpack_lo(gw), x1 = acc[ai][bj][m][1] * unpack_hi(gw);
                    float* mp = MF + ((unsigned)row * 1024u + (unsigned)col);
                    if (nbr != 0) { x0 = x0 + ldg4(mp); x1 = x1 + ldg4(mp + 4); }
                    if (nbr == 3) *(u32x4*)(MB + ((unsigned)row * 1024u + (unsigned)col)) = pack8(x0, x1);
                    else { *(f32x4*)mp = x0; *(f32x4*)(mp + 4) = x1; }
                    asm volatile("" ::: "memory");
                }
            }
    }
};
struct EpiF32 {
    static constexpr bool PERM = true, AFTER_DRAIN = false, BRANCH_A = false;
    float* O; int ldc;
    __device__ __forceinline__ void operator()(const f32x4 (&acc)[2][2][4][2], const Unit& u, int wr, int wc, int fr_, int fq_) const {
        const int ln_ = lane_now(); const int fr = ln_ & 15, fq = ln_ >> 4; (void)fr_; (void)fq_;
#pragma unroll
        for (int ai = 0; ai < 2; ++ai)
#pragma unroll
            for (int m = 0; m < 4; ++m) {
                const int row = u.pm * BM + ai * HALF + wr * 64 + m * 16 + fr;
#pragma unroll
                for (int bj = 0; bj < 2; ++bj) {
                    float* op = O + ((unsigned)row * (unsigned)ldc + (unsigned)(u.pn * BM + bj * HALF + wc * 32 + 8 * fq));
                    *(f32x4*)op = acc[ai][bj][m][0]; *(f32x4*)(op + 4) = acc[ai][bj][m][1];
                }
            }
    }
};
struct EpiSwiglu {
    static constexpr bool PERM = true, AFTER_DRAIN = false, BRANCH_A = false;
    bf16_t* O;
    __device__ __forceinline__ void operator()(const f32x4 (&acc)[2][2][4][2], const Unit& u, int wr, int wc, int fr_, int fq_) const {
        const int ln_ = lane_now(); const int fr = ln_ & 15, fq = ln_ >> 4; (void)fr_; (void)fq_;
#pragma unroll
        for (int ai = 0; ai < 2; ++ai)
#pragma unroll
            for (int m = 0; m < 4; ++m) {
                const int row = u.pm * BM + ai * HALF + wr * 64 + m * 16 + fr;
                f32x4 x0 = acc[ai][0][m][0], x1 = acc[ai][0][m][1];
                const f32x4 u0 = acc[ai][1][m][0], u1 = acc[ai][1][m][1];
#pragma unroll
                for (int i = 0; i < 4; ++i) { x0[i] = x0[i] * sigm(x0[i]) * u0[i]; x1[i] = x1[i] * sigm(x1[i]) * u1[i]; }
                *(u32x4*)(O + ((unsigned)row * 2816u + (unsigned)(u.pn * HALF + wc * 32 + 8 * fq))) = pack8(x0, x1);
            }
    }
};

struct EpiY {
    static constexpr bool PERM = true, AFTER_DRAIN = false, BRANCH_A = true;
    bf16_t* Y;
    __device__ __forceinline__ void operator()(const f32x4 (&acc)[2][2][4][2], const Unit& u, int wr, int wc, int fr_, int fq_) const {
        const int ln_ = lane_now(); const int fr = ln_ & 15, fq = ln_ >> 4; (void)fr_; (void)fq_;
        const int br = u.pn >> 2, ct = u.pn & 3;
#pragma unroll
        for (int ai = 0; ai < 2; ++ai)
#pragma unroll
            for (int m = 0; m < 4; ++m) {
                const int row = u.pm * BM + ai * HALF + wr * 64 + m * 16 + fr;
#pragma unroll
                for (int bj = 0; bj < 2; ++bj) {
                    const int ch0 = 256 * ct + 128 * bj + 32 * wc + 8 * fq;
                    bf16_t* yp = Y + ((unsigned)row * 4096u + (unsigned)((ch0 >> 2) * 16 + br * 4));
                    const f32x4 x0 = acc[ai][bj][m][0], x1 = acc[ai][bj][m][1];
                    typedef unsigned u32x2_t __attribute__((ext_vector_type(2)));
                    u32x2_t w0, w1; w0.x = cvt_pk_bf16(x0[0], x0[1]); w0.y = cvt_pk_bf16(x0[2], x0[3]); w1.x = cvt_pk_bf16(x1[0], x1[1]); w1.y = cvt_pk_bf16(x1[2], x1[3]);
                    *(u32x2_t*)yp = w0; *(u32x2_t*)(yp + 16) = w1;
                }
            }
    }
};
struct EpiMerge {
    static constexpr bool PERM = true, AFTER_DRAIN = false, BRANCH_A = false;
    const bf16_t* Y; bf16_t* MB;
    __device__ __forceinline__ void operator()(const f32x4 (&acc)[2][2][4][2], const Unit& u, int wr, int wc, int fr_, int fq_) const {
        const int ln_ = lane_now(); const int fr = ln_ & 15, fq = ln_ >> 4; (void)fr_; (void)fq_;
        const int ch0 = 64 * u.pn + 16 * wc + 4 * fq;
#pragma unroll
        for (int ai = 0; ai < 2; ++ai)
#pragma unroll
            for (int m = 0; m < 4; ++m) {
                const int row = u.pm * BM + ai * HALF + wr * 64 + m * 16 + fr;
                const bf16_t* yp = Y + ((unsigned)row * 4096u + (unsigned)((ch0 >> 2) * 16));
                const u32x4 ya = *(const u32x4*)yp, yb = *(const u32x4*)(yp + 8);
                const f32x4 y0 = unpack_lo(ya), y1 = unpack_hi(ya), y2 = unpack_lo(yb), y3 = unpack_hi(yb);
                f32x4 o;
#pragma unroll
                for (int i = 0; i < 4; ++i) o[i] = sigm(acc[ai][0][m][0][i]) * y0[i] + sigm(acc[ai][0][m][1][i]) * y1[i] + sigm(acc[ai][1][m][0][i]) * y2[i] + sigm(acc[ai][1][m][1][i]) * y3[i];
                typedef unsigned u32x2_t __attribute__((ext_vector_type(2)));
                u32x2_t w; w.x = cvt_pk_bf16(o[0], o[1]); w.y = cvt_pk_bf16(o[2], o[3]);
                *(u32x2_t*)(MB + ((unsigned)row * 1024u + (unsigned)ch0)) = w;
                asm volatile("" ::: "memory");
            }
    }
};
template <class Epi, class Sched, bool ALIGN_EPI = false, bool SP2 = false>
__device__ __forceinline__ void gemm_phase(PG8_LAS unsigned char* lds, const Gemm g, const Sched& S, const Epi& E, const int wave0) {
    const int tid = wave0 * 64 + lane_now(), wid = wave0, lane = tid & 63, wr = wid >> 2, wc = wid & 3, fr = lane & 15, fq = lane >> 4;
    const int K = g.K, nt = K / BK, lda = g.lda, ldb = g.ldb;
    unsigned voffA[2], voffB[2];
#pragma unroll
    for (int i = 0; i < 2; ++i) { int R, C; stage_rc(tid * 16 + i * 8192, R, C); const int Rb = Epi::PERM ? ((R & ~31) + perm32(R & 31)) : R;
        voffA[i] = (unsigned)(R * lda + C) * 2u; voffB[i] = (unsigned)(Rb * ldb + C) * 2u; }
    const size_t kstep = (size_t)(BK * 2);
    const size_t hstepA = (size_t)HALF * lda * 2, hstepB = (size_t)HALF * ldb * 2;
    const size_t tstepA = 2 * hstepA, tstepB = 2 * hstepB;
    const unsigned ldsw = (unsigned)wid * 1024u;
    const int aoff = lds_byte(wr * 64 + fr, fq * 8), boff = lds_byte(wc * 32 + fr, fq * 8);
#define PG8_SA(b, h) (((b) * 2 + (h)) * HTB)
#define PG8_SB(b, h) ((4 + (b) * 2 + (h)) * HTB)
#define PG8_STAGE(bufoff, gbase, voff) do { _Pragma("unroll") for (int _i = 0; _i < 2; ++_i) \
        __builtin_amdgcn_global_load_lds((const unsigned*)((const char*)(gbase) + (voff)[_i]), (PG8_LAS unsigned*)(lds + (bufoff) + ldsw + _i * 8192), 16, 0, 0); } while (0)
#define PG8_LDA(dst, b, h) do { _Pragma("unroll") for (int m = 0; m < 4; ++m) _Pragma("unroll") for (int k = 0; k < 2; ++k) dst[m][k] = *(const PG8_LAS bf16x8*)(lds + PG8_SA(b, h) + aoff + m * 2048 + k * 1024); } while (0)
#define PG8_LDB(dst, b, h) do { _Pragma("unroll") for (int n = 0; n < 2; ++n) _Pragma("unroll") for (int k = 0; k < 2; ++k) dst[n][k] = *(const PG8_LAS bf16x8*)(lds + PG8_SB(b, h) + boff + n * 2048 + k * 1024); } while (0)
#define PG8_MMA(ai, bj, At, Bt) do { __builtin_amdgcn_s_setprio(1); _Pragma("unroll") for (int m = 0; m < 4; ++m) _Pragma("unroll") for (int n = 0; n < 2; ++n) _Pragma("unroll") for (int k = 0; k < 2; ++k) \
        acc[ai][bj][m][n] = __builtin_amdgcn_mfma_f32_16x16x32_bf16(Bt[n][k], At[m][k], acc[ai][bj][m][n], 0, 0, 0); __builtin_amdgcn_s_setprio(0); } while (0)
#define PG8_WAIT_V(n) asm volatile("s_waitcnt vmcnt(" #n ")" ::: "memory")
#define PG8_WAIT_L(n) asm volatile("s_waitcnt lgkmcnt(" #n ")" ::: "memory")
#define PG8_BAR __builtin_amdgcn_s_barrier()
#define PG8_SCHED __builtin_amdgcn_sched_barrier(0)
    Unit cur, nxt; int ui = 0;
    if (!S.next(0, cur)) return;
    f32x4 acc[2][2][4][2];
#pragma unroll
    for (int a = 0; a < 2; ++a)
#pragma unroll
        for (int b = 0; b < 2; ++b)
#pragma unroll
            for (int m = 0; m < 4; ++m)
#pragma unroll
                for (int n = 0; n < 2; ++n) acc[a][b][m][n] = (f32x4){0.f, 0.f, 0.f, 0.f};
    bf16x8 At[4][2], B0[2][2], B1[2][2];
    const char* cA = (const char*)g.A + (size_t)cur.pm * tstepA + (Epi::BRANCH_A ? (size_t)branch_tile(cur.pn >> 2) * 512 : (size_t)0); const char* cB = (const char*)g.Bt + (size_t)cur.pn * tstepB;
    S.a_ready(cur);
    if constexpr (SP2) {
        PG8_STAGE(PG8_SB(0, 0), cB, voffB); PG8_STAGE(PG8_SB(0, 1), cB + hstepB, voffB); PG8_STAGE(PG8_SA(0, 0), cA, voffA); PG8_STAGE(PG8_SA(0, 1), cA + hstepA, voffA);
        if (wr == 1) PG8_BAR;
        PG8_WAIT_V(2); PG8_BAR;
        PG8_STAGE(PG8_SB(1, 0), cB + kstep, voffB); PG8_STAGE(PG8_SA(1, 0), cA + kstep, voffA); PG8_STAGE(PG8_SB(1, 1), cB + hstepB + kstep, voffB);
        PG8_WAIT_V(6); PG8_BAR;
    } else {
        PG8_STAGE(PG8_SB(0, 0), cB, voffB); PG8_STAGE(PG8_SA(0, 0), cA, voffA); PG8_STAGE(PG8_SB(0, 1), cB + hstepB, voffB); PG8_STAGE(PG8_SA(0, 1), cA + hstepA, voffA);
        if (wr == 1) PG8_BAR;
        PG8_WAIT_V(4); PG8_BAR;
        PG8_STAGE(PG8_SB(1, 0), cB + kstep, voffB); PG8_STAGE(PG8_SA(1, 0), cA + kstep, voffA); PG8_STAGE(PG8_SB(1, 1), cB + hstepB + kstep, voffB);
        PG8_WAIT_V(6); PG8_BAR;
    }
    for (;;) {
        const bool has_next = S.next(ui + 1, nxt);
        const char* nA = has_next ? (const char*)g.A + (size_t)nxt.pm * tstepA + (Epi::BRANCH_A ? (size_t)branch_tile(nxt.pn >> 2) * 512 : (size_t)0) : cA; const char* nB = has_next ? (const char*)g.Bt + (size_t)nxt.pn * tstepB : cB;
        for (int t = 0; t < nt; t += 2) {
            const bool last = (t == nt - 2);
            const char* a1 = cA + (size_t)(t + 1) * kstep;
            const char* a2 = last ? nA : cA + (size_t)(t + 2) * kstep; const char* b2 = last ? nB : cB + (size_t)(t + 2) * kstep;
            const char* a3 = a2 + kstep; const char* b3 = b2 + kstep;
            if (last && has_next) S.a_ready(nxt);
            if constexpr (SP2) {
            PG8_LDB(B0, 0, 0); PG8_LDB(B1, 0, 1); PG8_SCHED; PG8_LDA(At, 0, 0); PG8_STAGE(PG8_SA(1, 1), a1 + hstepA, voffA);
            PG8_WAIT_V(8); PG8_WAIT_L(0); PG8_BAR; PG8_MMA(0, 0, At, B0); PG8_MMA(0, 1, At, B1); PG8_BAR; PG8_SCHED;
            PG8_LDA(At, 0, 1); PG8_STAGE(PG8_SB(0, 0), b2, voffB); PG8_STAGE(PG8_SB(0, 1), b2 + hstepB, voffB); PG8_STAGE(PG8_SA(0, 0), a2, voffA);
            PG8_WAIT_V(8); PG8_WAIT_L(0); PG8_BAR; PG8_MMA(1, 0, At, B0); PG8_MMA(1, 1, At, B1); PG8_BAR; PG8_SCHED;
            PG8_LDB(B0, 1, 0); PG8_LDB(B1, 1, 1); PG8_SCHED; PG8_LDA(At, 1, 0); PG8_STAGE(PG8_SA(0, 1), a2 + hstepA, voffA);
            PG8_WAIT_V(8); PG8_WAIT_L(0); PG8_BAR; PG8_MMA(0, 0, At, B0); PG8_MMA(0, 1, At, B1); PG8_BAR; PG8_SCHED;
            PG8_LDA(At, 1, 1); PG8_STAGE(PG8_SB(1, 0), b3, voffB); PG8_STAGE(PG8_SB(1, 1), b3 + hstepB, voffB); PG8_STAGE(PG8_SA(1, 0), a3, voffA);
            PG8_WAIT_V(8); PG8_WAIT_L(0); PG8_BAR; PG8_MMA(1, 0, At, B0); PG8_MMA(1, 1, At, B1); PG8_BAR; PG8_SCHED;
            } else {
            PG8_LDB(B0, 0, 0); PG8_SCHED; PG8_LDA(At, 0, 0); PG8_STAGE(PG8_SA(1, 1), a1 + hstepA, voffA);
            PG8_WAIT_L(8); PG8_BAR; PG8_WAIT_L(0); PG8_MMA(0, 0, At, B0); PG8_BAR; PG8_SCHED;
            PG8_LDB(B1, 0, 1); PG8_STAGE(PG8_SB(0, 0), b2, voffB);
            PG8_BAR; PG8_WAIT_L(0); PG8_MMA(0, 1, At, B1); PG8_BAR;
            PG8_LDA(At, 0, 1); PG8_STAGE(PG8_SA(0, 0), a2, voffA);
            PG8_BAR; PG8_WAIT_L(0); PG8_MMA(1, 0, At, B0); PG8_BAR; PG8_SCHED;
            PG8_STAGE(PG8_SB(0, 1), b2 + hstepB, voffB);
            PG8_WAIT_V(6); PG8_BAR; PG8_MMA(1, 1, At, B1); PG8_BAR;
            PG8_LDB(B0, 1, 0); PG8_SCHED; PG8_LDA(At, 1, 0); PG8_STAGE(PG8_SA(0, 1), a2 + hstepA, voffA);
            PG8_WAIT_L(8); PG8_BAR; PG8_WAIT_L(0); PG8_MMA(0, 0, At, B0); PG8_BAR; PG8_SCHED;
            PG8_LDB(B1, 1, 1); PG8_STAGE(PG8_SB(1, 0), b3, voffB);
            PG8_BAR; PG8_WAIT_L(0); PG8_MMA(0, 1, At, B1); PG8_BAR;
            PG8_LDA(At, 1, 1); PG8_STAGE(PG8_SA(1, 0), a3, voffA);
            PG8_BAR; PG8_WAIT_L(0); PG8_MMA(1, 0, At, B0); PG8_BAR; PG8_SCHED;
            PG8_STAGE(PG8_SB(1, 1), b3 + hstepB, voffB);
            PG8_WAIT_V(6); PG8_BAR; PG8_MMA(1, 1, At, B1); PG8_BAR;
            }
        }
        if constexpr (ALIGN_EPI) { if (wr == 0) PG8_BAR; }
        if constexpr (!Epi::AFTER_DRAIN) { E(acc, cur, wr, wc, fr, fq); S.done(cur); }
        if (!has_next) break;
#pragma unroll
        for (int a = 0; a < 2; ++a)
#pragma unroll
            for (int b = 0; b < 2; ++b)
#pragma unroll
                for (int m = 0; m < 4; ++m)
#pragma unroll
                    for (int n = 0; n < 2; ++n) acc[a][b][m][n] = (f32x4){0.f, 0.f, 0.f, 0.f};
        cur = nxt; cA = nA; cB = nB; ++ui;
        if constexpr (ALIGN_EPI) { if (wr == 1) PG8_BAR; }
    }
    PG8_WAIT_V(0);
    if constexpr (!ALIGN_EPI) { if (wr == 0) PG8_BAR; }
    PG8_BAR;
    if constexpr (Epi::AFTER_DRAIN) { E.fused(acc, cur, wr, wc, fr, fq, lds, wid, lane); S.done(cur); }
#undef PG8_SA
#undef PG8_SB
#undef PG8_STAGE
#undef PG8_LDA
#undef PG8_LDB
#undef PG8_MMA
#undef PG8_WAIT_V
#undef PG8_WAIT_L
#undef PG8_BAR
#undef PG8_SCHED
}
}

namespace cg = cooperative_groups;
using pg8::bf16_t; using pg8::bf16x8; using pg8::f32x4; using pg8::u32x4; using pg8::f32x16;
typedef unsigned u32x2 __attribute__((ext_vector_type(2)));
#define LAS __attribute__((address_space(3)))
constexpr int NTHR = 512, NWAVES = 8;
constexpr int DM = 1024, T_ALL = 98304, T_PROMPT = 32768, GROUP = 16384, NGROUP = 6;
constexpr int PW = 3072;
constexpr int DFF = 2816;
constexpr float EPS = 1e-6f;
constexpr float QSCALE = 0.125f * 1.4426950408889634f;
constexpr size_t MiB = 1u << 20;
constexpr size_t WS_WIN = 0 * MiB, WS_WG = 6 * MiB, WS_WB = 14 * MiB, WS_WO = 16 * MiB, WS_WFI = 18 * MiB, WS_WFO = 29 * MiB, WS_MISC = 35 * MiB;
constexpr size_t WS_XN = 40 * MiB, WS_P = 72 * MiB, WS_S = 648 * MiB;
constexpr size_t S_HRAW = 0, S_HW8 = 20 * MiB, S_HW2 = 84 * MiB, S_KV = 100 * MiB;
constexpr size_t S_GATE = 0, S_ACT = 0, S_MF = 128 * MiB, S_MB = 192 * MiB;
constexpr size_t WS_CTL = 36 * MiB, CTL_BYTES = 16384;
constexpr size_t WS_NEED = 648 * MiB + 224 * MiB;
constexpr int LDS_BYTES = 147456;
#ifndef ENABLE
#define ENABLE 0xffff
#endif
constexpr int EN = ENABLE;

#define GSYNC() xcd_barrier(xbar)
struct Args { const float* in[20]; float* out; unsigned char* ws; };

__device__ __forceinline__ float wave_sum(float v) {
#pragma unroll
    for (int o = 1; o < 64; o <<= 1) v += pg8::shx(v, o);
    return v;
}
__device__ __forceinline__ unsigned cvtpk(float lo, float hi) { return pg8::cvt_pk_bf16(lo, hi); }
__device__ __forceinline__ float bf2f(unsigned h) { return __uint_as_float(h << 16); }
__device__ __forceinline__ unsigned f2bf1(float f) { return cvtpk(f, 0.f) & 0xffffu; }
__device__ __forceinline__ int pi_slot(int s) { return (s & ~31) | (((s >> 2) & 1) << 4) | (((s >> 3) & 3) << 2) | (s & 3); }
__device__ __forceinline__ f32x16 mfma32(bf16x8 a, bf16x8 b, f32x16 c) { return __builtin_amdgcn_mfma_f32_32x32x16_bf16(a, b, c, 0, 0, 0); }
__device__ __forceinline__ int crow(int r, int hi) { return (r & 3) + 8 * (r >> 2) + 4 * hi; }
__device__ __forceinline__ bf16x8 mk8(u32x2 lo, u32x2 hi) { u32x4 w; w.x = lo.x; w.y = lo.y; w.z = hi.x; w.w = hi.y; return __builtin_bit_cast(bf16x8, w); }
__device__ __forceinline__ bf16x8 pack8r(const f32x16& p, int b) { u32x4 w; w.x = cvtpk(p[b], p[b + 1]); w.y = cvtpk(p[b + 2], p[b + 3]); w.z = cvtpk(p[b + 4], p[b + 5]); w.w = cvtpk(p[b + 6], p[b + 7]); return __builtin_bit_cast(bf16x8, w); }
__device__ __forceinline__ unsigned short u16at(const u32x4& w, int e) { return (unsigned short)((w[e >> 1] >> (16 * (e & 1))) & 0xffffu); }

template <int MAP, bool KPERM>
__device__ __forceinline__ void transpose_item(const float* W, int ld, int K, int nblk, bf16_t* WT, float* scr, int item, int lane) {
    const int kb = item / nblk, nb = item % nblk, k0 = 64 * kb, n0 = 32 * nb;
#pragma unroll 8
    for (int i = 0; i < 32; ++i) { const int kk = 2 * i + (lane >> 5); scr[kk * 33 + (lane & 31)] = W[(size_t)(k0 + kk) * ld + n0 + (lane & 31)]; }
    asm volatile("s_waitcnt lgkmcnt(0)" ::: "memory");
    const int c = lane & 7;
#pragma unroll
    for (int j = 0; j < 4; ++j) {
        const int n = (lane >> 3) + 8 * j; const int ns = n0 + n; int dr;
        if (MAP == 0) dr = ns;
        else if (MAP == 1) { const int lc = ns & 255; dr = (ns & ~255) + 128 * ((lc >> 5) & 1) + 32 * ((lc >> 6) & 3) + 8 * ((lc >> 2) & 3) + 4 * ((lc >> 4) & 1) + (lc & 3); }
        else if (MAP == 3) { const int br = ns >> 10, ch = ns & 1023; dr = (ch >> 6) * 256 + 128 * (br >> 1) + 32 * ((ch >> 4) & 3) + 8 * ((ch >> 2) & 3) + 4 * (br & 1) + (ch & 3); }
        else { const int up = ns >= DFF ? 1 : 0; const int jj = ns - DFF * up; dr = (jj >> 7) * 256 + 128 * up + (jj & 127); }
        float s[8];
#pragma unroll
        for (int e = 0; e < 8; ++e) { const int kl = KPERM ? pi_slot(8 * c + e) : (8 * c + e); s[e] = scr[kl * 33 + n]; }
        u32x4 o; o.x = cvtpk(s[0], s[1]); o.y = cvtpk(s[2], s[3]); o.z = cvtpk(s[4], s[5]); o.w = cvtpk(s[6], s[7]);
        *(u32x4*)(WT + (size_t)dr * K + k0 + 8 * c) = o;
    }
    asm volatile("s_waitcnt lgkmcnt(0)" ::: "memory");
}

__device__ __forceinline__ void prep_weights(const Args& a, int layer, unsigned char* lds, const int wave0) {
    const int tid = (wave0 * 64 + pg8::lane_now()), lane = tid & 63, wave = wave0; const int gw = blockIdx.x * NWAVES + wave, NGW = gridDim.x * NWAVES;
    unsigned char* ws = a.ws;
    float* scr = (float*)(lds + wave * 16384);
    const float* w_in = a.in[3] + (size_t)layer * 1024 * 7168;
    const float* wbr = a.in[16] + (size_t)layer * 4 * 256 * 1024;
    const float* wo = a.in[17] + (size_t)layer * 1024 * 1024;
    const float* wfi = a.in[18] + (size_t)layer * 1024 * 5632;
    const float* wfo = a.in[19] + (size_t)layer * 2816 * 1024;
    constexpr int I_IN = 16 * 96, I_G = 16 * 128, I_B = 4 * 32, I_O = 16 * 32, I_FI = 16 * 176, I_FO = 44 * 32;
    constexpr int NIT = I_IN + I_G + 4 * I_B + I_O + I_FI + I_FO;
    for (int it = gw; it < NIT; it += NGW) {
        int r = it;
        if (r < I_IN) { transpose_item<1, false>(w_in, 7168, 1024, 96, (bf16_t*)(ws + WS_WIN), scr, r, lane); continue; } r -= I_IN;
        if (r < I_G) { transpose_item<3, false>(w_in + 3072, 7168, 1024, 128, (bf16_t*)(ws + WS_WG), scr, r, lane); continue; } r -= I_G;
        if (r < 4 * I_B) { const int n = r / I_B; transpose_item<0, true>(wbr + (size_t)n * 256 * 1024, 1024, 256, 32, (bf16_t*)(ws + WS_WB) + (size_t)n * 1024 * 256, scr, r % I_B, lane); continue; } r -= 4 * I_B;
        if (r < I_O) { transpose_item<0, false>(wo, 1024, 1024, 32, (bf16_t*)(ws + WS_WO), scr, r, lane); continue; } r -= I_O;
        if (r < I_FI) { transpose_item<2, false>(wfi, 5632, 1024, 176, (bf16_t*)(ws + WS_WFI), scr, r, lane); continue; } r -= I_FI;
        transpose_item<0, false>(wfo, 1024, 2816, 32, (bf16_t*)(ws + WS_WFO), scr, r, lane);
    }
}

__device__ __forceinline__ const float* xrow_ptr(const Args& a, int layer, int R) {
    if (layer == 0) return R < T_PROMPT ? a.in[0] + (size_t)R * DM : a.in[1] + (size_t)(R - T_PROMPT) * DM;
    return a.out + (size_t)R * DM;
}
__device__ __forceinline__ void norm_x_rows(const Args& a, int layer, int g, const float* gain, bf16_t* XN, const int wave0) {
    const int tid = (wave0 * 64 + pg8::lane_now()), lane = tid & 63, wave = wave0; const int gw = blockIdx.x * NWAVES + wave, NGW = gridDim.x * NWAVES;
    for (int row = gw; row < GROUP; row += NGW) {
        const float* xr = xrow_ptr(a, layer, g * GROUP + row);
        f32x4 v[4]; float ss = 0.f;
#pragma unroll
        for (int j = 0; j < 4; ++j) { v[j] = *(const f32x4*)(xr + 4 * lane + 256 * j); ss += (v[j][0] * v[j][0] + v[j][1] * v[j][1]) + (v[j][2] * v[j][2] + v[j][3] * v[j][3]); }
        const float rn = 1.0f / sqrtf(wave_sum(ss) * (1.0f / DM) + EPS);
#pragma unroll
        for (int j = 0; j < 4; ++j) { const f32x4 gv = *(const f32x4*)(gain + 4 * lane + 256 * j); const f32x4 o = v[j] * rn * gv;
            u32x2 w; w.x = cvtpk(o[0], o[1]); w.y = cvtpk(o[2], o[3]); *(u32x2*)(XN + (size_t)row * DM + 4 * lane + 256 * j) = w; }
    }
}
__device__ __forceinline__ void norm_res_rows(const Args& a, const float* TMP, int g, bool base_is_x0, const float* gain, const float* gain2, bf16_t* HN, const int wave0) {
    const int tid = (wave0 * 64 + pg8::lane_now()), lane = tid & 63, wave = wave0; const int gw = blockIdx.x * NWAVES + wave, NGW = gridDim.x * NWAVES;
    for (int row = gw; row < GROUP; row += NGW) {
        const int R = g * GROUP + row;
        const float* br = base_is_x0 ? xrow_ptr(a, 0, R) : a.out + (size_t)R * DM;
        const float* tr = TMP + (size_t)row * DM;
        f32x4 v[4], b[4]; float ss = 0.f;
#pragma unroll
        for (int j = 0; j < 4; ++j) { v[j] = *(const f32x4*)(tr + 4 * lane + 256 * j); b[j] = *(const f32x4*)(br + 4 * lane + 256 * j); ss += (v[j][0] * v[j][0] + v[j][1] * v[j][1]) + (v[j][2] * v[j][2] + v[j][3] * v[j][3]); }
        const float rn = 1.0f / sqrtf(wave_sum(ss) * (1.0f / DM) + EPS);
        float s2 = 0.f;
#pragma unroll
        for (int j = 0; j < 4; ++j) { const f32x4 gv = *(const f32x4*)(gain + 4 * lane + 256 * j); v[j] = b[j] + v[j] * rn * gv;
            *(f32x4*)(a.out + (size_t)R * DM + 4 * lane + 256 * j) = v[j]; s2 += (v[j][0] * v[j][0] + v[j][1] * v[j][1]) + (v[j][2] * v[j][2] + v[j][3] * v[j][3]); }
        if (HN) {
            const float r2 = 1.0f / sqrtf(wave_sum(s2) * (1.0f / DM) + EPS);
#pragma unroll
            for (int j = 0; j < 4; ++j) { const f32x4 gv = *(const f32x4*)(gain2 + 4 * lane + 256 * j); const f32x4 o = v[j] * r2 * gv;
                u32x2 w; w.x = cvtpk(o[0], o[1]); w.y = cvtpk(o[2], o[3]); *(u32x2*)(HN + (size_t)row * DM + 4 * lane + 256 * j) = w; }
        }
    }
}

__device__ __forceinline__ void rope_table(float* rcos, float* rsin, const int wave0) {
    for (int i = (wave0 * 64 + pg8::lane_now()); i < 128 * 16; i += NTHR) {
        const int pos = i >> 4, f = i & 15;
        const float inv = powf(10000.0f, -(float)f / 16.0f);
        const float ang = (float)pos * inv;
        rcos[i] = cosf(ang); rsin[i] = sinf(ang);
    }
}

__device__ __forceinline__ void hy_filter_item(const Args& a, int layer, int item, unsigned char* lds, const int wave0) {
    const int tid = (wave0 * 64 + pg8::lane_now());
    const bool big = item < 128; const int L = big ? 8192 : 2048; const int t0 = (big ? item : item - 128) * 64;
    float* hraw = (float*)(a.ws + WS_S + S_HRAW) + (big ? 0 : (size_t)2 * 256 * 8192);
    const float* w1 = a.in[7] + layer * 33 * 64; const float* b1 = a.in[8] + layer * 64; const float* w2 = a.in[9] + layer * 64 * 64; const float* b2 = a.in[10] + layer * 64;
    const float* w3 = a.in[11] + (size_t)layer * 64 * 512; const float* fr = a.in[12] + layer * 128;
    float* zf = (float*)lds; float* h1 = zf + 64 * 33; float* h2 = h1 + 64 * 65;
    const int p = tid & 63, kg = tid >> 6; const int t = t0 + p;
    const float tl = (float)t / (float)(L - 1);
    for (int f = kg; f < 33; f += 8) {
        float v;
        if (f == 0) v = tl;
        else { const int k = (f - 1) & 15; const float fk = 1e-4f + (float)k * ((15.0f - 1e-4f) / 15.0f); const float ang = (6.283185307179586f / (float)L) * (float)t * fk; v = f <= 16 ? cosf(ang) : -sinf(ang); }
        zf[p * 33 + f] = v;
    }
    __syncthreads();
    for (int u = kg; u < 64; u += 8) { float s = b1[u];
        for (int f = 0; f < 33; ++f) s += zf[p * 33 + f] * w1[f * 64 + u];
        h1[p * 65 + u] = sinf(fr[u] * s); }
    __syncthreads();
    for (int u = kg; u < 64; u += 8) { float s = b2[u];
        for (int k = 0; k < 64; ++k) s += h1[p * 65 + k] * w2[k * 64 + u];
        h2[p * 65 + u] = sinf(fr[64 + u] * s); }
    __syncthreads();
    const float dlo = -4.605170185988091f / 1.5f, dhi = -4.605170185988091f / 0.3f;
    for (int col = kg; col < 512; col += 8) { float s = 0.f;
        for (int k = 0; k < 64; ++k) s += h2[p * 65 + k] * w3[k * 512 + col];
        const int dir = col >> 8, c = col & 255; const float delta = fabsf(dlo + (float)c * ((dhi - dlo) / 255.0f));
        hraw[((size_t)dir * 256 + c) * L + t] = s * expf(-tl * delta); }
    __syncthreads();
}
__device__ __forceinline__ void hy_window_item(const Args& a, int item, unsigned char* lds, const int wave0) {
    const int tid = (wave0 * 64 + pg8::lane_now()), lane = tid & 63, wave = wave0;
    const bool big = item < 256; const int L = big ? 8192 : 2048; const int c = big ? item : item - 256;
    const float* hraw = (const float*)(a.ws + WS_S + S_HRAW) + (big ? 0 : (size_t)2 * 256 * 8192);
    const float* hf = hraw + (size_t)c * L; const float* hb = hraw + ((size_t)256 + c) * L;
    bf16_t* W = (bf16_t*)(a.ws + WS_S + (big ? S_HW8 : S_HW2)) + (size_t)c * (2 * L * 8);
    float* red = (float*)lds;
    float ss = 0.f;
    for (int t = tid; t < L; t += NTHR) { const float x = hf[t]; ss += x * x; if (t > 0) { const float y = hb[t]; ss += y * y; } }
    ss = wave_sum(ss);
    if (lane == 0) red[wave] = ss;
    __syncthreads();
    float tot = 0.f;
#pragma unroll
    for (int w = 0; w < NWAVES; ++w) tot += red[w];
    const float nrm = 1.0f / sqrtf(tot + EPS);
    for (int idx = tid; idx < 2 * L; idx += NTHR) {
        const int o = idx - L; float s[8];
#pragma unroll
        for (int e = 0; e < 8; ++e) { const int l = o - e; float v = 0.f; if (l >= 0) { if (l < L) v = hf[l]; } else { if (-l < L) v = hb[-l]; } s[e] = v * nrm; }
        u32x4 w; w.x = cvtpk(s[0], s[1]); w.y = cvtpk(s[2], s[3]); w.z = cvtpk(s[4], s[5]); w.w = cvtpk(s[6], s[7]);
        *(u32x4*)(W + (size_t)idx * 8) = w;
    }
    __syncthreads();
}

template <int NQ>
__device__ __forceinline__ void hyena_item(const Args& a, int layer, int row0, int g, unsigned char* lds, const int wave0) {
    constexpr int L = NQ * 1024, nb = L / 32;
    const int tid = (wave0 * 64 + pg8::lane_now()), lane = tid & 63, wave = wave0, r32 = lane & 31, hi = lane >> 5;
    bf16_t* P = (bf16_t*)(a.ws + WS_P);
    bf16_t* zs = (bf16_t*)lds;
    bf16_t* zero = zs + 8 * L;
    float* ptab = (float*)(lds + 8 * L * 2 + 64);
    const float* hcw = a.in[5] + layer * 3 * 768; const float* hcb = a.in[6] + layer * 768; const float* hbias = a.in[13] + layer * 256;
    if (tid < 16) ((unsigned*)zero)[tid] = 0u;
    if (tid < 128) { const int e = tid >> 4, q = tid & 15; const int lc = pi_slot(8 * g + e); float v = 0.f;
        if (q < 9) v = hcw[(q % 3) * 768 + (q / 3) * 256 + lc]; else if (q < 12) v = hcb[(q - 9) * 256 + lc]; else if (q == 12) v = hbias[lc];
        ptab[e * 16 + q] = v; }
    __syncthreads();
    for (int t = tid; t < L; t += NTHR) {
        const bf16_t* pr = P + (size_t)(row0 + t) * PW + 3 * 256 + 8 * g;
        const u32x4 zz = (u32x4){0u, 0u, 0u, 0u};
        const u32x4 x1c = *(const u32x4*)pr, x1m = t > 0 ? *(const u32x4*)(pr - PW) : zz, x1p = t < L - 1 ? *(const u32x4*)(pr + PW) : zz;
        const u32x4 hvc = *(const u32x4*)(pr + 256), hvm = t > 0 ? *(const u32x4*)(pr + 256 - PW) : zz, hvp = t < L - 1 ? *(const u32x4*)(pr + 256 + PW) : zz;
#pragma unroll
        for (int e = 0; e < 8; ++e) { const float* pt = ptab + e * 16;
            const float u1 = pt[3] * bf2f(u16at(x1m, e)) + pt[4] * bf2f(u16at(x1c, e)) + pt[5] * bf2f(u16at(x1p, e)) + pt[10];
            const float uv = pt[6] * bf2f(u16at(hvm, e)) + pt[7] * bf2f(u16at(hvc, e)) + pt[8] * bf2f(u16at(hvp, e)) + pt[11];
            zs[e * L + t] = (bf16_t)f2bf1(uv * u1); }
    }
    __syncthreads();
    {
        const int lc = pi_slot(8 * g + wave);
        const bf16_t* Wc = (const bf16_t*)(a.ws + WS_S + (NQ == 8 ? S_HW8 : S_HW2)) + (size_t)lc * (2 * L * 8);
        const bf16_t* zw = zs + wave * L;
        f32x16 acc[NQ];
#pragma unroll
        for (int q = 0; q < NQ; ++q) acc[q] = f32x16{};
        constexpr int NIT = 2 * (2 * nb - 1), dmin = -(nb - 1);
        const int abase = L + r32 - 8 * hi;
        bf16x8 ar[4];
#pragma unroll
        for (int u = 0; u < 4; ++u) { const int d = dmin + (u >> 1), ks = u & 1; ar[u] = *(const bf16x8*)(Wc + (size_t)(abase + 32 * d - 16 * ks) * 8); }
        for (int it = 0; it < NIT; it += 4) {
#pragma unroll
            for (int u = 0; u < 4; ++u) {
                const bf16x8 cur = ar[u];
                { int itn = it + u + 4; itn = itn < NIT ? itn : NIT - 1; const int dn = dmin + (itn >> 1), ksn = itn & 1; ar[u] = *(const bf16x8*)(Wc + (size_t)(abase + 32 * dn - 16 * ksn) * 8); }
                const int itc = it + u;
                if (itc < NIT) {
                    const int d = dmin + (itc >> 1), ks = itc & 1;
#pragma unroll
                    for (int q = 0; q < NQ; ++q) {
                        if (d >= 32 * q - nb + 1 && d <= 32 * q + 31) {
                            const int j = 32 * q + r32 - d;
                            const bf16_t* bp = ((unsigned)j < (unsigned)nb) ? (zw + 32 * j + 16 * ks + 8 * hi) : zero;
                            const bf16x8 bf = *(const bf16x8*)bp;
                            acc[q] = mfma32(cur, bf, acc[q]);
                        }
                    }
                }
            }
        }
        const float hb_ = ptab[wave * 16 + 12];
        bf16_t* zwm = zs + wave * L;
#pragma unroll
        for (int q = 0; q < NQ; ++q)
#pragma unroll
            for (int rg = 0; rg < 4; ++rg) {
                const int t0 = 32 * (32 * q + r32) + 8 * rg + 4 * hi;
                const u32x2 zz = *(const u32x2*)(zwm + t0);
                const float y0 = acc[q][4 * rg + 0] + hb_ * bf2f(zz.x & 0xffffu), y1 = acc[q][4 * rg + 1] + hb_ * bf2f(zz.x >> 16);
                const float y2 = acc[q][4 * rg + 2] + hb_ * bf2f(zz.y & 0xffffu), y3 = acc[q][4 * rg + 3] + hb_ * bf2f(zz.y >> 16);
                u32x2 w; w.x = cvtpk(y0, y1); w.y = cvtpk(y2, y3); *(u32x2*)(zwm + t0) = w;
            }
    }
    __syncthreads();
    for (int t = tid; t < L; t += NTHR) {
        const bf16_t* pr = P + (size_t)(row0 + t) * PW + 2 * 256 + 8 * g;
        const u32x4 zz = (u32x4){0u, 0u, 0u, 0u};
        const u32x4 xc = *(const u32x4*)pr, xm = t > 0 ? *(const u32x4*)(pr - PW) : zz, xp = t < L - 1 ? *(const u32x4*)(pr + PW) : zz;
        float o[8];
#pragma unroll
        for (int e = 0; e < 8; ++e) { const float* pt = ptab + e * 16;
            const float u0 = pt[0] * bf2f(u16at(xm, e)) + pt[1] * bf2f(u16at(xc, e)) + pt[2] * bf2f(u16at(xp, e)) + pt[9];
            o[e] = u0 * bf2f(zs[e * L + t]); }
        u32x4 w; w.x = cvtpk(o[0], o[1]); w.y = cvtpk(o[2], o[3]); w.z = cvtpk(o[4], o[5]); w.w = cvtpk(o[6], o[7]);
        *(u32x4*)(P + (size_t)(row0 + t) * PW + 3 * 256 + 8 * g) = w;
    }
    __syncthreads();
}

__device__ __forceinline__ void attn_unit(bf16_t* P, int row0, int L, int kvh, int qb, unsigned char* lds, const int wave0) {
    const int tid = (wave0 * 64 + pg8::lane_now()), lane = tid & 63, wave = wave0, r32 = lane & 31, hi = lane >> 5;
    const int head = 2 * kvh + (wave >> 2);
    bf16_t* qp = P + (size_t)(row0 + qb * 128 + (wave & 3) * 32 + r32) * PW + head * 64;
    bf16x8 qf[4];
#pragma unroll
    for (int ks = 0; ks < 4; ++ks) qf[ks] = *(const bf16x8*)(qp + 16 * ks + 8 * hi);
    bf16_t* Ks = (bf16_t*)lds; bf16_t* Vt = Ks + 2 * 64 * 72;
    const int skey = tid >> 3, sch = tid & 7;
    const bf16_t* kg = P + (size_t)(row0 + skey) * PW + 256 + kvh * 64 + sch * 8;
    u32x4 kreg = *(const u32x4*)kg, vreg = *(const u32x4*)(kg + 128);
#define ATT_PUT(buf) do { *(u32x4*)(Ks + (buf) * 64 * 72 + skey * 72 + sch * 8) = kreg; \
        _Pragma("unroll") for (int e = 0; e < 8; ++e) Vt[(buf) * 64 * 72 + (sch * 8 + e) * 72 + skey] = u16at(vreg, e); } while (0)
    ATT_PUT(0);
    __syncthreads();
    const int nt = L / 64;
    float m_run = -1e30f, l_run = 0.f; f32x16 o0 = f32x16{}, o1 = f32x16{};
    for (int kt = 0; kt < nt; ++kt) {
        const int buf = kt & 1;
        if (kt + 1 < nt) { const bf16_t* kn = kg + (size_t)(kt + 1) * 64 * PW; kreg = *(const u32x4*)kn; vreg = *(const u32x4*)(kn + 128); }
        f32x16 s0 = f32x16{}, s1 = f32x16{};
        const bf16_t* kb = Ks + buf * 64 * 72;
#pragma unroll
        for (int ks = 0; ks < 4; ++ks) {
            const bf16x8 a0 = *(const bf16x8*)(kb + r32 * 72 + 16 * ks + 8 * hi), a1 = *(const bf16x8*)(kb + (32 + r32) * 72 + 16 * ks + 8 * hi);
            s0 = mfma32(a0, qf[ks], s0); s1 = mfma32(a1, qf[ks], s1);
        }
        float mx = fmaxf(s0[0], s1[0]);
#pragma unroll
        for (int r = 1; r < 16; ++r) mx = fmaxf(mx, fmaxf(s0[r], s1[r]));
        mx = fmaxf(mx, pg8::shx(mx, 32));
        const float mnew = fmaxf(m_run, mx); const float alpha = __builtin_amdgcn_exp2f(m_run - mnew); m_run = mnew;
        float ps = 0.f;
#pragma unroll
        for (int r = 0; r < 16; ++r) { s0[r] = __builtin_amdgcn_exp2f(s0[r] - mnew); s1[r] = __builtin_amdgcn_exp2f(s1[r] - mnew); ps += s0[r] + s1[r]; }
        l_run = l_run * alpha + ps;
#pragma unroll
        for (int r = 0; r < 16; ++r) { o0[r] *= alpha; o1[r] *= alpha; }
        bf16x8 pb[4]; pb[0] = pack8r(s0, 0); pb[1] = pack8r(s0, 8); pb[2] = pack8r(s1, 0); pb[3] = pack8r(s1, 8);
        const bf16_t* vb = Vt + buf * 64 * 72;
#pragma unroll
        for (int j = 0; j < 4; ++j) {
            const bf16x8 A0 = mk8(*(const u32x2*)(vb + r32 * 72 + 16 * j + 4 * hi), *(const u32x2*)(vb + r32 * 72 + 16 * j + 8 + 4 * hi));
            const bf16x8 A1 = mk8(*(const u32x2*)(vb + (32 + r32) * 72 + 16 * j + 4 * hi), *(const u32x2*)(vb + (32 + r32) * 72 + 16 * j + 8 + 4 * hi));
            o0 = mfma32(A0, pb[j], o0); o1 = mfma32(A1, pb[j], o1);
        }
        if (kt + 1 < nt) ATT_PUT(buf ^ 1);
        __syncthreads();
    }
#undef ATT_PUT
    const float inv = 1.0f / (l_run + pg8::shx(l_run, 32));
#pragma unroll
    for (int rg = 0; rg < 4; ++rg) {
        u32x2 w0, w1;
        w0.x = cvtpk(o0[4 * rg] * inv, o0[4 * rg + 1] * inv); w0.y = cvtpk(o0[4 * rg + 2] * inv, o0[4 * rg + 3] * inv);
        w1.x = cvtpk(o1[4 * rg] * inv, o1[4 * rg + 1] * inv); w1.y = cvtpk(o1[4 * rg + 2] * inv, o1[4 * rg + 3] * inv);
        *(u32x2*)(qp + 8 * rg + 4 * hi) = w0; *(u32x2*)(qp + 32 + 8 * rg + 4 * hi) = w1;
    }
}

__device__ __forceinline__ float ret_lg2(const Args& a, int layer, int dir, int head) {
    const float rde = a.in[14][layer * 8 + dir * 4 + head];
    return log1pf(-exp2f(-rde)) * 1.4426950408889634f;
}
__device__ __forceinline__ void ret_kv_item(const Args& a, int layer, int cgi, int hp, unsigned char* lds, const int wave0) {
    const int tid = (wave0 * 64 + pg8::lane_now()), lane = tid & 63, wave = wave0, r32 = lane & 31, hi = lane >> 5;
    const bf16_t* P = (const bf16_t*)(a.ws + WS_P);
    bf16_t* KV = (bf16_t*)(a.ws + WS_S + S_KV);
    constexpr int PT = 136;
    bf16_t* Ktf = (bf16_t*)lds; bf16_t* Ktb = Ktf + 2 * 64 * PT; bf16_t* Vt = Ktb + 2 * 64 * PT;
#pragma unroll
    for (int i = 0; i < 4; ++i) {
        const int pc = tid + NTHR * i; const int h = pc >> 10, j = (pc >> 3) & 127, ch = pc & 7; const int head = 2 * hp + h;
        const bf16_t* src = P + (size_t)(cgi * 128 + j) * PW + 6 * 256 + head * 64 + ch * 8;
        const u32x4 kr = *(const u32x4*)src, vr = *(const u32x4*)(src + 256);
        const float wf = exp2f((float)(127 - j) * ret_lg2(a, layer, 0, head)), wb = exp2f((float)j * ret_lg2(a, layer, 1, head));
#pragma unroll
        for (int e = 0; e < 8; ++e) { const float kv = bf2f(u16at(kr, e)); const int o = (h * 64 + ch * 8 + e) * PT + j;
            Ktf[o] = (bf16_t)f2bf1(kv * wf); Ktb[o] = (bf16_t)f2bf1(kv * wb); Vt[o] = u16at(vr, e); }
    }
    __syncthreads();
    {
        const int h = wave >> 2, sub = wave & 3, dir = sub >> 1, e0 = sub & 1; const int head = 2 * hp + h;
        const bf16_t* kt = (dir ? Ktb : Ktf) + h * 64 * PT; const bf16_t* vt = Vt + h * 64 * PT;
        f32x16 c0 = f32x16{}, c1 = f32x16{};
#pragma unroll
        for (int ks = 0; ks < 8; ++ks) {
            const bf16x8 av = *(const bf16x8*)(vt + (32 * e0 + r32) * PT + 16 * ks + 8 * hi);
            const bf16x8 b0 = *(const bf16x8*)(kt + r32 * PT + 16 * ks + 8 * hi), b1 = *(const bf16x8*)(kt + (32 + r32) * PT + 16 * ks + 8 * hi);
            c0 = mfma32(av, b0, c0); c1 = mfma32(av, b1, c1);
        }
        bf16_t* dst = KV + ((size_t)(cgi * 4 + head) * 2 + dir) * 4096;
#pragma unroll
        for (int r = 0; r < 16; ++r) { const int e = 32 * e0 + crow(r, hi); dst[e * 64 + r32] = (bf16_t)f2bf1(c0[r]); dst[e * 64 + 32 + r32] = (bf16_t)f2bf1(c1[r]); }
    }
    __syncthreads();
}
__device__ __forceinline__ void ret_scan(const Args& a, int layer, const int wave0) {
    const int gtid = blockIdx.x * NTHR + (wave0 * 64 + pg8::lane_now()), gthreads = gridDim.x * NTHR;
    bf16_t* KV = (bf16_t*)(a.ws + WS_S + S_KV);
    for (int idx = gtid; idx < 24 * 4 * 2 * 4096; idx += gthreads) {
        const int el = idx & 4095, dir = (idx >> 12) & 1, head = (idx >> 13) & 3, s = idx >> 15;
        const int chunk0 = s < 16 ? 16 * s : 256 + 64 * (s - 16), nc = s < 16 ? 16 : 64;
        const float gch = exp2f(128.0f * ret_lg2(a, layer, dir, head));
        float S = 0.f;
        bf16_t* base = KV + ((size_t)(chunk0 * 4 + head) * 2 + dir) * 4096 + el;
        for (int b = 0; b < nc; b += 16) {
            float tmp[16];
#pragma unroll
            for (int k = 0; k < 16; ++k) { const int n = b + k; const int cn = dir == 0 ? n : nc - 1 - n; tmp[k] = bf2f(base[(size_t)cn * 32768]); }
#pragma unroll
            for (int k = 0; k < 16; ++k) { const int n = b + k; const int cn = dir == 0 ? n : nc - 1 - n; base[(size_t)cn * 32768] = (bf16_t)f2bf1(S); S = gch * S + tmp[k]; }
        }
    }
}
__device__ __forceinline__ void ret_out_item(const Args& a, int layer, int cgi, int hp, unsigned char* lds, const int wave0) {
    const int tid = (wave0 * 64 + pg8::lane_now()), lane = tid & 63, wave = wave0, r32 = lane & 31, hi = lane >> 5;
    bf16_t* P = (bf16_t*)(a.ws + WS_P);
    const bf16_t* KV = (const bf16_t*)(a.ws + WS_S + S_KV);
    constexpr int PK = 72, PT = 136;
    bf16_t* Kr = (bf16_t*)lds;
    bf16_t* Vt = Kr + 2 * 128 * PK;
    bf16_t* St = Vt + 2 * 64 * PT;
#pragma unroll
    for (int i = 0; i < 4; ++i) {
        const int pc = tid + NTHR * i; const int h = pc >> 10, j = (pc >> 3) & 127, ch = pc & 7; const int head = 2 * hp + h;
        const bf16_t* src = P + (size_t)(cgi * 128 + j) * PW + 6 * 256 + head * 64 + ch * 8;
        const u32x4 kr = *(const u32x4*)src, vr = *(const u32x4*)(src + 256);
        *(u32x4*)(Kr + (h * 128 + j) * PK + ch * 8) = kr;
#pragma unroll
        for (int e = 0; e < 8; ++e) Vt[(h * 64 + ch * 8 + e) * PT + j] = u16at(vr, e);
        const int hd = pc >> 9, e_ = (pc >> 3) & 63;
        const int h2 = hd >> 1, dir = hd & 1;
        const u32x4 sr = *(const u32x4*)(KV + ((size_t)(cgi * 4 + 2 * hp + h2) * 2 + dir) * 4096 + e_ * 64 + ch * 8);
        *(u32x4*)(St + (hd * 64 + e_) * PK + ch * 8) = sr;
    }
    const int h = wave >> 2, isub = wave & 3; const int head = 2 * hp + h;
    const int irow = cgi * 128 + isub * 32 + r32;
    bf16_t* qp = P + (size_t)irow * PW + 5 * 256 + head * 64;
    bf16x8 qf[4];
#pragma unroll
    for (int ks = 0; ks < 4; ++ks) qf[ks] = *(const bf16x8*)(qp + 16 * ks + 8 * hi);
    __syncthreads();
    const float lgf = ret_lg2(a, layer, 0, head), lgb = ret_lg2(a, layer, 1, head);
    const int ipos = isub * 32 + r32;
    f32x16 o0 = f32x16{}, o1 = f32x16{};
    const bf16_t* kb = Kr + h * 128 * PK; const bf16_t* vb = Vt + h * 64 * PT;
#pragma nounroll
    for (int jt = 0; jt < 4; ++jt) {
        f32x16 s = f32x16{};
#pragma unroll
        for (int ks = 0; ks < 4; ++ks) s = mfma32(*(const bf16x8*)(kb + (32 * jt + r32) * PK + 16 * ks + 8 * hi), qf[ks], s);
#pragma unroll
        for (int r = 0; r < 16; ++r) { const int j = 32 * jt + crow(r, hi); const int dist = ipos - j;
            const float w = dist >= 0 ? __builtin_amdgcn_exp2f((float)dist * lgf) : __builtin_amdgcn_exp2f((float)(-dist) * lgb); s[r] *= w; }
        const bf16x8 pb0 = pack8r(s, 0), pb1 = pack8r(s, 8);
#pragma unroll
        for (int jj = 0; jj < 2; ++jj) {
            const int j16 = 32 * jt + 16 * jj; const bf16x8 pb = jj ? pb1 : pb0;
            const bf16x8 A0 = mk8(*(const u32x2*)(vb + r32 * PT + j16 + 4 * hi), *(const u32x2*)(vb + r32 * PT + j16 + 8 + 4 * hi));
            const bf16x8 A1 = mk8(*(const u32x2*)(vb + (32 + r32) * PT + j16 + 4 * hi), *(const u32x2*)(vb + (32 + r32) * PT + j16 + 8 + 4 * hi));
            o0 = mfma32(A0, pb, o0); o1 = mfma32(A1, pb, o1);
        }
    }
#pragma nounroll
    for (int dir = 0; dir < 2; ++dir) {
        const bf16_t* sb = St + ((h * 2 + dir) * 64) * PK;
        f32x16 x0 = f32x16{}, x1 = f32x16{};
#pragma unroll
        for (int ks = 0; ks < 4; ++ks) {
            x0 = mfma32(*(const bf16x8*)(sb + r32 * PK + 16 * ks + 8 * hi), qf[ks], x0);
            x1 = mfma32(*(const bf16x8*)(sb + (32 + r32) * PK + 16 * ks + 8 * hi), qf[ks], x1);
        }
        const float wq = dir == 0 ? exp2f((float)(ipos + 1) * lgf) : exp2f((float)(128 - ipos) * lgb);
#pragma unroll
        for (int r = 0; r < 16; ++r) { o0[r] += wq * x0[r]; o1[r] += wq * x1[r]; }
    }
    float ss = 0.f;
#pragma unroll
    for (int r = 0; r < 16; ++r) ss += o0[r] * o0[r] + o1[r] * o1[r];
    ss += pg8::shx(ss, 32);
    const float rn = 1.0f / sqrtf(ss * (1.0f / 64.0f) + EPS);
    const bf16_t* gp = P + (size_t)irow * PW + 8 * 256 + head * 64;
#pragma unroll
    for (int rg = 0; rg < 4; ++rg) {
        const u32x2 g0 = *(const u32x2*)(gp + 8 * rg + 4 * hi), g1 = *(const u32x2*)(gp + 32 + 8 * rg + 4 * hi);
        u32x2 w0, w1;
        w0.x = cvtpk(o0[4 * rg] * rn * bf2f(g0.x & 0xffffu), o0[4 * rg + 1] * rn * bf2f(g0.x >> 16)); w0.y = cvtpk(o0[4 * rg + 2] * rn * bf2f(g0.y & 0xffffu), o0[4 * rg + 3] * rn * bf2f(g0.y >> 16));
        w1.x = cvtpk(o1[4 * rg] * rn * bf2f(g1.x & 0xffffu), o1[4 * rg + 1] * rn * bf2f(g1.x >> 16)); w1.y = cvtpk(o1[4 * rg + 2] * rn * bf2f(g1.y & 0xffffu), o1[4 * rg + 3] * rn * bf2f(g1.y >> 16));
        *(u32x2*)(qp + 8 * rg + 4 * hi) = w0; *(u32x2*)(qp + 32 + 8 * rg + 4 * hi) = w1;
    }
    __syncthreads();
}

__device__ __forceinline__ void sc_rows(const Args& a, int layer, const int wave0) {
    const int gtid = blockIdx.x * NTHR + (wave0 * 64 + pg8::lane_now()), gthreads = gridDim.x * NTHR;
    bf16_t* P = (bf16_t*)(a.ws + WS_P);
    const float* scw = a.in[15] + layer * 3 * 256;
    for (int idx = gtid; idx < T_ALL * 32; idx += gthreads) {
        const int R = idx >> 5, cg8 = idx & 31;
        const int L = R < T_PROMPT ? 2048 : 8192, t = R & (L - 1);
        bf16_t* pr = P + (size_t)R * PW + 9 * 256 + 8 * cg8;
        const u32x4 zz = (u32x4){0u, 0u, 0u, 0u};
        const u32x4 sb = *(const u32x4*)pr;
        const u32x4 cc = *(const u32x4*)(pr + 256), hc = *(const u32x4*)(pr + 512);
        const u32x4 cm = t > 0 ? *(const u32x4*)(pr + 256 - PW) : zz, hm = t > 0 ? *(const u32x4*)(pr + 512 - PW) : zz;
        const u32x4 cp = t < L - 1 ? *(const u32x4*)(pr + 256 + PW) : zz, hp = t < L - 1 ? *(const u32x4*)(pr + 512 + PW) : zz;
        float o[8];
#pragma unroll
        for (int e = 0; e < 8; ++e) { const int lc = pi_slot(8 * cg8 + e);
            const float y = scw[lc] * (bf2f(u16at(cm, e)) * bf2f(u16at(hm, e))) + scw[256 + lc] * (bf2f(u16at(cc, e)) * bf2f(u16at(hc, e))) + scw[512 + lc] * (bf2f(u16at(cp, e)) * bf2f(u16at(hp, e)));
            o[e] = bf2f(u16at(sb, e)) * y; }
        u32x4 w; w.x = cvtpk(o[0], o[1]); w.y = cvtpk(o[2], o[3]); w.z = cvtpk(o[4], o[5]); w.w = cvtpk(o[6], o[7]);
        *(u32x4*)pr = w;
    }
}


#ifndef STOP_AFTER
#define STOP_AFTER 0
#endif
__device__ __forceinline__ void dbg_fold(const Args& a, const bf16_t* src, int ld, int ncol3, const int wave0) {
    const int gtid = blockIdx.x * NTHR + (wave0 * 64 + pg8::lane_now()), gthreads = gridDim.x * NTHR;
    for (int idx = gtid; idx < T_ALL * 1024; idx += gthreads) { const int r = idx >> 10, c = idx & 1023; float v = 0.f;
        for (int k = 0; k < ncol3; ++k) v += bf2f(src[(size_t)r * ld + c + 1024 * k]);
        a.out[idx] = v; }
}

#define GAS __attribute__((address_space(1)))
#define XB_TMO      128
#define XB_XCNT(j)  (256  + 64 * (j))
#define XB_XSUB(j)  (1280 + 64 * (j))
#define XB_XGEN(j)  (2304 + 64 * (j))
#define XB_TOP      3328
#define XB_TOPGEN   3392
#define XCD_BAR_WORDS 3456
#define XB_SPIN_CAP (1u << 18)

__device__ __forceinline__ unsigned xb_ld(unsigned* p)              { return __hip_atomic_load(p, __ATOMIC_RELAXED, __HIP_MEMORY_SCOPE_AGENT); }
__device__ __forceinline__ unsigned xb_add(unsigned* p, unsigned v) { return __hip_atomic_fetch_add(p, v, __ATOMIC_RELAXED, __HIP_MEMORY_SCOPE_AGENT); }
__device__ __forceinline__ unsigned xb_xcc_id() { return (unsigned)__builtin_amdgcn_s_getreg((3 << 11) | 20) & 0xFu; }
#define XB_SPIN(cond, bar) do { unsigned _sp = 0; while (cond) { __builtin_amdgcn_s_sleep(1); \
    if ((++_sp & 255u) == 0u) { if (xb_ld(&(bar)[XB_TMO])) break; if (_sp > XB_SPIN_CAP) { atomicAdd(&(bar)[XB_TMO], 1u); break; } } } } while (0)

struct XcdBarrier {
    unsigned* bar; unsigned x; int w0;
    volatile LAS unsigned* st;
};

__device__ __forceinline__ XcdBarrier xcd_barrier_post(unsigned* bar, volatile LAS unsigned* st, int w0) {
    XcdBarrier b; b.bar = bar; b.x = xb_xcc_id(); b.st = st; b.w0 = w0;
    if (w0 == 0 && pg8::lane_now() == 0) (void)xb_add(&bar[XB_XCNT(b.x)], 1u);
    return b;
}
__device__ __forceinline__ void xcd_barrier_complete(unsigned* bar, unsigned x, unsigned& nloc, unsigned& nx) {
    const unsigned G = gridDim.x * gridDim.y * gridDim.z;
    unsigned sum, cnt, mine, sp = 0u;
    for (;;) {
        sum = 0u; cnt = 0u; mine = 0u;
#pragma unroll
        for (unsigned j = 0; j < 16; ++j) { const unsigned c = xb_ld(&bar[XB_XCNT(j)]); sum += c; cnt += (c > 0u) ? 1u : 0u; mine = (j == x) ? c : mine; }
        if (sum == G) break;
        __builtin_amdgcn_s_sleep(1);
        if ((++sp & 255u) == 0u) { if (xb_ld(&bar[XB_TMO])) break; if (sp > XB_SPIN_CAP) { atomicAdd(&bar[XB_TMO], 1u); break; } }
    }
    nloc = mine > 0u ? mine : 1u; nx = cnt > 0u ? cnt : 1u;
}

__device__ __forceinline__ void xcd_barrier(const XcdBarrier& b) {
    asm volatile("s_waitcnt vmcnt(0)" ::: "memory");
    __syncthreads();
    if (b.w0 == 0 && pg8::lane_now() == 0) {
        unsigned* bar = b.bar;
        __builtin_amdgcn_s_waitcnt(0);
        unsigned nloc = b.st[0], nx = b.st[1];
        if (nloc == 0u) { xcd_barrier_complete(bar, b.x, nloc, nx); b.st[0] = nloc; b.st[1] = nx; }
        const unsigned old = xb_add(&bar[XB_XSUB(b.x)], 1u);
        const unsigned gen = old / nloc;
        if (old + 1u == (gen + 1u) * nloc) {
            __builtin_amdgcn_fence(__ATOMIC_RELEASE, "agent");
            asm volatile("s_waitcnt vmcnt(0)" ::: "memory");
            const unsigned og = xb_add(&bar[XB_TOP], 1u);
            const unsigned tg = og / nx;
            if (og + 1u == (tg + 1u) * nx) xb_add(&bar[XB_TOPGEN], 1u);
            else XB_SPIN(xb_ld(&bar[XB_TOPGEN]) == tg, bar);
            __builtin_amdgcn_fence(__ATOMIC_ACQUIRE, "agent");
            xb_add(&bar[XB_XGEN(b.x)], 1u);
            asm volatile("s_waitcnt vmcnt(0)" ::: "memory");
        } else {
            XB_SPIN(xb_ld(&bar[XB_XGEN(b.x)]) == gen, bar);
            __builtin_amdgcn_fence(__ATOMIC_ACQUIRE, "agent");
            asm volatile("s_waitcnt vmcnt(0)" ::: "memory");
        }
    }
    __syncthreads();
}

template <class Epi>
__device__ __forceinline__ void run_gemm(unsigned char* lds, const bf16_t* A, const bf16_t* Bt, int M, int N, int K, int lda, int ldb, const Epi& E, const int wave0) {
    pg8::Gemm g{A, Bt, M, N, K, lda, ldb}; pg8::StaticOrder S; S.init(M, N, (int)gridDim.x, (int)blockIdx.x);
    pg8::gemm_phase<Epi, pg8::StaticOrder, true, true>((PG8_LAS unsigned char*)lds, g, S, E, wave0);
}

__global__ void __launch_bounds__(NTHR, 2) fwd_megakernel(Args a) {
    extern __shared__ __attribute__((aligned(16))) unsigned char lds[];
    cg::grid_group grid = cg::this_grid();
    const int wave0 = __builtin_amdgcn_readfirstlane((int)threadIdx.x >> 6);
    const int G = gridDim.x, bx = blockIdx.x;
    volatile LAS unsigned* xst = (volatile LAS unsigned*)((LAS unsigned char*)lds + (LDS_BYTES - 64));
    if (wave0 == 0 && pg8::lane_now() == 0) { xst[0] = 0u; xst[1] = 0u; }
    __syncthreads();
    XcdBarrier xbar = xcd_barrier_post((unsigned*)(a.ws + WS_CTL), xst, wave0);
    grid.sync();
    unsigned char* ws = a.ws;
    bf16_t* P = (bf16_t*)(ws + WS_P); bf16_t* XN = (bf16_t*)(ws + WS_XN);
    float* rcos = (float*)(ws + WS_MISC); float* rsin = rcos + 2048;
    bf16_t* YB = (bf16_t*)(ws + WS_S + S_GATE); bf16_t* XN2 = (bf16_t*)(ws + WS_S + 160 * MiB); bf16_t* ACT = (bf16_t*)(ws + WS_S + S_ACT);
    float* MF = (float*)(ws + WS_S + S_MF); bf16_t* MB = (bf16_t*)(ws + WS_S + S_MB);

    for (int layer = 0; layer < 2; ++layer) {
        const float* ng = a.in[2] + layer * 4 * DM;
        if (EN & 1) prep_weights(a, layer, lds, wave0);
        __syncthreads();
        if (layer == 0 && bx == G - 1) rope_table(rcos, rsin, wave0);
        if (EN & 2) for (int it = bx; it < 160; it += G) hy_filter_item(a, layer, it, lds, wave0);
        GSYNC();
        if (EN & 2) for (int it = bx; it < 512; it += G) hy_window_item(a, it, lds, wave0);
        norm_x_rows(a, layer, 0, ng, XN, wave0);
        GSYNC();
        for (int g = 0; g < NGROUP; ++g) {
            bf16_t* xa = (g & 1) ? XN2 : XN; bf16_t* xb = (g & 1) ? XN : XN2;
            pg8::EpiIn E{P, g * GROUP, a.in[4] + layer * 128, rcos, rsin, QSCALE};
            if (EN & 4) run_gemm(lds, xa, (const bf16_t*)(ws + WS_WIN), GROUP, PW, DM, DM, DM, E, wave0);
            if (g + 1 < NGROUP) norm_x_rows(a, layer, g + 1, ng, xb, wave0);
            GSYNC();
        }
        if (STOP_AFTER == 1) { dbg_fold(a, P, PW, 3, wave0); return; }
        if (EN & 8) for (int it = bx; it < 768 * 2; it += G) ret_kv_item(a, layer, it >> 1, it & 1, lds, wave0);
        GSYNC();
        if (EN & 8) ret_scan(a, layer, wave0);
        GSYNC();
        if (EN & 16) for (int it = bx; it < 256; it += G) hyena_item<8>(a, layer, T_PROMPT + (it >> 5) * 8192, it & 31, lds, wave0);
        if (EN & 32) for (int it = bx; it < 512; it += G) hyena_item<2>(a, layer, (it >> 5) * 2048, it & 31, lds, wave0);
        if (EN & 64) for (int it = bx; it < 1024; it += G) { const int pair = it & 15, qb = it >> 4; attn_unit(P, T_PROMPT + (pair >> 1) * 8192, 8192, pair & 1, qb, lds, wave0); }
        if (EN & 64) for (int it = bx; it < 512; it += G) { const int pair = it & 31, qb = it >> 5; attn_unit(P, (pair >> 1) * 2048, 2048, pair & 1, qb, lds, wave0); }
        if (EN & 128) for (int it = bx; it < 768 * 2; it += G) ret_out_item(a, layer, it >> 1, it & 1, lds, wave0);
        if (EN & 256) sc_rows(a, layer, wave0);
        GSYNC();
        if (STOP_AFTER == 2) { dbg_fold(a, P, PW, 3, wave0); return; }
        for (int g = 0; g < NGROUP; ++g) {
            if (g > 0) norm_res_rows(a, MF, g - 1, false, ng + 3 * DM, nullptr, nullptr, wave0);
            norm_x_rows(a, layer, g, ng, XN, wave0);
            { pg8::EpiY E{YB}; run_gemm(lds, P + (size_t)g * GROUP * PW, (const bf16_t*)(ws + WS_WB), GROUP, 4096, 256, PW, 256, E, wave0); }
            GSYNC();
            { pg8::EpiMerge E{YB, MB}; run_gemm(lds, XN, (const bf16_t*)(ws + WS_WG), GROUP, 4096, DM, DM, DM, E, wave0); }
            GSYNC();
            { pg8::EpiF32 E{MF, DM}; run_gemm(lds, MB, (const bf16_t*)(ws + WS_WO), GROUP, DM, DM, DM, DM, E, wave0); }
            GSYNC();
            norm_res_rows(a, MF, g, layer == 0, ng + DM, ng + 2 * DM, XN, wave0);
            GSYNC();
            { pg8::EpiSwiglu E{ACT}; run_gemm(lds, XN, (const bf16_t*)(ws + WS_WFI), GROUP, 2 * DFF, DM, DM, DM, E, wave0); }
            GSYNC();
            { pg8::EpiF32 E{MF, DM}; run_gemm(lds, ACT, (const bf16_t*)(ws + WS_WFO), GROUP, DM, DFF, DFF, DFF, E, wave0); }
            GSYNC();
        }
        norm_res_rows(a, MF, NGROUP - 1, false, ng + 3 * DM, nullptr, nullptr, wave0);
        GSYNC();
    }
}

extern "C" void kernel_launch(void* const* d_in, const int* in_sizes, int n_in, void* d_out, int out_size, void* d_ws, size_t ws_size, hipStream_t stream) {
    static int grid = 0;
    if (grid == 0) {
        if (n_in != 20 || out_size != T_ALL * DM || ws_size < WS_NEED) { fprintf(stderr, "kernel_launch: unexpected shapes: n_in %d out %d ws %zu (need %zu)\n", n_in, out_size, ws_size, (size_t)WS_NEED); grid = -1; return; }
        int dev = 0, cus = 0, per_cu = 0;
        hipGetDevice(&dev); hipDeviceGetAttribute(&cus, hipDeviceAttributeMultiprocessorCount, dev);
        hipFuncSetAttribute((const void*)fwd_megakernel, hipFuncAttributeMaxDynamicSharedMemorySize, LDS_BYTES);
        hipOccupancyMaxActiveBlocksPerMultiprocessor(&per_cu, (const void*)fwd_megakernel, NTHR, LDS_BYTES);
        (void)hipGetLastError();
        if (per_cu < 1) per_cu = 1;
        grid = cus * 1;
        fprintf(stderr, "kernel_launch: cus %d per_cu %d grid %d\n", cus, per_cu, grid);
    }
    if (grid < 0) return;
    Args a{};
    for (int i = 0; i < 20; ++i) a.in[i] = (const float*)d_in[i];
    a.out = (float*)d_out; a.ws = (unsigned char*)d_ws;
    if (hipMemsetAsync((char*)d_ws + WS_CTL, 0, CTL_BYTES, stream) != hipSuccess) { fprintf(stderr, "memset failed\n"); return; }
    void* args[] = {&a};
    hipError_t e = hipLaunchCooperativeKernel((const void*)fwd_megakernel, dim3(grid), dim3(NTHR), args, LDS_BYTES, stream);
    if (e != hipSuccess) fprintf(stderr, "cooperative launch failed: %s (grid %d)\n", hipGetErrorString(e), grid);
}
```

```cpp
#include <hip/hip_runtime.h>
#include <hip/hip_cooperative_groups.h>
#include <cstdio>
#include <cstdint>
namespace pg8 {
#define PG8_LAS __attribute__((address_space(3)))
typedef unsigned short bf16_t;
typedef short bf16x8 __attribute__((ext_vector_type(8)));
typedef float f32x4 __attribute__((ext_vector_type(4)));
typedef unsigned u32x4 __attribute__((ext_vector_type(4)));
__device__ __forceinline__ int opq(int x) { asm volatile("" : "+v"(x)); return x; }
__device__ __forceinline__ int lane_now() { int l; asm volatile("v_mbcnt_lo_u32_b32 %0, -1, 0\n\tv_mbcnt_hi_u32_b32 %0, -1, %0" : "=v"(l)); return l; }
__device__ __forceinline__ float shx(float v, int o) { return __builtin_bit_cast(float, __builtin_amdgcn_ds_bpermute((lane_now() ^ o) << 2, __builtin_bit_cast(int, v))); }
constexpr int BM = 256, BK = 64, HALF = 128, HTB = HALF * BK * 2  , STAGE_BYTES = 8 * HTB, NXCD = 8, WGM = 8;

__host__ __device__ __forceinline__ int lds_byte(int r, int c) { const int st = (r >> 4) * 2 + (c >> 5), rr = r & 15, cc = c & 31, ob = rr * 64 + cc * 2; return st * 1024 + (ob ^ (((ob >> 9) & 1) << 5)); }
__host__ __device__ __forceinline__ void stage_rc(int b, int& R, int& C) { const int st = b / 1024, sb = b % 1024, swz = sb ^ (((sb >> 9) & 1) << 5); R = (st >> 1) * 16 + swz / 64; C = (st & 1) * 32 + (swz % 64) / 2; }
__host__ __device__ __forceinline__ int perm32(int rho) { const int n = rho >> 4, i = rho & 15; return 8 * (i >> 2) + 4 * n + (i & 3); }

struct Unit { int pm, pn; };
struct Gemm { const bf16_t* A; const bf16_t* Bt; int M, N, K, lda, ldb; };

struct StaticOrder {
    int nM, nN, nwg, G, c;
    __host__ __device__ void init(int M, int N, int G_, int c_) { nM = M / BM; nN = N / BM; nwg = nM * nN; G = G_; c = c_; }
    __host__ __device__ bool next(int i, Unit& u) const {
        const long L = (long)i * G + c; if (L >= nwg) return false;
        int wgid = (int)L; { const int q = nwg / NXCD, r = nwg % NXCD, xcd = wgid % NXCD, off = wgid / NXCD; wgid = (xcd < r ? xcd * (q + 1) : r * (q + 1) + (xcd - r) * q) + off; }
        const int nig = WGM * nN, gid = wgid / nig, fm = gid * WGM, gsz = (nM - fm) < WGM ? (nM - fm) : WGM;
        u.pm = fm + ((wgid % nig) % gsz); u.pn = (wgid % nig) / gsz; return true;
    }
    __device__ __forceinline__ void a_ready(const Unit&) const {}
    __device__ __forceinline__ void done(const Unit&) const {}
};

typedef float f32x2 __attribute__((ext_vector_type(2)));
typedef __bf16 bf16x2_t __attribute__((ext_vector_type(2)));
__device__ __forceinline__ unsigned cvt_pk_bf16(float lo, float hi) { f32x2 v = {lo, hi}; bf16x2_t b = __builtin_convertvector(v, bf16x2_t); return __builtin_bit_cast(unsigned, b); }
typedef float f32x16 __attribute__((ext_vector_type(16)));
__device__ __forceinline__ f32x4 ldg4(const float* p) { return *(const f32x4*)p; }
__device__ __forceinline__ u32x4 pack8(const f32x4 a, const f32x4 b) { u32x4 w; w.x = cvt_pk_bf16(a[0], a[1]); w.y = cvt_pk_bf16(a[2], a[3]); w.z = cvt_pk_bf16(b[0], b[1]); w.w = cvt_pk_bf16(b[2], b[3]); return w; }
__device__ __forceinline__ float bf2f(unsigned h) { return __uint_as_float(h << 16); }
__device__ __forceinline__ f32x4 unpack_lo(const u32x4 w) { return (f32x4){__uint_as_float(w.x << 16), __uint_as_float(w.x & 0xffff0000u), __uint_as_float(w.y << 16), __uint_as_float(w.y & 0xffff0000u)}; }
__device__ __forceinline__ f32x4 unpack_hi(const u32x4 w) { return (f32x4){__uint_as_float(w.z << 16), __uint_as_float(w.z & 0xffff0000u), __uint_as_float(w.w << 16), __uint_as_float(w.w & 0xffff0000u)}; }
__device__ __forceinline__ int branch_tile(int n) { return n == 0 ? 0 : (n == 1 ? 3 : (n == 2 ? 5 : 9)); }
__device__ __forceinline__ float sigm(float v) { return 1.0f / (1.0f + __expf(-v)); }

struct EpiIn {
    static constexpr bool PERM = true, AFTER_DRAIN = false, BRANCH_A = false;
    bf16_t* P; int row_base; const float* qkn; const float* rcos; const float* rsin; float qscale;
    __device__ __forceinline__ void operator()(const f32x4 (&acc)[2][2][4][2], const Unit& u, int wr, int wc, int fr_, int fq_) const {
        const int ln_ = lane_now(); const int fr = ln_ & 15, fq = ln_ >> 4; (void)fr_; (void)fq_;
        const int pn = u.pn;
        const bool is_k = (pn == 1 && wc < 2);
        const bool do_norm = (pn == 0) || is_k;
        const bool do_rope = do_norm || pn == 5 || pn == 6;
        const float scale = (pn == 0) ? qscale : (pn == 6 ? 0.125f : 1.0f);
        const bool do_silu = (pn == 8);
        const float* gp = qkn + (is_k ? 64 : 0) + 4 * fq;
#pragma unroll
        for (int ai = 0; ai < 2; ++ai)
#pragma unroll
            for (int m = 0; m < 4; ++m) {
                const int row = row_base + u.pm * BM + ai * HALF + wr * 64 + m * 16 + fr;
                f32x4 v[2][2];
#pragma unroll
                for (int bj = 0; bj < 2; ++bj)
#pragma unroll
                    for (int n = 0; n < 2; ++n) v[bj][n] = acc[ai][bj][m][n];
                if (do_norm) {
                    float ss = 0.f;
#pragma unroll
                    for (int bj = 0; bj < 2; ++bj)
#pragma unroll
                        for (int n = 0; n < 2; ++n) ss += (v[bj][n][0] * v[bj][n][0] + v[bj][n][1] * v[bj][n][1]) + (v[bj][n][2] * v[bj][n][2] + v[bj][n][3] * v[bj][n][3]);
                    ss += shx(ss, 16); ss += shx(ss, 32);
                    const float rn = 1.0f / sqrtf(ss * (1.0f / 64.0f) + 1e-6f);
#pragma unroll
                    for (int bj = 0; bj < 2; ++bj)
#pragma unroll
                        for (int n = 0; n < 2; ++n) v[bj][n] = v[bj][n] * rn * ldg4(gp + 32 * bj + 16 * n);
                }
                if (do_rope) {
                    const int L = row < 32768 ? 2048 : 8192; const int t = row & (L - 1);
#pragma unroll
                    for (int bj = 0; bj < 2; ++bj) {
                        const int pos = bj == 0 ? (t >> 6) : (t & 63);
                        const f32x4 c = ldg4(rcos + pos * 16 + 4 * fq), s = ldg4(rsin + pos * 16 + 4 * fq);
                        const f32x4 a = v[bj][0], b = v[bj][1];
                        v[bj][0] = a * c - b * s; v[bj][1] = b * c + a * s;
                    }
                }
#pragma unroll
                for (int bj = 0; bj < 2; ++bj) {
                    f32x4 x0 = v[bj][0] * scale, x1 = v[bj][1] * scale;
                    if (do_silu) {
#pragma unroll
                        for (int i = 0; i < 4; ++i) { x0[i] = x0[i] * sigm(x0[i]); x1[i] = x1[i] * sigm(x1[i]); }
                    }
                    *(u32x4*)(P + ((unsigned)row * 3072u + (unsigned)(pn * 256 + 64 * wc + 32 * bj + 8 * fq))) = pack8(x0, x1);
                }
                asm volatile("" ::: "memory");
            }
    }
};
struct EpiGate {
    static constexpr bool PERM = true, AFTER_DRAIN = false, BRANCH_A = false;
    bf16_t* O; int ldc;
    __device__ __forceinline__ void operator()(const f32x4 (&acc)[2][2][4][2], const Unit& u, int wr, int wc, int fr_, int fq_) const {
        const int ln_ = lane_now(); const int fr = ln_ & 15, fq = ln_ >> 4; (void)fr_; (void)fq_;
#pragma unroll
        for (int ai = 0; ai < 2; ++ai)
#pragma unroll
            for (int m = 0; m < 4; ++m) {
                const int row = u.pm * BM + ai * HALF + wr * 64 + m * 16 + fr;
#pragma unroll
                for (int bj = 0; bj < 2; ++bj) {
                    f32x4 x0 = acc[ai][bj][m][0], x1 = acc[ai][bj][m][1];
#pragma unroll
                    for (int i = 0; i < 4; ++i) { x0[i] = sigm(x0[i]); x1[i] = sigm(x1[i]); }
                    *(u32x4*)(O + ((unsigned)row * (unsigned)ldc + (unsigned)(u.pn * BM + bj * HALF + wc * 32 + 8 * fq))) = pack8(x0, x1);
                }
            }
    }
};
struct EpiBranch {
    static constexpr bool PERM = true, AFTER_DRAIN = false, BRANCH_A = false;
    const bf16_t* G; float* MF; bf16_t* MB; int nbr;
    __device__ __forceinline__ void operator()(const f32x4 (&acc)[2][2][4][2], const Unit& u, int wr, int wc, int fr_, int fq_) const {
        const int ln_ = lane_now(); const int fr = ln_ & 15, fq = ln_ >> 4; (void)fr_; (void)fq_;
#pragma unroll
        for (int ai = 0; ai < 2; ++ai)
#pragma unroll
            for (int m = 0; m < 4; ++m) {
                const int row = u.pm * BM + ai * HALF + wr * 64 + m * 16 + fr;
#pragma unroll
                for (int bj = 0; bj < 2; ++bj) {
                    const int col = u.pn * BM + bj * HALF + wc * 32 + 8 * fq;
                    const u32x4 gw = *(const u32x4*)(G + ((unsigned)row * 4096u + (unsigned)(nbr * 1024 + col)));
                    f32x4 x0 = acc[ai][bj][m][0] * unpack_lo(gw), x1 = acc[ai][bj][m][1] * unpack_hi(gw);
                    float* mp = MF + ((unsigned)row * 1024u + (unsigned)col);
                    if (nbr != 0) { x0 = x0 + ldg4(mp); x1 = x1 + ldg4(mp + 4); }
                    if (nbr == 3) *(u32x4*)(MB + ((unsigned)row * 1024u + (unsigned)col)) = pack8(x0, x1);
                    else { *(f32x4*)mp = x0; *(f32x4*)(mp + 4) = x1; }
                    asm volatile("" ::: "memory");
                }
            }
    }
};
struct EpiF32 {
    static constexpr bool PERM = true, AFTER_DRAIN = false, BRANCH_A = false;
    float* O; int ldc;
    __device__ __forceinline__ void operator()(const f32x4 (&acc)[2][2][4][2], const Unit& u, int wr, int wc, int fr_, int fq_) const {
        const int ln_ = lane_now(); const int fr = ln_ & 15, fq = ln_ >> 4; (void)fr_; (void)fq_;
#pragma unroll
        for (int ai = 0; ai < 2; ++ai)
#pragma unroll
            for (int m = 0; m < 4; ++m) {
                const int row = u.pm * BM + ai * HALF + wr * 64 + m * 16 + fr;
#pragma unroll
                for (int bj = 0; bj < 2; ++bj) {
                    float* op = O + ((unsigned)row * (unsigned)ldc + (unsigned)(u.pn * BM + bj * HALF + wc * 32 + 8 * fq));
                    *(f32x4*)op = acc[ai][bj][m][0]; *(f32x4*)(op + 4) = acc[ai][bj][m][1];
                }
            }
    }
};
struct EpiSwiglu {
    static constexpr bool PERM = true, AFTER_DRAIN = false, BRANCH_A = false;
    bf16_t* O;
    __device__ __forceinline__ void operator()(const f32x4 (&acc)[2][2][4][2], const Unit& u, int wr, int wc, int fr_, int fq_) const {
        const int ln_ = lane_now(); const int fr = ln_ & 15, fq = ln_ >> 4; (void)fr_; (void)fq_;
#pragma unroll
        for (int ai = 0; ai < 2; ++ai)
#pragma unroll
            for (int m = 0; m < 4; ++m) {
                const int row = u.pm * BM + ai * HALF + wr * 64 + m * 16 + fr;
                f32x4 x0 = acc[ai][0][m][0], x1 = acc[ai][0][m][1];
                const f32x4 u0 = acc[ai][1][m][0], u1 = acc[ai][1][m][1];
#pragma unroll
                for (int i = 0; i < 4; ++i) { x0[i] = x0[i] * sigm(x0[i]) * u0[i]; x1[i] = x1[i] * sigm(x1[i]) * u1[i]; }
                *(u32x4*)(O + ((unsigned)row * 2816u + (unsigned)(u.pn * HALF + wc * 32 + 8 * fq))) = pack8(x0, x1);
            }
    }
};

struct EpiY {
    static constexpr bool PERM = true, AFTER_DRAIN = false, BRANCH_A = true;
    bf16_t* Y;
    __device__ __forceinline__ void operator()(const f32x4 (&acc)[2][2][4][2], const Unit& u, int wr, int wc, int fr_, int fq_) const {
        const int ln_ = lane_now(); const int fr = ln_ & 15, fq = ln_ >> 4; (void)fr_; (void)fq_;
        const int br = u.pn >> 2, ct = u.pn & 3;
#pragma unroll
        for (int ai = 0; ai < 2; ++ai)
#pragma unroll
            for (int m = 0; m < 4; ++m) {
                const int row = u.pm * BM + ai * HALF + wr * 64 + m * 16 + fr;
#pragma unroll
                for (int bj = 0; bj < 2; ++bj) {
                    const int ch0 = 256 * ct + 128 * bj + 32 * wc + 8 * fq;
                    *(u32x4*)(Y + ((unsigned)row * 4096u + (unsigned)(br * 1024 + ch0))) = pack8(acc[ai][bj][m][0], acc[ai][bj][m][1]);
                }
            }
    }
};
struct EpiMerge {
    static constexpr bool PERM = true, AFTER_DRAIN = false, BRANCH_A = false;
    const bf16_t* Y; bf16_t* MB;
    __device__ __forceinline__ void operator()(const f32x4 (&acc)[2][2][4][2], const Unit& u, int wr, int wc, int fr_, int fq_) const {
        const int ln_ = lane_now(); const int fr = ln_ & 15, fq = ln_ >> 4; (void)fr_; (void)fq_;
        const int ch0 = 64 * u.pn + 16 * wc + 4 * fq;
#pragma unroll
        for (int ai = 0; ai < 2; ++ai)
#pragma unroll
            for (int m = 0; m < 4; ++m) {
                const int row = u.pm * BM + ai * HALF + wr * 64 + m * 16 + fr;
                typedef unsigned u32x2_t __attribute__((ext_vector_type(2)));
                const bf16_t* yp = Y + ((unsigned)row * 4096u + (unsigned)ch0);
                const u32x2_t ya = *(const u32x2_t*)yp, yb = *(const u32x2_t*)(yp + 1024), yc = *(const u32x2_t*)(yp + 2048), yd = *(const u32x2_t*)(yp + 3072);
                const u32x4 yab = (u32x4){ya.x, ya.y, yb.x, yb.y}, ycd = (u32x4){yc.x, yc.y, yd.x, yd.y};
                const f32x4 y0 = unpack_lo(yab), y1 = unpack_hi(yab), y2 = unpack_lo(ycd), y3 = unpack_hi(ycd);
                f32x4 o;
#pragma unroll
                for (int i = 0; i < 4; ++i) o[i] = sigm(acc[ai][0][m][0][i]) * y0[i] + sigm(acc[ai][0][m][1][i]) * y1[i] + sigm(acc[ai][1][m][0][i]) * y2[i] + sigm(acc[ai][1][m][1][i]) * y3[i];
                u32x2_t w; w.x = cvt_pk_bf16(o[0], o[1]); w.y = cvt_pk_bf16(o[2], o[3]);
                *(u32x2_t*)(MB + ((unsigned)row * 1024u + (unsigned)ch0)) = w;
                asm volatile("" ::: "memory");
            }
    }
};

struct RmsStats {
    float* xbuf;
    unsigned* cnt;
    unsigned want;
    __device__ __forceinline__ void run(const f32x4 (&v)[2][2][4][2], const Unit& u, int wr, int wc, PG8_LAS unsigned char* lds, int wid) const {
        const int lane = lane_now(), fr = lane & 15, fq = lane >> 4;
        PG8_LAS float* Pp = (PG8_LAS float*)lds; PG8_LAS float* S = (PG8_LAS float*)(lds + 4096);
#pragma unroll
        for (int ai = 0; ai < 2; ++ai)
#pragma unroll
            for (int m = 0; m < 4; ++m) {
                float s = 0.f;
#pragma unroll
                for (int bj = 0; bj < 2; ++bj)
#pragma unroll
                    for (int n = 0; n < 2; ++n) { const f32x4 x = v[ai][bj][m][n]; s += (x[0] * x[0] + x[1] * x[1]) + (x[2] * x[2] + x[3] * x[3]); }
                s += shx(s, 16); s += shx(s, 32);
                if (fq == 0) Pp[(ai * HALF + wr * 64 + m * 16 + fr) * 4 + wc] = s;
            }
        asm volatile("s_waitcnt lgkmcnt(0)" ::: "memory"); __builtin_amdgcn_s_barrier(); asm volatile("" ::: "memory");
        const int row = wid * 64 + lane;
        if (wid < 4) {
            const float t = (Pp[row * 4 + 0] + Pp[row * 4 + 1]) + (Pp[row * 4 + 2] + Pp[row * 4 + 3]);
            __hip_atomic_store(xbuf + ((size_t)(u.pm * BM + row) * 4 + u.pn), t, __ATOMIC_RELAXED, __HIP_MEMORY_SCOPE_AGENT);
            asm volatile("s_waitcnt vmcnt(0)" ::: "memory");
            if (lane == 0) __hip_atomic_fetch_add(cnt + 64 * u.pm, 1u, __ATOMIC_RELAXED, __HIP_MEMORY_SCOPE_AGENT);
        }
        if (wid == 0) {
            unsigned sp = 0;
            while ((unsigned)__builtin_amdgcn_readfirstlane(__hip_atomic_load(cnt + 64 * u.pm, __ATOMIC_RELAXED, __HIP_MEMORY_SCOPE_AGENT)) < want) { __builtin_amdgcn_s_sleep(2); if (++sp > (1u << 22)) break; }
            __builtin_amdgcn_fence(__ATOMIC_ACQUIRE, "agent");
        }
        asm volatile("s_waitcnt vmcnt(0) lgkmcnt(0)" ::: "memory"); __builtin_amdgcn_s_barrier(); asm volatile("" ::: "memory");
        if (wid < 4) {
            const float* sl = xbuf + (size_t)(u.pm * BM + row) * 4; float t = 0.f;
#pragma unroll
            for (int k = 0; k < 4; ++k) t += __hip_atomic_load(sl + k, __ATOMIC_RELAXED, __HIP_MEMORY_SCOPE_AGENT);
            S[row] = 1.0f / sqrtf(t * (1.0f / 1024.0f) + 1e-6f);
        }
        asm volatile("s_waitcnt lgkmcnt(0)" ::: "memory"); __builtin_amdgcn_s_barrier(); asm volatile("" ::: "memory");
    }
};
struct EpiRmsRes {
    static constexpr bool PERM = true, AFTER_DRAIN = true, BRANCH_A = false;
    const float* base; float* out; const float* gain; RmsStats st;
    __device__ __forceinline__ void fused(f32x4 (&acc)[2][2][4][2], const Unit& u, int wr, int wc, int fr_, int fq_, PG8_LAS unsigned char* lds, int wid, int lane_) const {
        (void)fr_; (void)fq_; (void)lane_;
        st.run(acc, u, wr, wc, lds, wid);
        const int lane = lane_now(), fr = lane & 15, fq = lane >> 4;
        const PG8_LAS float* S = (const PG8_LAS float*)(lds + 4096);
#pragma unroll
        for (int ai = 0; ai < 2; ++ai)
#pragma unroll
            for (int m = 0; m < 4; ++m) {
                const int r = ai * HALF + wr * 64 + m * 16 + fr; const float rs = S[r];
#pragma unroll
                for (int bj = 0; bj < 2; ++bj) {
                    const int col = u.pn * BM + bj * HALF + wc * 32 + 8 * fq;
                    const unsigned off = (unsigned)(u.pm * BM + r) * 1024u + (unsigned)col;
                    const f32x4 g0 = ldg4(gain + col), g1 = ldg4(gain + col + 4);
                    const f32x4 b0 = ldg4(base + off), b1 = ldg4(base + off + 4);
                    *(f32x4*)(out + off) = b0 + acc[ai][bj][m][0] * rs * g0; *(f32x4*)(out + off + 4) = b1 + acc[ai][bj][m][1] * rs * g1;
                }
                asm volatile("" ::: "memory");
            }
    }
};
struct EpiRmsResRms {
    static constexpr bool PERM = true, AFTER_DRAIN = true, BRANCH_A = false;
    const float* base; float* out; bf16_t* XN; const float* gain; const float* gain2; RmsStats st1, st2;
    __device__ __forceinline__ void fused(f32x4 (&acc)[2][2][4][2], const Unit& u, int wr, int wc, int fr_, int fq_, PG8_LAS unsigned char* lds, int wid, int lane_) const {
        (void)fr_; (void)fq_; (void)lane_;
        st1.run(acc, u, wr, wc, lds, wid);
        const PG8_LAS float* S = (const PG8_LAS float*)(lds + 4096);
        {
            const int lane = lane_now(), fr = lane & 15, fq = lane >> 4;
#pragma unroll
            for (int ai = 0; ai < 2; ++ai)
#pragma unroll
                for (int m = 0; m < 4; ++m) {
                    const int r = ai * HALF + wr * 64 + m * 16 + fr; const float rs = S[r];
#pragma unroll
                    for (int bj = 0; bj < 2; ++bj) {
                        const int col = u.pn * BM + bj * HALF + wc * 32 + 8 * fq;
                        const unsigned off = (unsigned)(u.pm * BM + r) * 1024u + (unsigned)col;
                        const f32x4 g0 = ldg4(gain + col), g1 = ldg4(gain + col + 4);
                        const f32x4 b0 = ldg4(base + off), b1 = ldg4(base + off + 4);
                        acc[ai][bj][m][0] = b0 + acc[ai][bj][m][0] * rs * g0; acc[ai][bj][m][1] = b1 + acc[ai][bj][m][1] * rs * g1;
                        *(f32x4*)(out + off) = acc[ai][bj][m][0]; *(f32x4*)(out + off + 4) = acc[ai][bj][m][1];
                    }
                    asm volatile("" : "+v"(acc[ai][0][m][0]), "+v"(acc[ai][0][m][1]), "+v"(acc[ai][1][m][0]), "+v"(acc[ai][1][m][1]));
                    asm volatile("" ::: "memory");
                }
        }
        st2.run(acc, u, wr, wc, lds, wid);
        {
            const int lane = lane_now(), fr = lane & 15, fq = lane >> 4;
#pragma unroll
            for (int ai = 0; ai < 2; ++ai)
#pragma unroll
                for (int m = 0; m < 4; ++m) {
                    const int r = ai * HALF + wr * 64 + m * 16 + fr; const float rs = S[r];
#pragma unroll
                    for (int bj = 0; bj < 2; ++bj) {
                        const int col = u.pn * BM + bj * HALF + wc * 32 + 8 * fq;
                        const unsigned off = (unsigned)(u.pm * BM + r) * 1024u + (unsigned)col;
                        const f32x4 g0 = ldg4(gain2 + col), g1 = ldg4(gain2 + col + 4);
                        *(u32x4*)(XN + off) = pack8(acc[ai][bj][m][0] * rs * g0, acc[ai][bj][m][1] * rs * g1);
                    }
                    asm volatile("" ::: "memory");
                }
        }
    }
};
template <class Epi, class Sched, bool ALIGN_EPI = false, bool SP2 = false>
__device__ __forceinline__ void gemm_phase(PG8_LAS unsigned char* lds, const Gemm g, const Sched& S, const Epi& E, const int wave0) {
    const int tid = wave0 * 64 + lane_now(), wid = wave0, lane = tid & 63, wr = wid >> 2, wc = wid & 3, fr = lane & 15, fq = lane >> 4;
    const int K = g.K, nt = K / BK, lda = g.lda, ldb = g.ldb;
    unsigned voffA[2], voffB[2];
#pragma unroll
    for (int i = 0; i < 2; ++i) { int R, C; stage_rc(tid * 16 + i * 8192, R, C); const int Rb = Epi::PERM ? ((R & ~31) + perm32(R & 31)) : R;
        voffA[i] = (unsigned)(R * lda + C) * 2u; voffB[i] = (unsigned)(Rb * ldb + C) * 2u; }
    const size_t kstep = (size_t)(BK * 2);
    const size_t hstepA = (size_t)HALF * lda * 2, hstepB = (size_t)HALF * ldb * 2;
    const size_t tstepA = 2 * hstepA, tstepB = 2 * hstepB;
    const unsigned ldsw = (unsigned)wid * 1024u;
    const int aoff = lds_byte(wr * 64 + fr, fq * 8), boff = lds_byte(wc * 32 + fr, fq * 8);
#define PG8_SA(b, h) (((b) * 2 + (h)) * HTB)
#define PG8_SB(b, h) ((4 + (b) * 2 + (h)) * HTB)
#define PG8_STAGE(bufoff, gbase, voff) do { _Pragma("unroll") for (int _i = 0; _i < 2; ++_i) \
        __builtin_amdgcn_global_load_lds((const unsigned*)((const char*)(gbase) + (voff)[_i]), (PG8_LAS unsigned*)(lds + (bufoff) + ldsw + _i * 8192), 16, 0, 0); } while (0)
#define PG8_LDA(dst, b, h) do { _Pragma("unroll") for (int m = 0; m < 4; ++m) _Pragma("unroll") for (int k = 0; k < 2; ++k) dst[m][k] = *(const PG8_LAS bf16x8*)(lds + PG8_SA(b, h) + aoff + m * 2048 + k * 1024); } while (0)
#define PG8_LDB(dst, b, h) do { _Pragma("unroll") for (int n = 0; n < 2; ++n) _Pragma("unroll") for (int k = 0; k < 2; ++k) dst[n][k] = *(const PG8_LAS bf16x8*)(lds + PG8_SB(b, h) + boff + n * 2048 + k * 1024); } while (0)
#define PG8_MMA(ai, bj, At, Bt) do { __builtin_amdgcn_s_setprio(1); _Pragma("unroll") for (int m = 0; m < 4; ++m) _Pragma("unroll") for (int n = 0; n < 2; ++n) _Pragma("unroll") for (int k = 0; k < 2; ++k) \
        acc[ai][bj][m][n] = __builtin_amdgcn_mfma_f32_16x16x32_bf16(Bt[n][k], At[m][k], acc[ai][bj][m][n], 0, 0, 0); __builtin_amdgcn_s_setprio(0); } while (0)
#define PG8_WAIT_V(n) asm volatile("s_waitcnt vmcnt(" #n ")" ::: "memory")
#define PG8_WAIT_L(n) asm volatile("s_waitcnt lgkmcnt(" #n ")" ::: "memory")
#define PG8_BAR __builtin_amdgcn_s_barrier()
#define PG8_SCHED __builtin_amdgcn_sched_barrier(0)
    Unit cur, nxt; int ui = 0;
    if (!S.next(0, cur)) return;
    f32x4 acc[2][2][4][2];
#pragma unroll
    for (int a = 0; a < 2; ++a)
#pragma unroll
        for (int b = 0; b < 2; ++b)
#pragma unroll
            for (int m = 0; m < 4; ++m)
#pragma unroll
                for (int n = 0; n < 2; ++n) acc[a][b][m][n] = (f32x4){0.f, 0.f, 0.f, 0.f};
    bf16x8 At[4][2], B0[2][2], B1[2][2];
    const char* cA = (const char*)g.A + (size_t)cur.pm * tstepA + (Epi::BRANCH_A ? (size_t)branch_tile(cur.pn >> 2) * 512 : (size_t)0); const char* cB = (const char*)g.Bt + (size_t)cur.pn * tstepB;
    S.a_ready(cur);
    if constexpr (SP2) {
        PG8_STAGE(PG8_SB(0, 0), cB, voffB); PG8_STAGE(PG8_SB(0, 1), cB + hstepB, voffB); PG8_STAGE(PG8_SA(0, 0), cA, voffA); PG8_STAGE(PG8_SA(0, 1), cA + hstepA, voffA);
        if (wr == 1) PG8_BAR;
        PG8_WAIT_V(2); PG8_BAR;
        PG8_STAGE(PG8_SB(1, 0), cB + kstep, voffB); PG8_STAGE(PG8_SA(1, 0), cA + kstep, voffA); PG8_STAGE(PG8_SB(1, 1), cB + hstepB + kstep, voffB);
        PG8_WAIT_V(6); PG8_BAR;
    } else {
        PG8_STAGE(PG8_SB(0, 0), cB, voffB); PG8_STAGE(PG8_SA(0, 0), cA, voffA); PG8_STAGE(PG8_SB(0, 1), cB + hstepB, voffB); PG8_STAGE(PG8_SA(0, 1), cA + hstepA, voffA);
        if (wr == 1) PG8_BAR;
        PG8_WAIT_V(4); PG8_BAR;
        PG8_STAGE(PG8_SB(1, 0), cB + kstep, voffB); PG8_STAGE(PG8_SA(1, 0), cA + kstep, voffA); PG8_STAGE(PG8_SB(1, 1), cB + hstepB + kstep, voffB);
        PG8_WAIT_V(6); PG8_BAR;
    }
    for (;;) {
        const bool has_next = S.next(ui + 1, nxt);
        const char* nA = has_next ? (const char*)g.A + (size_t)nxt.pm * tstepA + (Epi::BRANCH_A ? (size_t)branch_tile(nxt.pn >> 2) * 512 : (size_t)0) : cA; const char* nB = has_next ? (const char*)g.Bt + (size_t)nxt.pn * tstepB : cB;
        for (int t = 0; t < nt; t += 2) {
            const bool last = (t == nt - 2);
            const char* a1 = cA + (size_t)(t + 1) * kstep;
            const char* a2 = last ? nA : cA + (size_t)(t + 2) * kstep; const char* b2 = last ? nB : cB + (size_t)(t + 2) * kstep;
            const char* a3 = a2 + kstep; const char* b3 = b2 + kstep;
            if (last && has_next) S.a_ready(nxt);
            if constexpr (SP2) {
            PG8_LDB(B0, 0, 0); PG8_LDB(B1, 0, 1); PG8_SCHED; PG8_LDA(At, 0, 0); PG8_STAGE(PG8_SA(1, 1), a1 + hstepA, voffA);
            PG8_WAIT_V(8); PG8_WAIT_L(0); PG8_BAR; PG8_MMA(0, 0, At, B0); PG8_MMA(0, 1, At, B1); PG8_BAR; PG8_SCHED;
            PG8_LDA(At, 0, 1); PG8_STAGE(PG8_SB(0, 0), b2, voffB); PG8_STAGE(PG8_SB(0, 1), b2 + hstepB, voffB); PG8_STAGE(PG8_SA(0, 0), a2, voffA);
            PG8_WAIT_V(8); PG8_WAIT_L(0); PG8_BAR; PG8_MMA(1, 0, At, B0); PG8_MMA(1, 1, At, B1); PG8_BAR; PG8_SCHED;
            PG8_LDB(B0, 1, 0); PG8_LDB(B1, 1, 1); PG8_SCHED; PG8_LDA(At, 1, 0); PG8_STAGE(PG8_SA(0, 1), a2 + hstepA, voffA);
            PG8_WAIT_V(8); PG8_WAIT_L(0); PG8_BAR; PG8_MMA(0, 0, At, B0); PG8_MMA(0, 1, At, B1); PG8_BAR; PG8_SCHED;
            PG8_LDA(At, 1, 1); PG8_STAGE(PG8_SB(1, 0), b3, voffB); PG8_STAGE(PG8_SB(1, 1), b3 + hstepB, voffB); PG8_STAGE(PG8_SA(1, 0), a3, voffA);
            PG8_WAIT_V(8); PG8_WAIT_L(0); PG8_BAR; PG8_MMA(1, 0, At, B0); PG8_MMA(1, 1, At, B1); PG8_BAR; PG8_SCHED;
            } else {
            PG8_LDB(B0, 0, 0); PG8_SCHED; PG8_LDA(At, 0, 0); PG8_STAGE(PG8_SA(1, 1), a1 + hstepA, voffA);
            PG8_WAIT_L(8); PG8_BAR; PG8_WAIT_L(0); PG8_MMA(0, 0, At, B0); PG8_BAR; PG8_SCHED;
            PG8_LDB(B1, 0, 1); PG8_STAGE(PG8_SB(0, 0), b2, voffB);
            PG8_BAR; PG8_WAIT_L(0); PG8_MMA(0, 1, At, B1); PG8_BAR;
            PG8_LDA(At, 0, 1); PG8_STAGE(PG8_SA(0, 0), a2, voffA);
            PG8_BAR; PG8_WAIT_L(0); PG8_MMA(1, 0, At, B0); PG8_BAR; PG8_SCHED;
            PG8_STAGE(PG8_SB(0, 1), b2 + hstepB, voffB);
            PG8_WAIT_V(6); PG8_BAR; PG8_MMA(1, 1, At, B1); PG8_BAR;
            PG8_LDB(B0, 1, 0); PG8_SCHED; PG8_LDA(At, 1, 0); PG8_STAGE(PG8_SA(0, 1), a2 + hstepA, voffA);
            PG8_WAIT_L(8); PG8_BAR; PG8_WAIT_L(0); PG8_MMA(0, 0, At, B0); PG8_BAR; PG8_SCHED;
            PG8_LDB(B1, 1, 1); PG8_STAGE(PG8_SB(1, 0), b3, voffB);
            PG8_BAR; PG8_WAIT_L(0); PG8_MMA(0, 1, At, B1); PG8_BAR;
            PG8_LDA(At, 1, 1); PG8_STAGE(PG8_SA(1, 0), a3, voffA);
            PG8_BAR; PG8_WAIT_L(0); PG8_MMA(1, 0, At, B0); PG8_BAR; PG8_SCHED;
            PG8_STAGE(PG8_SB(1, 1), b3 + hstepB, voffB);
            PG8_WAIT_V(6); PG8_BAR; PG8_MMA(1, 1, At, B1); PG8_BAR;
            }
        }
        if constexpr (ALIGN_EPI) { if (wr == 0) PG8_BAR; }
        if constexpr (!Epi::AFTER_DRAIN) { E(acc, cur, wr, wc, fr, fq); S.done(cur); }
        if (!has_next) break;
#pragma unroll
        for (int a = 0; a < 2; ++a)
#pragma unroll
            for (int b = 0; b < 2; ++b)
#pragma unroll
                for (int m = 0; m < 4; ++m)
#pragma unroll
                    for (int n = 0; n < 2; ++n) acc[a][b][m][n] = (f32x4){0.f, 0.f, 0.f, 0.f};
        cur = nxt; cA = nA; cB = nB; ++ui;
        if constexpr (ALIGN_EPI) { if (wr == 1) PG8_BAR; }
    }
    PG8_WAIT_V(0);
    if constexpr (!ALIGN_EPI) { if (wr == 0) PG8_BAR; }
    PG8_BAR;
    if constexpr (Epi::AFTER_DRAIN) { E.fused(acc, cur, wr, wc, fr, fq, lds, wid, lane); S.done(cur); }
#undef PG8_SA
#undef PG8_SB
#undef PG8_STAGE
#undef PG8_LDA
#undef PG8_LDB
#undef PG8_MMA
#undef PG8_WAIT_V
#undef PG8_WAIT_L
#undef PG8_BAR
#undef PG8_SCHED
}
}

namespace cg = cooperative_groups;
using pg8::bf16_t; using pg8::bf16x8; using pg8::f32x4; using pg8::u32x4; using pg8::f32x16;
typedef unsigned u32x2 __attribute__((ext_vector_type(2)));
#define LAS __attribute__((address_space(3)))
constexpr int NTHR = 512, NWAVES = 8;
constexpr int DM = 1024, T_ALL = 98304, T_PROMPT = 32768, GROUP = 16384, NGROUP = 6;
constexpr int PW = 3072;
constexpr int DFF = 2816;
constexpr float EPS = 1e-6f;
constexpr float QSCALE = 0.125f * 1.4426950408889634f;
constexpr size_t MiB = 1u << 20;
constexpr size_t WS_WIN = 0 * MiB, WS_WG = 6 * MiB, WS_WB = 14 * MiB, WS_WO = 16 * MiB, WS_WFI = 18 * MiB, WS_WFO = 29 * MiB, WS_MISC = 35 * MiB;
constexpr size_t WS_XN = 40 * MiB, WS_P = 72 * MiB, WS_S = 648 * MiB;
constexpr size_t S_HRAW = 0, S_HW8 = 20 * MiB, S_HW2 = 84 * MiB, S_KV = 100 * MiB;
constexpr size_t S_GATE = 0, S_ACT = 0, S_MF = 128 * MiB, S_MB = 192 * MiB;
constexpr size_t WS_CTL = 36 * MiB, CTL_BYTES = 131072;
constexpr size_t WS_NEED = 648 * MiB + 312 * MiB;
constexpr int LDS_BYTES = 147456;
#ifndef ENABLE
#define ENABLE 0xffff
#endif
constexpr int EN = ENABLE;
#ifndef PROBE_T
#define PROBE_T 0
#endif
#if PROBE_T
#define TMARK(c) do { const unsigned long long tn_ = __builtin_amdgcn_s_memrealtime(); if (PROBE_T == (c)) tacc += tn_ - tprev; tprev = tn_; } while (0)
#else
#define TMARK(c) do {} while (0)
#endif
#ifndef PROBE_DUP
#define PROBE_DUP 0
#endif

#define GSYNC() xcd_barrier(xbar)
struct Args { const float* in[20]; float* out; unsigned char* ws; };

__device__ __forceinline__ float wave_sum(float v) {
#pragma unroll
    for (int o = 1; o < 64; o <<= 1) v += pg8::shx(v, o);
    return v;
}
__device__ __forceinline__ unsigned cvtpk(float lo, float hi) { return pg8::cvt_pk_bf16(lo, hi); }
__device__ __forceinline__ float bf2f(unsigned h) { return __uint_as_float(h << 16); }
__device__ __forceinline__ unsigned f2bf1(float f) { return cvtpk(f, 0.f) & 0xffffu; }
__device__ __forceinline__ int pi_slot(int s) { return (s & ~31) | (((s >> 2) & 1) << 4) | (((s >> 3) & 3) << 2) | (s & 3); }
__device__ __forceinline__ f32x16 mfma32(bf16x8 a, bf16x8 b, f32x16 c) { return __builtin_amdgcn_mfma_f32_32x32x16_bf16(a, b, c, 0, 0, 0); }
__device__ __forceinline__ int crow(int r, int hi) { return (r & 3) + 8 * (r >> 2) + 4 * hi; }
__device__ __forceinline__ bf16x8 mk8(u32x2 lo, u32x2 hi) { u32x4 w; w.x = lo.x; w.y = lo.y; w.z = hi.x; w.w = hi.y; return __builtin_bit_cast(bf16x8, w); }
__device__ __forceinline__ bf16x8 pack8r(const f32x16& p, int b) { u32x4 w; w.x = cvtpk(p[b], p[b + 1]); w.y = cvtpk(p[b + 2], p[b + 3]); w.z = cvtpk(p[b + 4], p[b + 5]); w.w = cvtpk(p[b + 6], p[b + 7]); return __builtin_bit_cast(bf16x8, w); }
__device__ __forceinline__ unsigned short u16at(const u32x4& w, int e) { return (unsigned short)((w[e >> 1] >> (16 * (e & 1))) & 0xffffu); }

template <int MAP, bool KPERM>
__device__ __forceinline__ void transpose_item(const float* W, int ld, int K, int nblk, bf16_t* WT, float* scr, int item, int lane) {
    const int kb = item / nblk, nb = item % nblk, k0 = 64 * kb, n0 = 32 * nb;
#pragma unroll
    for (int i = 0; i < 8; ++i) { const int kk = 8 * i + (lane >> 3); const f32x4 v = *(const f32x4*)(W + (size_t)(k0 + kk) * ld + n0 + 4 * (lane & 7));
        float* sp = scr + kk * 33 + 4 * (lane & 7); sp[0] = v[0]; sp[1] = v[1]; sp[2] = v[2]; sp[3] = v[3]; }
    asm volatile("s_waitcnt lgkmcnt(0)" ::: "memory");
    const int c = lane & 7;
#pragma unroll
    for (int j = 0; j < 4; ++j) {
        const int n = (lane >> 3) + 8 * j; const int ns = n0 + n; int dr;
        if (MAP == 0) dr = ns;
        else if (MAP == 1) { const int lc = ns & 255; dr = (ns & ~255) + 128 * ((lc >> 5) & 1) + 32 * ((lc >> 6) & 3) + 8 * ((lc >> 2) & 3) + 4 * ((lc >> 4) & 1) + (lc & 3); }
        else if (MAP == 3) { const int br = ns >> 10, ch = ns & 1023; dr = (ch >> 6) * 256 + 128 * (br >> 1) + 32 * ((ch >> 4) & 3) + 8 * ((ch >> 2) & 3) + 4 * (br & 1) + (ch & 3); }
        else { const int up = ns >= DFF ? 1 : 0; const int jj = ns - DFF * up; dr = (jj >> 7) * 256 + 128 * up + (jj & 127); }
        float s[8];
#pragma unroll
        for (int e = 0; e < 8; ++e) { const int kl = KPERM ? pi_slot(8 * c + e) : (8 * c + e); s[e] = scr[kl * 33 + n]; }
        u32x4 o; o.x = cvtpk(s[0], s[1]); o.y = cvtpk(s[2], s[3]); o.z = cvtpk(s[4], s[5]); o.w = cvtpk(s[6], s[7]);
        *(u32x4*)(WT + (size_t)dr * K + k0 + 8 * c) = o;
    }
    asm volatile("s_waitcnt lgkmcnt(0)" ::: "memory");
}

__device__ __forceinline__ void prep_weights(const Args& a, int layer, unsigned char* lds, const int wave0) {
    const int tid = (wave0 * 64 + pg8::lane_now()), lane = tid & 63, wave = wave0; const int gw = blockIdx.x * NWAVES + wave, NGW = gridDim.x * NWAVES;
    unsigned char* ws = a.ws;
    float* scr = (float*)(lds + wave * 16384);
    const float* w_in = a.in[3] + (size_t)layer * 1024 * 7168;
    const float* wbr = a.in[16] + (size_t)layer * 4 * 256 * 1024;
    const float* wo = a.in[17] + (size_t)layer * 1024 * 1024;
    const float* wfi = a.in[18] + (size_t)layer * 1024 * 5632;
    const float* wfo = a.in[19] + (size_t)layer * 2816 * 1024;
    constexpr int I_IN = 16 * 96, I_G = 16 * 128, I_B = 4 * 32, I_O = 16 * 32, I_FI = 16 * 176, I_FO = 44 * 32;
    constexpr int NIT = I_IN + I_G + 4 * I_B + I_O + I_FI + I_FO;
    for (int it = gw; it < NIT; it += NGW) {
        int r = it;
        if (r < I_IN) { transpose_item<1, false>(w_in, 7168, 1024, 96, (bf16_t*)(ws + WS_WIN), scr, r, lane); continue; } r -= I_IN;
        if (r < I_G) { transpose_item<3, false>(w_in + 3072, 7168, 1024, 128, (bf16_t*)(ws + WS_WG), scr, r, lane); continue; } r -= I_G;
        if (r < 4 * I_B) { const int n = r / I_B; transpose_item<0, true>(wbr + (size_t)n * 256 * 1024, 1024, 256, 32, (bf16_t*)(ws + WS_WB) + (size_t)n * 1024 * 256, scr, r % I_B, lane); continue; } r -= 4 * I_B;
        if (r < I_O) { transpose_item<0, false>(wo, 1024, 1024, 32, (bf16_t*)(ws + WS_WO), scr, r, lane); continue; } r -= I_O;
        if (r < I_FI) { transpose_item<2, false>(wfi, 5632, 1024, 176, (bf16_t*)(ws + WS_WFI), scr, r, lane); continue; } r -= I_FI;
        transpose_item<0, false>(wfo, 1024, 2816, 32, (bf16_t*)(ws + WS_WFO), scr, r, lane);
    }
}

__device__ __forceinline__ const float* xrow_ptr(const Args& a, int layer, int R) {
    if (layer == 0) return R < T_PROMPT ? a.in[0] + (size_t)R * DM : a.in[1] + (size_t)(R - T_PROMPT) * DM;
    return a.out + (size_t)R * DM;
}
__device__ __forceinline__ void norm_x_rows(const Args& a, int layer, int g, const float* gain, bf16_t* XN, const int wave0) {
    const int tid = (wave0 * 64 + pg8::lane_now()), lane = tid & 63, wave = wave0; const int gw = blockIdx.x * NWAVES + wave, NGW = gridDim.x * NWAVES;
    for (int row = gw; row < GROUP; row += 2 * NGW) {
        const int row2 = row + NGW;
        const float* xr = xrow_ptr(a, layer, g * GROUP + row); const float* xr2 = xrow_ptr(a, layer, g * GROUP + row2);
        f32x4 v[4], w[4]; float ss = 0.f, ss2 = 0.f;
#pragma unroll
        for (int j = 0; j < 4; ++j) { v[j] = *(const f32x4*)(xr + 4 * lane + 256 * j); w[j] = *(const f32x4*)(xr2 + 4 * lane + 256 * j); }
#pragma unroll
        for (int j = 0; j < 4; ++j) { ss += (v[j][0] * v[j][0] + v[j][1] * v[j][1]) + (v[j][2] * v[j][2] + v[j][3] * v[j][3]); ss2 += (w[j][0] * w[j][0] + w[j][1] * w[j][1]) + (w[j][2] * w[j][2] + w[j][3] * w[j][3]); }
        const float rn = 1.0f / sqrtf(wave_sum(ss) * (1.0f / DM) + EPS), rn2 = 1.0f / sqrtf(wave_sum(ss2) * (1.0f / DM) + EPS);
#pragma unroll
        for (int j = 0; j < 4; ++j) { const f32x4 gv = *(const f32x4*)(gain + 4 * lane + 256 * j); const f32x4 o = v[j] * rn * gv, o2 = w[j] * rn2 * gv;
            u32x2 p; p.x = cvtpk(o[0], o[1]); p.y = cvtpk(o[2], o[3]); *(u32x2*)(XN + (size_t)row * DM + 4 * lane + 256 * j) = p;
            u32x2 p2; p2.x = cvtpk(o2[0], o2[1]); p2.y = cvtpk(o2[2], o2[3]); *(u32x2*)(XN + (size_t)row2 * DM + 4 * lane + 256 * j) = p2; }
    }
}
__device__ __forceinline__ void norm_res_rows(const Args& a, const float* TMP, int g, bool base_is_x0, const float* gain, const float* gain2, bf16_t* HN, const int wave0) {
    const int tid = (wave0 * 64 + pg8::lane_now()), lane = tid & 63, wave = wave0; const int gw = blockIdx.x * NWAVES + wave, NGW = gridDim.x * NWAVES;
    for (int row = gw; row < GROUP; row += NGW) {
        const int R = g * GROUP + row;
        const float* br = base_is_x0 ? xrow_ptr(a, 0, R) : a.out + (size_t)R * DM;
        const float* tr = TMP + (size_t)row * DM;
        f32x4 v[4], b[4]; float ss = 0.f;
#pragma unroll
        for (int j = 0; j < 4; ++j) { v[j] = *(const f32x4*)(tr + 4 * lane + 256 * j); b[j] = *(const f32x4*)(br + 4 * lane + 256 * j); ss += (v[j][0] * v[j][0] + v[j][1] * v[j][1]) + (v[j][2] * v[j][2] + v[j][3] * v[j][3]); }
        const float rn = 1.0f / sqrtf(wave_sum(ss) * (1.0f / DM) + EPS);
        float s2 = 0.f;
#pragma unroll
        for (int j = 0; j < 4; ++j) { const f32x4 gv = *(const f32x4*)(gain + 4 * lane + 256 * j); v[j] = b[j] + v[j] * rn * gv;
            *(f32x4*)(a.out + (size_t)R * DM + 4 * lane + 256 * j) = v[j]; s2 += (v[j][0] * v[j][0] + v[j][1] * v[j][1]) + (v[j][2] * v[j][2] + v[j][3] * v[j][3]); }
        if (HN) {
            const float r2 = 1.0f / sqrtf(wave_sum(s2) * (1.0f / DM) + EPS);
#pragma unroll
            for (int j = 0; j < 4; ++j) { const f32x4 gv = *(const f32x4*)(gain2 + 4 * lane + 256 * j); const f32x4 o = v[j] * r2 * gv;
                u32x2 w; w.x = cvtpk(o[0], o[1]); w.y = cvtpk(o[2], o[3]); *(u32x2*)(HN + (size_t)row * DM + 4 * lane + 256 * j) = w; }
        }
    }
}

__device__ __forceinline__ void rope_table(float* rcos, float* rsin, const int wave0) {
    for (int i = (wave0 * 64 + pg8::lane_now()); i < 128 * 16; i += NTHR) {
        const int pos = i >> 4, f = i & 15;
        const float inv = powf(10000.0f, -(float)f / 16.0f);
        const float ang = (float)pos * inv;
        rcos[i] = cosf(ang); rsin[i] = sinf(ang);
    }
}

__device__ __forceinline__ void hy_filter_item(const Args& a, int layer, int item, unsigned char* lds, const int wave0) {
    const int tid = (wave0 * 64 + pg8::lane_now());
    const bool big = item < 512; const int L = big ? 8192 : 2048; const int t0 = (big ? item : item - 512) * 16;
    float* hraw = (float*)(a.ws + WS_S + S_HRAW) + (big ? 0 : (size_t)2 * 256 * 8192);
    const float* w1 = a.in[7] + layer * 33 * 64; const float* b1 = a.in[8] + layer * 64; const float* w2 = a.in[9] + layer * 64 * 64; const float* b2 = a.in[10] + layer * 64;
    const float* w3 = a.in[11] + (size_t)layer * 64 * 512; const float* fr = a.in[12] + layer * 128;
    float* zf = (float*)lds; float* h1 = zf + 16 * 33; float* h2 = h1 + 16 * 65;
    for (int idx = tid; idx < 16 * 33; idx += NTHR) {
        const int p = idx / 33, f = idx - p * 33; const int t = t0 + p; float v;
        if (f == 0) v = (float)t / (float)(L - 1);
        else { const int k = (f - 1) & 15; const float fk = 1e-4f + (float)k * ((15.0f - 1e-4f) / 15.0f); float x = ((float)t * fk) / (float)L; x = x - floorf(x); v = f <= 16 ? __builtin_amdgcn_cosf(x) : -__builtin_amdgcn_sinf(x); }
        zf[idx] = v;
    }
    __syncthreads();
    for (int idx = tid; idx < 1024; idx += NTHR) { const int p = idx >> 6, u = idx & 63; float s = b1[u];
#pragma unroll 11
        for (int f = 0; f < 33; ++f) s += zf[p * 33 + f] * w1[f * 64 + u];
        h1[p * 65 + u] = sinf(fr[u] * s); }
    __syncthreads();
    for (int idx = tid; idx < 1024; idx += NTHR) { const int p = idx >> 6, u = idx & 63; float s = b2[u];
#pragma unroll 16
        for (int k = 0; k < 64; ++k) s += h1[p * 65 + k] * w2[k * 64 + u];
        h2[p * 65 + u] = sinf(fr[64 + u] * s); }
    __syncthreads();
    {
        const int p = tid & 15, c0 = (tid >> 4) * 16; const int t = t0 + p; const float tl = (float)t / (float)(L - 1);
        f32x4 ac[4] = {f32x4{}, f32x4{}, f32x4{}, f32x4{}};
#pragma unroll 4
        for (int k = 0; k < 64; ++k) { const float h = h2[p * 65 + k]; const float* wp = w3 + k * 512 + c0;
#pragma unroll
            for (int j = 0; j < 4; ++j) ac[j] += h * *(const f32x4*)(wp + 4 * j); }
        const float dlo = -4.605170185988091f / 1.5f, dhi = -4.605170185988091f / 0.3f;
#pragma unroll
        for (int j = 0; j < 4; ++j)
#pragma unroll
            for (int i = 0; i < 4; ++i) { const int col = c0 + 4 * j + i; const int dir = col >> 8, c = col & 255; const float delta = fabsf(dlo + (float)c * ((dhi - dlo) / 255.0f));
                hraw[((size_t)dir * 256 + c) * L + t] = ac[j][i] * expf(-tl * delta); }
    }
    __syncthreads();
}
__device__ __forceinline__ void hy_window_item(const Args& a, int item, unsigned char* lds, const int wave0) {
    const int tid = (wave0 * 64 + pg8::lane_now()), lane = tid & 63, wave = wave0;
    const bool big = item < 256; const int L = big ? 8192 : 2048; const int c = big ? item : item - 256;
    const float* hraw = (const float*)(a.ws + WS_S + S_HRAW) + (big ? 0 : (size_t)2 * 256 * 8192);
    const float* hf = hraw + (size_t)c * L; const float* hb = hraw + ((size_t)256 + c) * L;
    bf16_t* W = (bf16_t*)(a.ws + WS_S + (big ? S_HW8 : S_HW2)) + (size_t)c * (2 * L * 8);
    float* red = (float*)lds;
    float ss = 0.f;
    for (int t = tid; t < L; t += NTHR) { const float x = hf[t]; ss += x * x; if (t > 0) { const float y = hb[t]; ss += y * y; } }
    ss = wave_sum(ss);
    if (lane == 0) red[wave] = ss;
    __syncthreads();
    float tot = 0.f;
#pragma unroll
    for (int w = 0; w < NWAVES; ++w) tot += red[w];
    const float nrm = 1.0f / sqrtf(tot + EPS);
    for (int idx = tid; idx < 2 * L; idx += NTHR) {
        const int o = idx - L; float s[8];
#pragma unroll
        for (int e = 0; e < 8; ++e) { const int l = o - e; float v = 0.f; if (l >= 0) { if (l < L) v = hf[l]; } else { if (-l < L) v = hb[-l]; } s[e] = v * nrm; }
        u32x4 w; w.x = cvtpk(s[0], s[1]); w.y = cvtpk(s[2], s[3]); w.z = cvtpk(s[4], s[5]); w.w = cvtpk(s[6], s[7]);
        *(u32x4*)(W + (size_t)idx * 8) = w;
    }
    __syncthreads();
}

__device__ __forceinline__ int zidx(int t) { return (t & ~31) | ((((t >> 3) & 3) ^ ((t >> 7) & 3)) << 3) | (t & 7); }
#define HY_STEP8(dd, ks, slot) do { const bf16x8 cur = ar[slot]; \
        { int dn = (dd) + 4; dn = dn <= dmax ? dn : dmax; ar[slot] = *(const bf16x8*)(Wc + (size_t)(abase + 32 * dn - 16 * (ks)) * 8); } \
        bf16x8 bf[NQ]; const int u = r32 - (dd); const bf16_t* bu = zw + 32 * u + 8 * ((2 * (ks) + hi) ^ ((u >> 2) & 3)); \
        _Pragma("unroll") for (int q = QLO; q <= QHI; ++q) { \
            if (q == QLO || q == QHI) { const bf16_t* bp = ((unsigned)(u + 32 * q) < (unsigned)nb) ? (bu + 1024 * q) : zero; bf[q] = *(const bf16x8*)bp; } \
            else bf[q] = *(const bf16x8*)(bu + 1024 * q); } \
        __builtin_amdgcn_sched_barrier(0); \
        _Pragma("unroll") for (int q = QLO; q <= QHI; ++q) acc[q] = mfma32(cur, bf[q], acc[q]); \
        __builtin_amdgcn_sched_barrier(0); } while (0)
template <int NQ, int QLO, int QHI>
__device__ __forceinline__ void hy_seg(f32x16 (&acc)[NQ], const int dlo, const int dhi, const int dmax, const bf16_t* Wc, const int abase, const bf16_t* zw, const bf16_t* zero, const int r32, const int hi,
                                       bf16x8 (&ar)[8]) {
    constexpr int nb = NQ * 32;
    for (int d = dlo; d <= dhi; d += 4) {
        HY_STEP8(d, 0, 0); HY_STEP8(d, 1, 1); HY_STEP8(d + 1, 0, 2); HY_STEP8(d + 1, 1, 3);
        HY_STEP8(d + 2, 0, 4); HY_STEP8(d + 2, 1, 5); HY_STEP8(d + 3, 0, 6); HY_STEP8(d + 3, 1, 7);
    }
}
#undef HY_STEP8
template <int NQ, int S> struct HySegs {
    static __device__ __forceinline__ void run(f32x16 (&acc)[NQ], const bf16_t* Wc, const int abase, const bf16_t* zw, const bf16_t* zero, const int r32, const int hi, bf16x8 (&ar)[8]) {
        constexpr int nb = NQ * 32;
        constexpr int QLO = S < NQ ? 0 : S - NQ + 1, QHI = S < NQ ? S : NQ - 1;
        constexpr int dlo = S < NQ - 1 ? 32 * S - nb + 1 : (S == NQ - 1 ? -31 : 32 * (S - NQ + 1) + 1);
        constexpr int dhi = S < NQ - 1 ? dlo + 31 : (S == NQ - 1 ? 32 : dlo + 31);
        hy_seg<NQ, QLO, QHI>(acc, dlo, dhi, nb - 1, Wc, abase, zw, zero, r32, hi, ar);
        if constexpr (S + 1 < 2 * NQ - 1) HySegs<NQ, S + 1>::run(acc, Wc, abase, zw, zero, r32, hi, ar);
    }
};
template <int NQ>
__device__ __forceinline__ void hyena_item(const Args& a, int layer, int row0, int g, unsigned char* lds, const bool do_store, const int wave0) {
    constexpr int L = NQ * 1024, nb = L / 32;
    const int tid = (wave0 * 64 + pg8::lane_now()), lane = tid & 63, wave = wave0, r32 = lane & 31, hi = lane >> 5;
    bf16_t* P = (bf16_t*)(a.ws + WS_P);
    bf16_t* zs = (bf16_t*)lds;
    bf16_t* zero = zs + 8 * L;
    float* ptab = (float*)(lds + 8 * L * 2 + 64);
    const float* hcw = a.in[5] + layer * 3 * 768; const float* hcb = a.in[6] + layer * 768; const float* hbias = a.in[13] + layer * 256;
    if (tid < 16) ((unsigned*)zero)[tid] = 0u;
    if (tid < 128) { const int e = tid >> 4, q = tid & 15; const int lc = pi_slot(8 * g + e); float v = 0.f;
        if (q < 9) v = hcw[(q % 3) * 768 + (q / 3) * 256 + lc]; else if (q < 12) v = hcb[(q - 9) * 256 + lc]; else if (q == 12) v = hbias[lc];
        ptab[e * 16 + q] = v; }
    __syncthreads();
    for (int tu = tid; tu < L / 8; tu += NTHR) {
        const int t0 = 8 * tu;
        u32x4 x1r[10], hvr[10];
#pragma unroll
        for (int k = 0; k < 10; ++k) { const int t = t0 - 1 + k; const bool ok = (t >= 0) && (t < L);
            const bf16_t* pr = P + (size_t)(row0 + (ok ? t : t0)) * PW + 3 * 256 + 8 * g;
            const u32x4 a_ = *(const u32x4*)pr, b_ = *(const u32x4*)(pr + 256); const u32x4 zz = (u32x4){0u, 0u, 0u, 0u};
            x1r[k] = ok ? a_ : zz; hvr[k] = ok ? b_ : zz; }
        const int zt = zidx(t0);
#pragma unroll
        for (int e = 0; e < 8; ++e) { const float* pt = ptab + e * 16; float z[8];
#pragma unroll
            for (int i = 0; i < 8; ++i) {
                const float u1 = pt[3] * bf2f(u16at(x1r[i], e)) + pt[4] * bf2f(u16at(x1r[i + 1], e)) + pt[5] * bf2f(u16at(x1r[i + 2], e)) + pt[10];
                const float uv = pt[6] * bf2f(u16at(hvr[i], e)) + pt[7] * bf2f(u16at(hvr[i + 1], e)) + pt[8] * bf2f(u16at(hvr[i + 2], e)) + pt[11];
                z[i] = uv * u1; }
            u32x4 w; w.x = cvtpk(z[0], z[1]); w.y = cvtpk(z[2], z[3]); w.z = cvtpk(z[4], z[5]); w.w = cvtpk(z[6], z[7]);
            *(u32x4*)(zs + e * L + zt) = w; }
    }
    __syncthreads();
    {
        const int lc = pi_slot(8 * g + wave);
        const bf16_t* Wc = (const bf16_t*)(a.ws + WS_S + (NQ == 8 ? S_HW8 : S_HW2)) + (size_t)lc * (2 * L * 8);
        const bf16_t* zw = zs + wave * L;
        f32x16 acc[NQ];
#pragma unroll
        for (int q = 0; q < NQ; ++q) acc[q] = f32x16{};
        constexpr int dmin = -(nb - 1);
        const int abase = L + r32 - 8 * hi;
        bf16x8 ar[8];
#pragma unroll
        for (int st = 0; st < 8; ++st) ar[st] = *(const bf16x8*)(Wc + (size_t)(abase + 32 * (dmin + (st >> 1)) - 16 * (st & 1)) * 8);
        HySegs<NQ, 0>::run(acc, Wc, abase, zw, zero, r32, hi, ar);
        const float hb_ = ptab[wave * 16 + 12];
        bf16_t* zwm = zs + wave * L;
#pragma unroll
        for (int q = 0; q < NQ; ++q)
#pragma unroll
            for (int rg = 0; rg < 4; ++rg) {
                const int jb = 32 * q + r32; const int t0 = 32 * jb + 8 * (rg ^ ((jb >> 2) & 3)) + 4 * hi;
                const u32x2 zz = *(const u32x2*)(zwm + t0);
                const float y0 = acc[q][4 * rg + 0] + hb_ * bf2f(zz.x & 0xffffu), y1 = acc[q][4 * rg + 1] + hb_ * bf2f(zz.x >> 16);
                const float y2 = acc[q][4 * rg + 2] + hb_ * bf2f(zz.y & 0xffffu), y3 = acc[q][4 * rg + 3] + hb_ * bf2f(zz.y >> 16);
                u32x2 w; w.x = cvtpk(y0, y1); w.y = cvtpk(y2, y3); *(u32x2*)(zwm + t0) = w;
            }
    }
    __syncthreads();
    for (int tu = tid; tu < L / 8; tu += NTHR) {
        const int t0 = 8 * tu;
        u32x4 xr[10], yr[8];
#pragma unroll
        for (int k = 0; k < 10; ++k) { const int t = t0 - 1 + k; const bool ok = (t >= 0) && (t < L);
            const u32x4 a_ = *(const u32x4*)(P + (size_t)(row0 + (ok ? t : t0)) * PW + 2 * 256 + 8 * g); const u32x4 zz = (u32x4){0u, 0u, 0u, 0u};
            xr[k] = ok ? a_ : zz; }
        const int zt = zidx(t0);
#pragma unroll
        for (int e = 0; e < 8; ++e) yr[e] = *(const u32x4*)(zs + e * L + zt);
#pragma unroll
        for (int i = 0; i < 8; ++i) { float o[8];
#pragma unroll
            for (int e = 0; e < 8; ++e) { const float* pt = ptab + e * 16;
                const float u0 = pt[0] * bf2f(u16at(xr[i], e)) + pt[1] * bf2f(u16at(xr[i + 1], e)) + pt[2] * bf2f(u16at(xr[i + 2], e)) + pt[9];
                o[e] = u0 * bf2f(u16at(yr[e], i)); }
            u32x4 w; w.x = cvtpk(o[0], o[1]); w.y = cvtpk(o[2], o[3]); w.z = cvtpk(o[4], o[5]); w.w = cvtpk(o[6], o[7]);
            if (do_store) *(u32x4*)(P + (size_t)(row0 + t0 + i) * PW + 3 * 256 + 8 * g) = w; }
    }
    __syncthreads();
}

typedef short v4i16_t __attribute__((ext_vector_type(4)));
__device__ __forceinline__ u32x2 vtr64(const bf16_t* p) {
    return __builtin_bit_cast(u32x2, __builtin_amdgcn_ds_read_tr16_b64_v4i16((__attribute__((address_space(3))) v4i16_t*)(uintptr_t)p));
}

__device__ __forceinline__ void attn_unit(bf16_t* P, int row0, int L, int kvh, int qb, unsigned char* lds, const bool do_store, const int wave0) {
    const int tid = (wave0 * 64 + pg8::lane_now()), lane = tid & 63, wave = wave0, r32 = lane & 31, hi = lane >> 5;
    const int head = 2 * kvh + (wave >> 2);
    bf16_t* qp0 = P + (size_t)(row0 + qb * 256 + (wave & 3) * 64 + r32) * PW + head * 64;
    bf16x8 qf[2][4];
#pragma unroll
    for (int t = 0; t < 2; ++t)
#pragma unroll
        for (int ks = 0; ks < 4; ++ks) qf[t][ks] = *(const bf16x8*)(qp0 + (size_t)t * 32 * PW + 16 * ks + 8 * hi);
    bf16_t* Ks = (bf16_t*)lds; bf16_t* Vt = Ks + 2 * 64 * 72;
    const int skey = tid >> 3, sch = tid & 7;
    const bf16_t* kg = P + (size_t)(row0 + skey) * PW + 256 + kvh * 64 + sch * 8;
    u32x4 kreg = *(const u32x4*)kg, vreg = *(const u32x4*)(kg + 128);
#define ATT_PUT(buf) do { *(u32x4*)(Ks + (buf) * 64 * 72 + skey * 72 + sch * 8) = kreg; *(u32x4*)(Vt + (buf) * 64 * 72 + skey * 72 + sch * 8) = vreg; } while (0)
    ATT_PUT(0);
    __syncthreads();
    const int nt = L / 64;
    const int vtb = (4 * hi + ((lane & 15) >> 2)) * 72 + 16 * ((lane >> 4) & 1) + 4 * (lane & 3);
    float mhat[2] = {0.f, 0.f}, l_run[2] = {0.f, 0.f}; f32x16 o[2][2], negm[2];
#pragma unroll
    for (int t = 0; t < 2; ++t) { o[t][0] = f32x16{}; o[t][1] = f32x16{}; negm[t] = f32x16{}; }
    for (int kt = 0; kt < nt; ++kt) {
        const int buf = kt & 1;
        if (kt + 1 < nt) { const bf16_t* kn = kg + (size_t)(kt + 1) * 64 * PW; kreg = *(const u32x4*)kn; vreg = *(const u32x4*)(kn + 128); }
        const bf16_t* kb = Ks + buf * 64 * 72; const bf16_t* vb = Vt + buf * 64 * 72;
#pragma unroll
        for (int h = 0; h < 2; ++h) {
            bf16x8 ka[4], va[4];
#pragma unroll
            for (int ks = 0; ks < 4; ++ks) ka[ks] = *(const bf16x8*)(kb + (32 * h + r32) * 72 + 16 * ks + 8 * hi);
#pragma unroll
            for (int jj = 0; jj < 2; ++jj) { const int j = 2 * h + jj;
                va[2 * jj] = mk8(vtr64(vb + vtb + (16 * j) * 72), vtr64(vb + vtb + (16 * j + 8) * 72));
                va[2 * jj + 1] = mk8(vtr64(vb + vtb + (16 * j) * 72 + 32), vtr64(vb + vtb + (16 * j + 8) * 72 + 32)); }
            __builtin_amdgcn_sched_barrier(0);
#pragma unroll
            for (int t = 0; t < 2; ++t) {
                f32x16 sc = mfma32(ka[0], qf[t][0], negm[t]);
#pragma unroll
                for (int ks = 1; ks < 4; ++ks) sc = mfma32(ka[ks], qf[t][ks], sc);
                float mx = sc[0];
#pragma unroll
                for (int r = 1; r < 16; ++r) mx = fmaxf(mx, sc[r]);
                mx = fmaxf(mx, pg8::shx(mx, 32));
                if ((kt == 0 && h == 0) || __any(mx > 8.0f)) {
                    const float dl = (kt == 0 && h == 0) ? mx : fmaxf(mx, 0.f);
                    mhat[t] += dl; const float alpha = __builtin_amdgcn_exp2f(-dl);
#pragma unroll
                    for (int r = 0; r < 16; ++r) { sc[r] -= dl; o[t][0][r] *= alpha; o[t][1][r] *= alpha; negm[t][r] = -mhat[t]; }
                    l_run[t] *= alpha;
                }
                float ps = 0.f;
#pragma unroll
                for (int r = 0; r < 16; ++r) { sc[r] = __builtin_amdgcn_exp2f(sc[r]); ps += sc[r]; }
                l_run[t] += ps;
                const bf16x8 pb0 = pack8r(sc, 0), pb1 = pack8r(sc, 8);
                o[t][0] = mfma32(va[0], pb0, o[t][0]); o[t][1] = mfma32(va[1], pb0, o[t][1]);
                o[t][0] = mfma32(va[2], pb1, o[t][0]); o[t][1] = mfma32(va[3], pb1, o[t][1]);
            }
        }
        if (kt + 1 < nt) ATT_PUT(buf ^ 1);
        __syncthreads();
    }
#undef ATT_PUT
#pragma unroll
    for (int t = 0; t < 2; ++t) {
        const float inv = 1.0f / (l_run[t] + pg8::shx(l_run[t], 32));
        bf16_t* qp = qp0 + (size_t)t * 32 * PW;
#pragma unroll
        for (int rg = 0; rg < 4; ++rg) {
            u32x2 w0, w1;
            w0.x = cvtpk(o[t][0][4 * rg] * inv, o[t][0][4 * rg + 1] * inv); w0.y = cvtpk(o[t][0][4 * rg + 2] * inv, o[t][0][4 * rg + 3] * inv);
            w1.x = cvtpk(o[t][1][4 * rg] * inv, o[t][1][4 * rg + 1] * inv); w1.y = cvtpk(o[t][1][4 * rg + 2] * inv, o[t][1][4 * rg + 3] * inv);
            if (do_store) { *(u32x2*)(qp + 8 * rg + 4 * hi) = w0; *(u32x2*)(qp + 32 + 8 * rg + 4 * hi) = w1; }
        }
    }
}

__device__ __forceinline__ float ret_lg2(const Args& a, int layer, int dir, int head) {
    const float rde = a.in[14][layer * 8 + dir * 4 + head];
    return log1pf(-exp2f(-rde)) * 1.4426950408889634f;
}
__device__ __forceinline__ void ret_kv_item(const Args& a, int layer, int cgi, int hp, unsigned char* lds, const int wave0) {
    const int tid = (wave0 * 64 + pg8::lane_now()), lane = tid & 63, wave = wave0, r32 = lane & 31, hi = lane >> 5;
    const bf16_t* P = (const bf16_t*)(a.ws + WS_P);
    bf16_t* KV = (bf16_t*)(a.ws + WS_S + S_KV);
    constexpr int PT = 136;
    bf16_t* Ktf = (bf16_t*)lds; bf16_t* Ktb = Ktf + 2 * 64 * PT; bf16_t* Vt = Ktb + 2 * 64 * PT;
#pragma unroll
    for (int i = 0; i < 4; ++i) {
        const int pc = tid + NTHR * i; const int h = pc >> 10, j = (pc >> 3) & 127, ch = pc & 7; const int head = 2 * hp + h;
        const bf16_t* src = P + (size_t)(cgi * 128 + j) * PW + 6 * 256 + head * 64 + ch * 8;
        const u32x4 kr = *(const u32x4*)src, vr = *(const u32x4*)(src + 256);
        const float wf = exp2f((float)(127 - j) * ret_lg2(a, layer, 0, head)), wb = exp2f((float)j * ret_lg2(a, layer, 1, head));
#pragma unroll
        for (int e = 0; e < 8; ++e) { const float kv = bf2f(u16at(kr, e)); const int o = (h * 64 + ch * 8 + e) * PT + j;
            Ktf[o] = (bf16_t)f2bf1(kv * wf); Ktb[o] = (bf16_t)f2bf1(kv * wb); Vt[o] = u16at(vr, e); }
    }
    __syncthreads();
    {
        const int h = wave >> 2, sub = wave & 3, dir = sub >> 1, e0 = sub & 1; const int head = 2 * hp + h;
        const bf16_t* kt = (dir ? Ktb : Ktf) + h * 64 * PT; const bf16_t* vt = Vt + h * 64 * PT;
        f32x16 c0 = f32x16{}, c1 = f32x16{};
#pragma unroll
        for (int ks = 0; ks < 8; ++ks) {
            const bf16x8 av = *(const bf16x8*)(vt + (32 * e0 + r32) * PT + 16 * ks + 8 * hi);
            const bf16x8 b0 = *(const bf16x8*)(kt + r32 * PT + 16 * ks + 8 * hi), b1 = *(const bf16x8*)(kt + (32 + r32) * PT + 16 * ks + 8 * hi);
            c0 = mfma32(av, b0, c0); c1 = mfma32(av, b1, c1);
        }
        bf16_t* dst = KV + ((size_t)(cgi * 4 + head) * 2 + dir) * 4096;
#pragma unroll
        for (int r = 0; r < 16; ++r) { const int e = 32 * e0 + crow(r, hi); dst[e * 64 + r32] = (bf16_t)f2bf1(c0[r]); dst[e * 64 + 32 + r32] = (bf16_t)f2bf1(c1[r]); }
    }
    __syncthreads();
}
__device__ __forceinline__ void ret_scan(const Args& a, int layer, const int wave0) {
    const int gtid = blockIdx.x * NTHR + (wave0 * 64 + pg8::lane_now()), gthreads = gridDim.x * NTHR;
    bf16_t* KV = (bf16_t*)(a.ws + WS_S + S_KV);
    for (int idx = gtid; idx < 24 * 4 * 2 * 4096; idx += gthreads) {
        const int el = idx & 4095, dir = (idx >> 12) & 1, head = (idx >> 13) & 3, s = idx >> 15;
        const int chunk0 = s < 16 ? 16 * s : 256 + 64 * (s - 16), nc = s < 16 ? 16 : 64;
        const float gch = exp2f(128.0f * ret_lg2(a, layer, dir, head));
        float S = 0.f;
        bf16_t* base = KV + ((size_t)(chunk0 * 4 + head) * 2 + dir) * 4096 + el;
        for (int b = 0; b < nc; b += 16) {
            float tmp[16];
#pragma unroll
            for (int k = 0; k < 16; ++k) { const int n = b + k; const int cn = dir == 0 ? n : nc - 1 - n; tmp[k] = bf2f(base[(size_t)cn * 32768]); }
#pragma unroll
            for (int k = 0; k < 16; ++k) { const int n = b + k; const int cn = dir == 0 ? n : nc - 1 - n; base[(size_t)cn * 32768] = (bf16_t)f2bf1(S); S = gch * S + tmp[k]; }
        }
    }
}
__device__ __forceinline__ void ret_out_item(const Args& a, int layer, int cgi, int hp, unsigned char* lds, const int wave0) {
    const int tid = (wave0 * 64 + pg8::lane_now()), lane = tid & 63, wave = wave0, r32 = lane & 31, hi = lane >> 5;
    bf16_t* P = (bf16_t*)(a.ws + WS_P);
    const bf16_t* KV = (const bf16_t*)(a.ws + WS_S + S_KV);
    constexpr int PK = 72, PT = 136;
    bf16_t* Kr = (bf16_t*)lds;
    bf16_t* Vt = Kr + 2 * 128 * PK;
    bf16_t* St = Vt + 2 * 64 * PT;
#pragma unroll
    for (int i = 0; i < 4; ++i) {
        const int pc = tid + NTHR * i; const int h = pc >> 10, j = (pc >> 3) & 127, ch = pc & 7; const int head = 2 * hp + h;
        const bf16_t* src = P + (size_t)(cgi * 128 + j) * PW + 6 * 256 + head * 64 + ch * 8;
        const u32x4 kr = *(const u32x4*)src, vr = *(const u32x4*)(src + 256);
        *(u32x4*)(Kr + (h * 128 + j) * PK + ch * 8) = kr;
#pragma unroll
        for (int e = 0; e < 8; ++e) Vt[(h * 64 + ch * 8 + e) * PT + j] = u16at(vr, e);
        const int hd = pc >> 9, e_ = (pc >> 3) & 63;
        const int h2 = hd >> 1, dir = hd & 1;
        const u32x4 sr = *(const u32x4*)(KV + ((size_t)(cgi * 4 + 2 * hp + h2) * 2 + dir) * 4096 + e_ * 64 + ch * 8);
        *(u32x4*)(St + (hd * 64 + e_) * PK + ch * 8) = sr;
    }
    const int h = wave >> 2, isub = wave & 3; const int head = 2 * hp + h;
    const int irow = cgi * 128 + isub * 32 + r32;
    bf16_t* qp = P + (size_t)irow * PW + 5 * 256 + head * 64;
    bf16x8 qf[4];
#pragma unroll
    for (int ks = 0; ks < 4; ++ks) qf[ks] = *(const bf16x8*)(qp + 16 * ks + 8 * hi);
    __syncthreads();
    const float lgf = ret_lg2(a, layer, 0, head), lgb = ret_lg2(a, layer, 1, head);
    const int ipos = isub * 32 + r32;
    f32x16 o0 = f32x16{}, o1 = f32x16{};
    const bf16_t* kb = Kr + h * 128 * PK; const bf16_t* vb = Vt + h * 64 * PT;
#pragma nounroll
    for (int jt = 0; jt < 4; ++jt) {
        f32x16 s = f32x16{};
#pragma unroll
        for (int ks = 0; ks < 4; ++ks) s = mfma32(*(const bf16x8*)(kb + (32 * jt + r32) * PK + 16 * ks + 8 * hi), qf[ks], s);
#pragma unroll
        for (int r = 0; r < 16; ++r) { const int j = 32 * jt + crow(r, hi); const int dist = ipos - j;
            const float w = dist >= 0 ? __builtin_amdgcn_exp2f((float)dist * lgf) : __builtin_amdgcn_exp2f((float)(-dist) * lgb); s[r] *= w; }
        const bf16x8 pb0 = pack8r(s, 0), pb1 = pack8r(s, 8);
#pragma unroll
        for (int jj = 0; jj < 2; ++jj) {
            const int j16 = 32 * jt + 16 * jj; const bf16x8 pb = jj ? pb1 : pb0;
            const bf16x8 A0 = mk8(*(const u32x2*)(vb + r32 * PT + j16 + 4 * hi), *(const u32x2*)(vb + r32 * PT + j16 + 8 + 4 * hi));
            const bf16x8 A1 = mk8(*(const u32x2*)(vb + (32 + r32) * PT + j16 + 4 * hi), *(const u32x2*)(vb + (32 + r32) * PT + j16 + 8 + 4 * hi));
            o0 = mfma32(A0, pb, o0); o1 = mfma32(A1, pb, o1);
        }
    }
#pragma nounroll
    for (int dir = 0; dir < 2; ++dir) {
        const bf16_t* sb = St + ((h * 2 + dir) * 64) * PK;
        f32x16 x0 = f32x16{}, x1 = f32x16{};
#pragma unroll
        for (int ks = 0; ks < 4; ++ks) {
            x0 = mfma32(*(const bf16x8*)(sb + r32 * PK + 16 * ks + 8 * hi), qf[ks], x0);
            x1 = mfma32(*(const bf16x8*)(sb + (32 + r32) * PK + 16 * ks + 8 * hi), qf[ks], x1);
        }
        const float wq = dir == 0 ? exp2f((float)(ipos + 1) * lgf) : exp2f((float)(128 - ipos) * lgb);
#pragma unroll
        for (int r = 0; r < 16; ++r) { o0[r] += wq * x0[r]; o1[r] += wq * x1[r]; }
    }
    float ss = 0.f;
#pragma unroll
    for (int r = 0; r < 16; ++r) ss += o0[r] * o0[r] + o1[r] * o1[r];
    ss += pg8::shx(ss, 32);
    const float rn = 1.0f / sqrtf(ss * (1.0f / 64.0f) + EPS);
    const bf16_t* gp = P + (size_t)irow * PW + 8 * 256 + head * 64;
#pragma unroll
    for (int rg = 0; rg < 4; ++rg) {
        const u32x2 g0 = *(const u32x2*)(gp + 8 * rg + 4 * hi), g1 = *(const u32x2*)(gp + 32 + 8 * rg + 4 * hi);
        u32x2 w0, w1;
        w0.x = cvtpk(o0[4 * rg] * rn * bf2f(g0.x & 0xffffu), o0[4 * rg + 1] * rn * bf2f(g0.x >> 16)); w0.y = cvtpk(o0[4 * rg + 2] * rn * bf2f(g0.y & 0xffffu), o0[4 * rg + 3] * rn * bf2f(g0.y >> 16));
        w1.x = cvtpk(o1[4 * rg] * rn * bf2f(g1.x & 0xffffu), o1[4 * rg + 1] * rn * bf2f(g1.x >> 16)); w1.y = cvtpk(o1[4 * rg + 2] * rn * bf2f(g1.y & 0xffffu), o1[4 * rg + 3] * rn * bf2f(g1.y >> 16));
        *(u32x2*)(qp + 8 * rg + 4 * hi) = w0; *(u32x2*)(qp + 32 + 8 * rg + 4 * hi) = w1;
    }
    __syncthreads();
}

__device__ __forceinline__ void sc_rows(const Args& a, int layer, const int wave0) {
    const int gtid = blockIdx.x * NTHR + (wave0 * 64 + pg8::lane_now()), gthreads = gridDim.x * NTHR;
    bf16_t* P = (bf16_t*)(a.ws + WS_P);
    const float* scw = a.in[15] + layer * 3 * 256;
    for (int idx = gtid; idx < T_ALL * 32; idx += gthreads) {
        const int R = idx >> 5, cg8 = idx & 31;
        const int L = R < T_PROMPT ? 2048 : 8192, t = R & (L - 1);
        bf16_t* pr = P + (size_t)R * PW + 9 * 256 + 8 * cg8;
        const u32x4 zz = (u32x4){0u, 0u, 0u, 0u};
        const u32x4 sb = *(const u32x4*)pr;
        const u32x4 cc = *(const u32x4*)(pr + 256), hc = *(const u32x4*)(pr + 512);
        const u32x4 cm = t > 0 ? *(const u32x4*)(pr + 256 - PW) : zz, hm = t > 0 ? *(const u32x4*)(pr + 512 - PW) : zz;
        const u32x4 cp = t < L - 1 ? *(const u32x4*)(pr + 256 + PW) : zz, hp = t < L - 1 ? *(const u32x4*)(pr + 512 + PW) : zz;
        float o[8];
#pragma unroll
        for (int e = 0; e < 8; ++e) { const int lc = pi_slot(8 * cg8 + e);
            const float y = scw[lc] * (bf2f(u16at(cm, e)) * bf2f(u16at(hm, e))) + scw[256 + lc] * (bf2f(u16at(cc, e)) * bf2f(u16at(hc, e))) + scw[512 + lc] * (bf2f(u16at(cp, e)) * bf2f(u16at(hp, e)));
            o[e] = bf2f(u16at(sb, e)) * y; }
        u32x4 w; w.x = cvtpk(o[0], o[1]); w.y = cvtpk(o[2], o[3]); w.z = cvtpk(o[4], o[5]); w.w = cvtpk(o[6], o[7]);
        *(u32x4*)pr = w;
    }
}


#ifndef STOP_AFTER
#define STOP_AFTER 0
#endif
__device__ __forceinline__ void dbg_fold(const Args& a, const bf16_t* src, int ld, int ncol3, const int wave0) {
    const int gtid = blockIdx.x * NTHR + (wave0 * 64 + pg8::lane_now()), gthreads = gridDim.x * NTHR;
    for (int idx = gtid; idx < T_ALL * 1024; idx += gthreads) { const int r = idx >> 10, c = idx & 1023; float v = 0.f;
        for (int k = 0; k < ncol3; ++k) v += bf2f(src[(size_t)r * ld + c + 1024 * k]);
        a.out[idx] = v; }
}

#define GAS __attribute__((address_space(1)))
#define XB_TMO      128
#define XB_XCNT(j)  (256  + 64 * (j))
#define XB_XSUB(j)  (1280 + 64 * (j))
#define XB_XGEN(j)  (2304 + 64 * (j))
#define XB_TOP      3328
#define XB_TOPGEN   3392
#define XCD_BAR_WORDS 3456
#define XB_SPIN_CAP (1u << 18)

__device__ __forceinline__ unsigned xb_ld(unsigned* p)              { return __hip_atomic_load(p, __ATOMIC_RELAXED, __HIP_MEMORY_SCOPE_AGENT); }
__device__ __forceinline__ unsigned xb_add(unsigned* p, unsigned v) { return __hip_atomic_fetch_add(p, v, __ATOMIC_RELAXED, __HIP_MEMORY_SCOPE_AGENT); }
__device__ __forceinline__ unsigned xb_xcc_id() { return (unsigned)__builtin_amdgcn_s_getreg((3 << 11) | 20) & 0xFu; }
#define XB_SPIN(cond, bar) do { unsigned _sp = 0; while (cond) { __builtin_amdgcn_s_sleep(1); \
    if ((++_sp & 255u) == 0u) { if (xb_ld(&(bar)[XB_TMO])) break; if (_sp > XB_SPIN_CAP) { atomicAdd(&(bar)[XB_TMO], 1u); break; } } } } while (0)

struct XcdBarrier {
    unsigned* bar; unsigned x; int w0;
    volatile LAS unsigned* st;
};

__device__ __forceinline__ XcdBarrier xcd_barrier_post(unsigned* bar, volatile LAS unsigned* st, int w0) {
    XcdBarrier b; b.bar = bar; b.x = xb_xcc_id(); b.st = st; b.w0 = w0;
    if (w0 == 0 && pg8::lane_now() == 0) (void)xb_add(&bar[XB_XCNT(b.x)], 1u);
    return b;
}
__device__ __forceinline__ void xcd_barrier_complete(unsigned* bar, unsigned x, unsigned& nloc, unsigned& nx) {
    const unsigned G = gridDim.x * gridDim.y * gridDim.z;
    unsigned sum, cnt, mine, sp = 0u;
    for (;;) {
        sum = 0u; cnt = 0u; mine = 0u;
#pragma unroll
        for (unsigned j = 0; j < 16; ++j) { const unsigned c = xb_ld(&bar[XB_XCNT(j)]); sum += c; cnt += (c > 0u) ? 1u : 0u; mine = (j == x) ? c : mine; }
        if (sum == G) break;
        __builtin_amdgcn_s_sleep(1);
        if ((++sp & 255u) == 0u) { if (xb_ld(&bar[XB_TMO])) break; if (sp > XB_SPIN_CAP) { atomicAdd(&bar[XB_TMO], 1u); break; } }
    }
    nloc = mine > 0u ? mine : 1u; nx = cnt > 0u ? cnt : 1u;
}

__device__ __forceinline__ void xcd_barrier(const XcdBarrier& b) {
    asm volatile("s_waitcnt vmcnt(0)" ::: "memory");
    __syncthreads();
    if (b.w0 == 0 && pg8::lane_now() == 0) {
        unsigned* bar = b.bar;
        __builtin_amdgcn_s_waitcnt(0);
        unsigned nloc = b.st[0], nx = b.st[1];
        if (nloc == 0u) { xcd_barrier_complete(bar, b.x, nloc, nx); b.st[0] = nloc; b.st[1] = nx; }
        const unsigned old = xb_add(&bar[XB_XSUB(b.x)], 1u);
        const unsigned gen = old / nloc;
        if (old + 1u == (gen + 1u) * nloc) {
            __builtin_amdgcn_fence(__ATOMIC_RELEASE, "agent");
            asm volatile("s_waitcnt vmcnt(0)" ::: "memory");
            const unsigned og = xb_add(&bar[XB_TOP], 1u);
            const unsigned tg = og / nx;
            if (og + 1u == (tg + 1u) * nx) xb_add(&bar[XB_TOPGEN], 1u);
            else XB_SPIN(xb_ld(&bar[XB_TOPGEN]) == tg, bar);
            __builtin_amdgcn_fence(__ATOMIC_ACQUIRE, "agent");
            xb_add(&bar[XB_XGEN(b.x)], 1u);
            asm volatile("s_waitcnt vmcnt(0)" ::: "memory");
        } else {
            XB_SPIN(xb_ld(&bar[XB_XGEN(b.x)]) == gen, bar);
            __builtin_amdgcn_fence(__ATOMIC_ACQUIRE, "agent");
            asm volatile("s_waitcnt vmcnt(0)" ::: "memory");
        }
    }
    __syncthreads();
}

template <class Epi>
__device__ __forceinline__ void run_gemm(unsigned char* lds, const bf16_t* A, const bf16_t* Bt, int M, int N, int K, int lda, int ldb, const Epi& E, const int wave0) {
    pg8::Gemm g{A, Bt, M, N, K, lda, ldb}; pg8::StaticOrder S; S.init(M, N, (int)gridDim.x, (int)blockIdx.x);
    pg8::gemm_phase<Epi, pg8::StaticOrder, true, true>((PG8_LAS unsigned char*)lds, g, S, E, wave0);
}

__global__ void __launch_bounds__(NTHR, 2) fwd_megakernel(Args a) {
    extern __shared__ __attribute__((aligned(16))) unsigned char lds[];
    cg::grid_group grid = cg::this_grid();
    const int wave0 = __builtin_amdgcn_readfirstlane((int)threadIdx.x >> 6);
    const int G = gridDim.x, bx = blockIdx.x;
    volatile LAS unsigned* xst = (volatile LAS unsigned*)((LAS unsigned char*)lds + (LDS_BYTES - 64));
    if (wave0 == 0 && pg8::lane_now() == 0) { xst[0] = 0u; xst[1] = 0u; }
    __syncthreads();
    XcdBarrier xbar = xcd_barrier_post((unsigned*)(a.ws + WS_CTL), xst, wave0);
    grid.sync();
    unsigned char* ws = a.ws;
    bf16_t* P = (bf16_t*)(ws + WS_P); bf16_t* XN = (bf16_t*)(ws + WS_XN);
    float* rcos = (float*)(ws + WS_MISC); float* rsin = rcos + 2048;
    bf16_t* YB = (bf16_t*)(ws + WS_S + S_GATE); bf16_t* XN2 = (bf16_t*)(ws + WS_S + 160 * MiB); bf16_t* ACT = (bf16_t*)(ws + WS_S + 224 * MiB); float* XB = (float*)(ws + 37 * MiB); unsigned* CNT = (unsigned*)(ws + WS_CTL) + 8192;
    float* MF = (float*)(ws + WS_S + S_MF); bf16_t* MB = (bf16_t*)(ws + WS_S + S_MB);

#if PROBE_T
    unsigned long long tprev = __builtin_amdgcn_s_memrealtime(), tacc = 0;
#endif
    for (int layer = 0; layer < 2; ++layer) {
        const float* ng = a.in[2] + layer * 4 * DM;
        if (EN & 1) prep_weights(a, layer, lds, wave0);
        __syncthreads();
        if (layer == 0 && bx == G - 1) rope_table(rcos, rsin, wave0);
        if (EN & 2) for (int it = bx; it < 640; it += G) hy_filter_item(a, layer, it, lds, wave0);
        GSYNC(); TMARK(1);
        if (EN & 2) for (int it = bx; it < 512; it += G) hy_window_item(a, it, lds, wave0);
        norm_x_rows(a, layer, 0, ng, XN, wave0);
        GSYNC(); TMARK(2);
        for (int g = 0; g < NGROUP; ++g) {
            bf16_t* xa = (g & 1) ? XN2 : XN; bf16_t* xb = (g & 1) ? XN : XN2;
            pg8::EpiIn E{P, g * GROUP, a.in[4] + layer * 128, rcos, rsin, QSCALE};
            if (EN & 4) run_gemm(lds, xa, (const bf16_t*)(ws + WS_WIN), GROUP, PW, DM, DM, DM, E, wave0);
#if PROBE_DUP & 4
            run_gemm(lds, xa, (const bf16_t*)(ws + WS_WIN), GROUP, PW, DM, DM, DM, E, wave0);
#endif
            if (g + 1 < NGROUP) norm_x_rows(a, layer, g + 1, ng, xb, wave0);
            GSYNC(); TMARK(2);
        }
        if (STOP_AFTER == 1) { dbg_fold(a, P, PW, 3, wave0); return; }
        if (EN & 8) for (int it = bx; it < 768 * 2; it += G) ret_kv_item(a, layer, it >> 1, it & 1, lds, wave0);
        GSYNC(); TMARK(3);
        if (EN & 8) ret_scan(a, layer, wave0);
        GSYNC(); TMARK(3);
        if (EN & 16) for (int it = bx; it < 256; it += G) hyena_item<8>(a, layer, T_PROMPT + (it >> 5) * 8192, it & 31, lds, true, wave0);
        if (EN & 32) for (int it = bx; it < 512; it += G) hyena_item<2>(a, layer, (it >> 5) * 2048, it & 31, lds, true, wave0);
        if (EN & 64) for (int it = bx; it < 512; it += G) { const int pair = it & 15, qb = it >> 4; attn_unit(P, T_PROMPT + (pair >> 1) * 8192, 8192, pair & 1, qb, lds, true, wave0); }
        if (EN & 64) for (int it = bx; it < 256; it += G) { const int pair = it & 31, qb = it >> 5; attn_unit(P, (pair >> 1) * 2048, 2048, pair & 1, qb, lds, true, wave0); }
#if PROBE_DUP & 1
        { const bool never = (a.out == nullptr);
        for (int it = bx; it < 512; it += G) { const int pair = it & 15, qb = it >> 4; attn_unit(P, T_PROMPT + (pair >> 1) * 8192, 8192, pair & 1, qb, lds, never, wave0); }
        for (int it = bx; it < 256; it += G) { const int pair = it & 31, qb = it >> 5; attn_unit(P, (pair >> 1) * 2048, 2048, pair & 1, qb, lds, never, wave0); } }
#endif
#if PROBE_DUP & 2
        { const bool never = (a.out == nullptr);
        for (int it = bx; it < 256; it += G) hyena_item<8>(a, layer, T_PROMPT + (it >> 5) * 8192, it & 31, lds, never, wave0);
        for (int it = bx; it < 512; it += G) hyena_item<2>(a, layer, (it >> 5) * 2048, it & 31, lds, never, wave0); }
#endif
        if (EN & 128) for (int it = bx; it < 768 * 2; it += G) ret_out_item(a, layer, it >> 1, it & 1, lds, wave0);
        if (EN & 256) sc_rows(a, layer, wave0);
        GSYNC(); TMARK(3);
        if (STOP_AFTER == 2) { dbg_fold(a, P, PW, 3, wave0); return; }
        norm_x_rows(a, layer, 0, ng, XN, wave0);
        { pg8::EpiY E{YB}; run_gemm(lds, P, (const bf16_t*)(ws + WS_WB), GROUP, 4096, 256, PW, 256, E, wave0); }
        GSYNC(); TMARK(5);
        for (int g = 0; g < NGROUP; ++g) {
            const unsigned inst = (unsigned)(layer * NGROUP + g);
            float* outg = a.out + (size_t)g * GROUP * DM;
            const float* xg = layer == 0 ? (g < 2 ? a.in[0] + (size_t)g * GROUP * DM : a.in[1] + (size_t)(g - 2) * GROUP * DM) : outg;
            { pg8::EpiMerge E{YB, MB}; run_gemm(lds, XN, (const bf16_t*)(ws + WS_WG), GROUP, 4096, DM, DM, DM, E, wave0); }
            GSYNC(); TMARK(6);
            { pg8::RmsStats s1{XB, CNT, 16u * (inst + 1u)}, s2{XB + 65536, CNT + 4096, 16u * (inst + 1u)};
              pg8::EpiRmsResRms E{xg, outg, XN, ng + DM, ng + 2 * DM, s1, s2}; run_gemm(lds, MB, (const bf16_t*)(ws + WS_WO), GROUP, DM, DM, DM, DM, E, wave0); }
            GSYNC(); TMARK(7);
            { pg8::EpiSwiglu E{ACT}; run_gemm(lds, XN, (const bf16_t*)(ws + WS_WFI), GROUP, 2 * DFF, DM, DM, DM, E, wave0); }
#if PROBE_DUP & 8
            { pg8::EpiSwiglu E{ACT}; run_gemm(lds, XN, (const bf16_t*)(ws + WS_WFI), GROUP, 2 * DFF, DM, DM, DM, E, wave0); }
#endif
            GSYNC(); TMARK(6);
            { pg8::RmsStats s3{XB + 2 * 65536, CNT + 2 * 4096, 16u * (inst + 1u)};
              pg8::EpiRmsRes E{outg, outg, ng + 3 * DM, s3}; run_gemm(lds, ACT, (const bf16_t*)(ws + WS_WFO), GROUP, DM, DFF, DFF, DFF, E, wave0); }
            if (g + 1 < NGROUP) {
                norm_x_rows(a, layer, g + 1, ng, XN, wave0);
                pg8::EpiY E{YB}; run_gemm(lds, P + (size_t)(g + 1) * GROUP * PW, (const bf16_t*)(ws + WS_WB), GROUP, 4096, 256, PW, 256, E, wave0);
#if PROBE_DUP & 16
                run_gemm(lds, P + (size_t)(g + 1) * GROUP * PW, (const bf16_t*)(ws + WS_WB), GROUP, 4096, 256, PW, 256, E, wave0);
#endif
            }
            GSYNC(); TMARK(5);
        }
    }
#if PROBE_T
    if (bx == 0 && wave0 == 0 && pg8::lane_now() == 0) a.out[0] += (float)tacc * 0.0005f;
#endif
}

extern "C" void kernel_launch(void* const* d_in, const int* in_sizes, int n_in, void* d_out, int out_size, void* d_ws, size_t ws_size, hipStream_t stream) {
    static int grid = 0;
    if (grid == 0) {
        if (n_in != 20 || out_size != T_ALL * DM || ws_size < WS_NEED) { fprintf(stderr, "kernel_launch: unexpected shapes: n_in %d out %d ws %zu (need %zu)\n", n_in, out_size, ws_size, (size_t)WS_NEED); grid = -1; return; }
        int dev = 0, cus = 0, per_cu = 0;
        hipGetDevice(&dev); hipDeviceGetAttribute(&cus, hipDeviceAttributeMultiprocessorCount, dev);
        hipFuncSetAttribute((const void*)fwd_megakernel, hipFuncAttributeMaxDynamicSharedMemorySize, LDS_BYTES);
        hipOccupancyMaxActiveBlocksPerMultiprocessor(&per_cu, (const void*)fwd_megakernel, NTHR, LDS_BYTES);
        (void)hipGetLastError();
        if (per_cu < 1) per_cu = 1;
        grid = cus * 1;
        fprintf(stderr, "kernel_launch: cus %d per_cu %d grid %d\n", cus, per_cu, grid);
    }
    if (grid < 0) return;
    Args a{};
    for (int i = 0; i < 20; ++i) a.in[i] = (const float*)d_in[i];
    a.out = (float*)d_out; a.ws = (unsigned char*)d_ws;
    if (hipMemsetAsync((char*)d_ws + WS_CTL, 0, CTL_BYTES, stream) != hipSuccess) { fprintf(stderr, "memset failed\n"); return; }
    void* args[] = {&a};
    hipError_t e = hipLaunchCooperativeKernel((const void*)fwd_megakernel, dim3(grid), dim3(NTHR), args, LDS_BYTES, stream);
    if (e != hipSuccess) fprintf(stderr, "cooperative launch failed: %s (grid %d)\n", hipGetErrorString(e), grid);
}
```

```cpp
#include <hip/hip_runtime.h>
#include <hip/hip_cooperative_groups.h>
#include <cstdio>
#include <cstdint>
namespace pg8 {
#define PG8_LAS __attribute__((address_space(3)))
typedef unsigned short bf16_t;
typedef short bf16x8 __attribute__((ext_vector_type(8)));
typedef float f32x4 __attribute__((ext_vector_type(4)));
typedef unsigned u32x4 __attribute__((ext_vector_type(4)));
__device__ __forceinline__ int opq(int x) { asm volatile("" : "+v"(x)); return x; }
__device__ __forceinline__ int lane_now() { int l; asm volatile("v_mbcnt_lo_u32_b32 %0, -1, 0\n\tv_mbcnt_hi_u32_b32 %0, -1, %0" : "=v"(l)); return l; }
__device__ __forceinline__ float shx(float v, int o) { return __builtin_bit_cast(float, __builtin_amdgcn_ds_bpermute((lane_now() ^ o) << 2, __builtin_bit_cast(int, v))); }
constexpr int BM = 256, BK = 64, HALF = 128, HTB = HALF * BK * 2  , STAGE_BYTES = 8 * HTB, NXCD = 8, WGM = 8;

__host__ __device__ __forceinline__ int lds_byte(int r, int c) { const int st = (r >> 4) * 2 + (c >> 5), rr = r & 15, cc = c & 31, ob = rr * 64 + cc * 2; return st * 1024 + (ob ^ (((ob >> 9) & 1) << 5)); }
__host__ __device__ __forceinline__ void stage_rc(int b, int& R, int& C) { const int st = b / 1024, sb = b % 1024, swz = sb ^ (((sb >> 9) & 1) << 5); R = (st >> 1) * 16 + swz / 64; C = (st & 1) * 32 + (swz % 64) / 2; }
__host__ __device__ __forceinline__ int perm32(int rho) { const int n = rho >> 4, i = rho & 15; return 8 * (i >> 2) + 4 * n + (i & 3); }

struct Unit { int pm, pn; };
struct Gemm { const bf16_t* A; const bf16_t* Bt; int M, N, K, lda, ldb; };

struct StaticOrder {
    int nM, nN, nwg, G, c;
    __host__ __device__ void init(int M, int N, int G_, int c_) { nM = M / BM; nN = N / BM; nwg = nM * nN; G = G_; c = c_; }
    __host__ __device__ bool next(int i, Unit& u) const {
        const long L = (long)i * G + c; if (L >= nwg) return false;
        int wgid = (int)L; { const int q = nwg / NXCD, r = nwg % NXCD, xcd = wgid % NXCD, off = wgid / NXCD; wgid = (xcd < r ? xcd * (q + 1) : r * (q + 1) + (xcd - r) * q) + off; }
        const int nig = WGM * nN, gid = wgid / nig, fm = gid * WGM, gsz = (nM - fm) < WGM ? (nM - fm) : WGM;
        u.pm = fm + ((wgid % nig) % gsz); u.pn = (wgid % nig) / gsz; return true;
    }
    __device__ __forceinline__ void a_ready(const Unit&) const {}
    __device__ __forceinline__ void done(const Unit&) const {}
};

typedef float f32x2 __attribute__((ext_vector_type(2)));
typedef __bf16 bf16x2_t __attribute__((ext_vector_type(2)));
__device__ __forceinline__ unsigned cvt_pk_bf16(float lo, float hi) { f32x2 v = {lo, hi}; bf16x2_t b = __builtin_convertvector(v, bf16x2_t); return __builtin_bit_cast(unsigned, b); }
typedef float f32x16 __attribute__((ext_vector_type(16)));
__device__ __forceinline__ f32x4 ldg4(const float* p) { return *(const f32x4*)p; }
__device__ __forceinline__ u32x4 pack8(const f32x4 a, const f32x4 b) { u32x4 w; w.x = cvt_pk_bf16(a[0], a[1]); w.y = cvt_pk_bf16(a[2], a[3]); w.z = cvt_pk_bf16(b[0], b[1]); w.w = cvt_pk_bf16(b[2], b[3]); return w; }
__device__ __forceinline__ float bf2f(unsigned h) { return __uint_as_float(h << 16); }
__device__ __forceinline__ f32x4 unpack_lo(const u32x4 w) { return (f32x4){__uint_as_float(w.x << 16), __uint_as_float(w.x & 0xffff0000u), __uint_as_float(w.y << 16), __uint_as_float(w.y & 0xffff0000u)}; }
__device__ __forceinline__ f32x4 unpack_hi(const u32x4 w) { return (f32x4){__uint_as_float(w.z << 16), __uint_as_float(w.z & 0xffff0000u), __uint_as_float(w.w << 16), __uint_as_float(w.w & 0xffff0000u)}; }
__device__ __forceinline__ int branch_tile(int n) { return n == 0 ? 0 : (n == 1 ? 3 : (n == 2 ? 5 : 9)); }
__device__ __forceinline__ float sigm(float v) { return __builtin_amdgcn_rcpf(1.0f + __builtin_amdgcn_exp2f(-1.4426950408889634f * v)); }

struct EpiIn {
    static constexpr bool PERM = true, AFTER_DRAIN = false, BRANCH_A = false;
    bf16_t* P; int row_base; const float* qkn; const float* rcos; const float* rsin; float qscale;
    __device__ __forceinline__ void operator()(const f32x4 (&acc)[2][2][4][2], const Unit& u, int wr, int wc, int fr_, int fq_) const {
        const int ln_ = lane_now(); const int fr = ln_ & 15, fq = ln_ >> 4; (void)fr_; (void)fq_;
        const int pn = u.pn;
        const bool is_k = (pn == 1 && wc < 2);
        const bool do_norm = (pn == 0) || is_k;
        const bool do_rope = do_norm || pn == 5 || pn == 6;
        const float scale = (pn == 0) ? qscale : (pn == 6 ? 0.125f : 1.0f);
        const bool do_silu = (pn == 8);
        const float* gp = qkn + (is_k ? 64 : 0) + 4 * fq;
#pragma unroll
        for (int ai = 0; ai < 2; ++ai)
#pragma unroll
            for (int m = 0; m < 4; ++m) {
                const int row = row_base + u.pm * BM + ai * HALF + wr * 64 + m * 16 + fr;
                f32x4 v[2][2];
#pragma unroll
                for (int bj = 0; bj < 2; ++bj)
#pragma unroll
                    for (int n = 0; n < 2; ++n) v[bj][n] = acc[ai][bj][m][n];
                if (do_norm) {
                    float ss = 0.f;
#pragma unroll
                    for (int bj = 0; bj < 2; ++bj)
#pragma unroll
                        for (int n = 0; n < 2; ++n) ss += (v[bj][n][0] * v[bj][n][0] + v[bj][n][1] * v[bj][n][1]) + (v[bj][n][2] * v[bj][n][2] + v[bj][n][3] * v[bj][n][3]);
                    ss += shx(ss, 16); ss += shx(ss, 32);
                    const float rn = 1.0f / sqrtf(ss * (1.0f / 64.0f) + 1e-6f);
#pragma unroll
                    for (int bj = 0; bj < 2; ++bj)
#pragma unroll
                        for (int n = 0; n < 2; ++n) v[bj][n] = v[bj][n] * rn * ldg4(gp + 32 * bj + 16 * n);
                }
                if (do_rope) {
                    const int L = row < 32768 ? 2048 : 8192; const int t = row & (L - 1);
#pragma unroll
                    for (int bj = 0; bj < 2; ++bj) {
                        const int pos = bj == 0 ? (t >> 6) : (t & 63);
                        const f32x4 c = ldg4(rcos + pos * 16 + 4 * fq), s = ldg4(rsin + pos * 16 + 4 * fq);
                        const f32x4 a = v[bj][0], b = v[bj][1];
                        v[bj][0] = a * c - b * s; v[bj][1] = b * c + a * s;
                    }
                }
#pragma unroll
                for (int bj = 0; bj < 2; ++bj) {
                    f32x4 x0 = v[bj][0] * scale, x1 = v[bj][1] * scale;
                    if (do_silu) {
#pragma unroll
                        for (int i = 0; i < 4; ++i) { x0[i] = x0[i] * sigm(x0[i]); x1[i] = x1[i] * sigm(x1[i]); }
                    }
                    *(u32x4*)(P + ((unsigned)row * 3072u + (unsigned)(pn * 256 + 64 * wc + 32 * bj + 8 * fq))) = pack8(x0, x1);
                }
                asm volatile("" ::: "memory");
            }
    }
};
struct EpiGate {
    static constexpr bool PERM = true, AFTER_DRAIN = false, BRANCH_A = false;
    bf16_t* O; int ldc;
    __device__ __forceinline__ void operator()(const f32x4 (&acc)[2][2][4][2], const Unit& u, int wr, int wc, int fr_, int fq_) const {
        const int ln_ = lane_now(); const int fr = ln_ & 15, fq = ln_ >> 4; (void)fr_; (void)fq_;
#pragma unroll
        for (int ai = 0; ai < 2; ++ai)
#pragma unroll
            for (int m = 0; m < 4; ++m) {
                const int row = u.pm * BM + ai * HALF + wr * 64 + m * 16 + fr;
#pragma unroll
                for (int bj = 0; bj < 2; ++bj) {
                    f32x4 x0 = acc[ai][bj][m][0], x1 = acc[ai][bj][m][1];
#pragma unroll
                    for (int i = 0; i < 4; ++i) { x0[i] = sigm(x0[i]); x1[i] = sigm(x1[i]); }
                    *(u32x4*)(O + ((unsigned)row * (unsigned)ldc + (unsigned)(u.pn * BM + bj * HALF + wc * 32 + 8 * fq))) = pack8(x0, x1);
                }
            }
    }
};
struct EpiBranch {
    static constexpr bool PERM = true, AFTER_DRAIN = false, BRANCH_A = false;
    const bf16_t* G; float* MF; bf16_t* MB; int nbr;
    __device__ __forceinline__ void operator()(const f32x4 (&acc)[2][2][4][2], const Unit& u, int wr, int wc, int fr_, int fq_) const {
        const int ln_ = lane_now(); const int fr = ln_ & 15, fq = ln_ >> 4; (void)fr_; (void)fq_;
#pragma unroll
        for (int ai = 0; ai < 2; ++ai)
#pragma unroll
            for (int m = 0; m < 4; ++m) {
                const int row = u.pm * BM + ai * HALF + wr * 64 + m * 16 + fr;
#pragma unroll
                for (int bj = 0; bj < 2; ++bj) {
                    const int col = u.pn * BM + bj * HALF + wc * 32 + 8 * fq;
                    const u32x4 gw = *(const u32x4*)(G + ((unsigned)row * 4096u + (unsigned)(nbr * 1024 + col)));
                    f32x4 x0 = acc[ai][bj][m][0] * unpack_lo(gw), x1 = acc[ai][bj][m][1] * unpack_hi(gw);
                    float* mp = MF + ((unsigned)row * 1024u + (unsigned)col);
                    if (nbr != 0) { x0 = x0 + ldg4(mp); x1 = x1 + ldg4(mp + 4); }
                    if (nbr == 3) *(u32x4*)(MB + ((unsigned)row * 1024u + (unsigned)col)) = pack8(x0, x1);
                    else { *(f32x4*)mp = x0; *(f32x4*)(mp + 4) = x1; }
                    asm volatile("" ::: "memory");
                }
            }
    }
};
struct EpiF32 {
    static constexpr bool PERM = true, AFTER_DRAIN = false, BRANCH_A = false;
    float* O; int ldc;
    __device__ __forceinline__ void operator()(const f32x4 (&acc)[2][2][4][2], const Unit& u, int wr, int wc, int fr_, int fq_) const {
        const int ln_ = lane_now(); const int fr = ln_ & 15, fq = ln_ >> 4; (void)fr_; (void)fq_;
#pragma unroll
        for (int ai = 0; ai < 2; ++ai)
#pragma unroll
            for (int m = 0; m < 4; ++m) {
                const int row = u.pm * BM + ai * HALF + wr * 64 + m * 16 + fr;
#pragma unroll
                for (int bj = 0; bj < 2; ++bj) {
                    float* op = O + ((unsigned)row * (unsigned)ldc + (unsigned)(u.pn * BM + bj * HALF + wc * 32 + 8 * fq));
                    *(f32x4*)op = acc[ai][bj][m][0]; *(f32x4*)(op + 4) = acc[ai][bj][m][1];
                }
            }
    }
};
struct EpiSwiglu {
    static constexpr bool PERM = true, AFTER_DRAIN = false, BRANCH_A = false;
    bf16_t* O;
    __device__ __forceinline__ void operator()(const f32x4 (&acc)[2][2][4][2], const Unit& u, int wr, int wc, int fr_, int fq_) const {
        const int ln_ = lane_now(); const int fr = ln_ & 15, fq = ln_ >> 4; (void)fr_; (void)fq_;
#pragma unroll
        for (int ai = 0; ai < 2; ++ai)
#pragma unroll
            for (int m = 0; m < 4; ++m) {
                const int row = u.pm * BM + ai * HALF + wr * 64 + m * 16 + fr;
                f32x4 x0 = acc[ai][0][m][0], x1 = acc[ai][0][m][1];
                const f32x4 u0 = acc[ai][1][m][0], u1 = acc[ai][1][m][1];
#pragma unroll
                for (int i = 0; i < 4; ++i) { x0[i] = x0[i] * sigm(x0[i]) * u0[i]; x1[i] = x1[i] * sigm(x1[i]) * u1[i]; }
                *(u32x4*)(O + ((unsigned)row * 2816u + (unsigned)(u.pn * HALF + wc * 32 + 8 * fq))) = pack8(x0, x1);
            }
    }
};

struct EpiY {
    static constexpr bool PERM = true, AFTER_DRAIN = false, BRANCH_A = true;
    bf16_t* Y;
    __device__ __forceinline__ void operator()(const f32x4 (&acc)[2][2][4][2], const Unit& u, int wr, int wc, int fr_, int fq_) const {
        const int ln_ = lane_now(); const int fr = ln_ & 15, fq = ln_ >> 4; (void)fr_; (void)fq_;
        const int br = u.pn >> 2, ct = u.pn & 3;
#pragma unroll
        for (int ai = 0; ai < 2; ++ai)
#pragma unroll
            for (int m = 0; m < 4; ++m) {
                const int row = u.pm * BM + ai * HALF + wr * 64 + m * 16 + fr;
#pragma unroll
                for (int bj = 0; bj < 2; ++bj) {
                    const int ch0 = 256 * ct + 128 * bj + 32 * wc + 8 * fq;
                    *(u32x4*)(Y + ((unsigned)row * 4096u + (unsigned)(br * 1024 + ch0))) = pack8(acc[ai][bj][m][0], acc[ai][bj][m][1]);
                }
            }
    }
};
struct EpiMerge {
    static constexpr bool PERM = true, AFTER_DRAIN = false, BRANCH_A = false;
    const bf16_t* Y; bf16_t* MB;
    __device__ __forceinline__ void operator()(const f32x4 (&acc)[2][2][4][2], const Unit& u, int wr, int wc, int fr_, int fq_) const {
        const int ln_ = lane_now(); const int fr = ln_ & 15, fq = ln_ >> 4; (void)fr_; (void)fq_;
        const int ch0 = 64 * u.pn + 16 * wc + 4 * fq;
#pragma unroll
        for (int ai = 0; ai < 2; ++ai)
#pragma unroll
            for (int m = 0; m < 4; ++m) {
                const int row = u.pm * BM + ai * HALF + wr * 64 + m * 16 + fr;
                typedef unsigned u32x2_t __attribute__((ext_vector_type(2)));
                const bf16_t* yp = Y + ((unsigned)row * 4096u + (unsigned)ch0);
                const u32x2_t ya = *(const u32x2_t*)yp, yb = *(const u32x2_t*)(yp + 1024), yc = *(const u32x2_t*)(yp + 2048), yd = *(const u32x2_t*)(yp + 3072);
                const u32x4 yab = (u32x4){ya.x, ya.y, yb.x, yb.y}, ycd = (u32x4){yc.x, yc.y, yd.x, yd.y};
                const f32x4 y0 = unpack_lo(yab), y1 = unpack_hi(yab), y2 = unpack_lo(ycd), y3 = unpack_hi(ycd);
                f32x4 o;
#pragma unroll
                for (int i = 0; i < 4; ++i) o[i] = sigm(acc[ai][0][m][0][i]) * y0[i] + sigm(acc[ai][0][m][1][i]) * y1[i] + sigm(acc[ai][1][m][0][i]) * y2[i] + sigm(acc[ai][1][m][1][i]) * y3[i];
                u32x2_t w; w.x = cvt_pk_bf16(o[0], o[1]); w.y = cvt_pk_bf16(o[2], o[3]);
                *(u32x2_t*)(MB + ((unsigned)row * 1024u + (unsigned)ch0)) = w;
                asm volatile("" ::: "memory");
            }
    }
};

struct RmsStats {
    float* xbuf;
    unsigned* cnt;
    unsigned want;
    __device__ __forceinline__ void run(const f32x4 (&v)[2][2][4][2], const Unit& u, int wr, int wc, PG8_LAS unsigned char* lds, int wid) const {
        const int lane = lane_now(), fr = lane & 15, fq = lane >> 4;
        PG8_LAS float* Pp = (PG8_LAS float*)lds; PG8_LAS float* S = (PG8_LAS float*)(lds + 4096);
#pragma unroll
        for (int ai = 0; ai < 2; ++ai)
#pragma unroll
            for (int m = 0; m < 4; ++m) {
                float s = 0.f;
#pragma unroll
                for (int bj = 0; bj < 2; ++bj)
#pragma unroll
                    for (int n = 0; n < 2; ++n) { const f32x4 x = v[ai][bj][m][n]; s += (x[0] * x[0] + x[1] * x[1]) + (x[2] * x[2] + x[3] * x[3]); }
                s += shx(s, 16); s += shx(s, 32);
                if (fq == 0) Pp[(ai * HALF + wr * 64 + m * 16 + fr) * 4 + wc] = s;
            }
        asm volatile("s_waitcnt lgkmcnt(0)" ::: "memory"); __builtin_amdgcn_s_barrier(); asm volatile("" ::: "memory");
        const int row = wid * 64 + lane;
        if (wid < 4) {
            const float t = (Pp[row * 4 + 0] + Pp[row * 4 + 1]) + (Pp[row * 4 + 2] + Pp[row * 4 + 3]);
            __hip_atomic_store(xbuf + ((size_t)(u.pm * BM + row) * 4 + u.pn), t, __ATOMIC_RELAXED, __HIP_MEMORY_SCOPE_AGENT);
            asm volatile("s_waitcnt vmcnt(0)" ::: "memory");
            if (lane == 0) __hip_atomic_fetch_add(cnt + 64 * u.pm, 1u, __ATOMIC_RELAXED, __HIP_MEMORY_SCOPE_AGENT);
        }
        if (wid == 0) {
            unsigned sp = 0;
            while ((unsigned)__builtin_amdgcn_readfirstlane(__hip_atomic_load(cnt + 64 * u.pm, __ATOMIC_RELAXED, __HIP_MEMORY_SCOPE_AGENT)) < want) { __builtin_amdgcn_s_sleep(2); if (++sp > (1u << 22)) break; }
            __builtin_amdgcn_fence(__ATOMIC_ACQUIRE, "agent");
        }
        asm volatile("s_waitcnt vmcnt(0) lgkmcnt(0)" ::: "memory"); __builtin_amdgcn_s_barrier(); asm volatile("" ::: "memory");
        if (wid < 4) {
            const float* sl = xbuf + (size_t)(u.pm * BM + row) * 4; float t = 0.f;
#pragma unroll
            for (int k = 0; k < 4; ++k) t += __hip_atomic_load(sl + k, __ATOMIC_RELAXED, __HIP_MEMORY_SCOPE_AGENT);
            S[row] = 1.0f / sqrtf(t * (1.0f / 1024.0f) + 1e-6f);
        }
        asm volatile("s_waitcnt lgkmcnt(0)" ::: "memory"); __builtin_amdgcn_s_barrier(); asm volatile("" ::: "memory");
    }
};
struct EpiRmsRes {
    static constexpr bool PERM = true, AFTER_DRAIN = true, BRANCH_A = false;
    const float* base; float* out; const float* gain; RmsStats st;
    __device__ __forceinline__ void fused(f32x4 (&acc)[2][2][4][2], const Unit& u, int wr, int wc, int fr_, int fq_, PG8_LAS unsigned char* lds, int wid, int lane_) const {
        (void)fr_; (void)fq_; (void)lane_;
        st.run(acc, u, wr, wc, lds, wid);
        const int lane = lane_now(), fr = lane & 15, fq = lane >> 4;
        const PG8_LAS float* S = (const PG8_LAS float*)(lds + 4096);
#pragma unroll
        for (int ai = 0; ai < 2; ++ai)
#pragma unroll
            for (int m = 0; m < 4; ++m) {
                const int r = ai * HALF + wr * 64 + m * 16 + fr; const float rs = S[r];
#pragma unroll
                for (int bj = 0; bj < 2; ++bj) {
                    const int col = u.pn * BM + bj * HALF + wc * 32 + 8 * fq;
                    const unsigned off = (unsigned)(u.pm * BM + r) * 1024u + (unsigned)col;
                    const f32x4 g0 = ldg4(gain + col), g1 = ldg4(gain + col + 4);
                    const f32x4 b0 = ldg4(base + off), b1 = ldg4(base + off + 4);
                    *(f32x4*)(out + off) = b0 + acc[ai][bj][m][0] * rs * g0; *(f32x4*)(out + off + 4) = b1 + acc[ai][bj][m][1] * rs * g1;
                }
                asm volatile("" ::: "memory");
            }
    }
};
struct EpiRmsResRms {
    static constexpr bool PERM = true, AFTER_DRAIN = true, BRANCH_A = false;
    const float* base; float* out; bf16_t* XN; const float* gain; const float* gain2; RmsStats st1, st2;
    __device__ __forceinline__ void fused(f32x4 (&acc)[2][2][4][2], const Unit& u, int wr, int wc, int fr_, int fq_, PG8_LAS unsigned char* lds, int wid, int lane_) const {
        (void)fr_; (void)fq_; (void)lane_;
        st1.run(acc, u, wr, wc, lds, wid);
        const PG8_LAS float* S = (const PG8_LAS float*)(lds + 4096);
        {
            const int lane = lane_now(), fr = lane & 15, fq = lane >> 4;
#pragma unroll
            for (int ai = 0; ai < 2; ++ai)
#pragma unroll
                for (int m = 0; m < 4; ++m) {
                    const int r = ai * HALF + wr * 64 + m * 16 + fr; const float rs = S[r];
#pragma unroll
                    for (int bj = 0; bj < 2; ++bj) {
                        const int col = u.pn * BM + bj * HALF + wc * 32 + 8 * fq;
                        const unsigned off = (unsigned)(u.pm * BM + r) * 1024u + (unsigned)col;
                        const f32x4 g0 = ldg4(gain + col), g1 = ldg4(gain + col + 4);
                        const f32x4 b0 = ldg4(base + off), b1 = ldg4(base + off + 4);
                        acc[ai][bj][m][0] = b0 + acc[ai][bj][m][0] * rs * g0; acc[ai][bj][m][1] = b1 + acc[ai][bj][m][1] * rs * g1;
                        *(f32x4*)(out + off) = acc[ai][bj][m][0]; *(f32x4*)(out + off + 4) = acc[ai][bj][m][1];
                    }
                    asm volatile("" : "+v"(acc[ai][0][m][0]), "+v"(acc[ai][0][m][1]), "+v"(acc[ai][1][m][0]), "+v"(acc[ai][1][m][1]));
                    asm volatile("" ::: "memory");
                }
        }
        st2.run(acc, u, wr, wc, lds, wid);
        {
            const int lane = lane_now(), fr = lane & 15, fq = lane >> 4;
#pragma unroll
            for (int ai = 0; ai < 2; ++ai)
#pragma unroll
                for (int m = 0; m < 4; ++m) {
                    const int r = ai * HALF + wr * 64 + m * 16 + fr; const float rs = S[r];
#pragma unroll
                    for (int bj = 0; bj < 2; ++bj) {
                        const int col = u.pn * BM + bj * HALF + wc * 32 + 8 * fq;
                        const unsigned off = (unsigned)(u.pm * BM + r) * 1024u + (unsigned)col;
                        const f32x4 g0 = ldg4(gain2 + col), g1 = ldg4(gain2 + col + 4);
                        *(u32x4*)(XN + off) = pack8(acc[ai][bj][m][0] * rs * g0, acc[ai][bj][m][1] * rs * g1);
                    }
                    asm volatile("" ::: "memory");
                }
        }
    }
};
template <class Epi, class Sched, bool ALIGN_EPI = false, bool SP2 = false>
__device__ __forceinline__ void gemm_phase(PG8_LAS unsigned char* lds, const Gemm g, const Sched& S, const Epi& E, const int wave0) {
    const int tid = wave0 * 64 + lane_now(), wid = wave0, lane = tid & 63, wr = wid >> 2, wc = wid & 3, fr = lane & 15, fq = lane >> 4;
    const int K = g.K, nt = K / BK, lda = g.lda, ldb = g.ldb;
    unsigned voffA[2], voffB[2];
#pragma unroll
    for (int i = 0; i < 2; ++i) { int R, C; stage_rc(tid * 16 + i * 8192, R, C); const int Rb = Epi::PERM ? ((R & ~31) + perm32(R & 31)) : R;
        voffA[i] = (unsigned)(R * lda + C) * 2u; voffB[i] = (unsigned)(Rb * ldb + C) * 2u; }
    const size_t kstep = (size_t)(BK * 2);
    const size_t hstepA = (size_t)HALF * lda * 2, hstepB = (size_t)HALF * ldb * 2;
    const size_t tstepA = 2 * hstepA, tstepB = 2 * hstepB;
    const unsigned ldsw = (unsigned)wid * 1024u;
    const int aoff = lds_byte(wr * 64 + fr, fq * 8), boff = lds_byte(wc * 32 + fr, fq * 8);
#define PG8_SA(b, h) (((b) * 2 + (h)) * HTB)
#define PG8_SB(b, h) ((4 + (b) * 2 + (h)) * HTB)
#define PG8_STAGE(bufoff, gbase, voff) do { _Pragma("unroll") for (int _i = 0; _i < 2; ++_i) \
        __builtin_amdgcn_global_load_lds((const unsigned*)((const char*)(gbase) + (voff)[_i]), (PG8_LAS unsigned*)(lds + (bufoff) + ldsw + _i * 8192), 16, 0, 0); } while (0)
#define PG8_LDA(dst, b, h) do { _Pragma("unroll") for (int m = 0; m < 4; ++m) _Pragma("unroll") for (int k = 0; k < 2; ++k) dst[m][k] = *(const PG8_LAS bf16x8*)(lds + PG8_SA(b, h) + aoff + m * 2048 + k * 1024); } while (0)
#define PG8_LDB(dst, b, h) do { _Pragma("unroll") for (int n = 0; n < 2; ++n) _Pragma("unroll") for (int k = 0; k < 2; ++k) dst[n][k] = *(const PG8_LAS bf16x8*)(lds + PG8_SB(b, h) + boff + n * 2048 + k * 1024); } while (0)
#define PG8_MMA(ai, bj, At, Bt) do { __builtin_amdgcn_s_setprio(1); _Pragma("unroll") for (int m = 0; m < 4; ++m) _Pragma("unroll") for (int n = 0; n < 2; ++n) _Pragma("unroll") for (int k = 0; k < 2; ++k) \
        acc[ai][bj][m][n] = __builtin_amdgcn_mfma_f32_16x16x32_bf16(Bt[n][k], At[m][k], acc[ai][bj][m][n], 0, 0, 0); __builtin_amdgcn_s_setprio(0); } while (0)
#define PG8_WAIT_V(n) asm volatile("s_waitcnt vmcnt(" #n ")" ::: "memory")
#define PG8_WAIT_L(n) asm volatile("s_waitcnt lgkmcnt(" #n ")" ::: "memory")
#define PG8_BAR __builtin_amdgcn_s_barrier()
#define PG8_SCHED __builtin_amdgcn_sched_barrier(0)
    Unit cur, nxt; int ui = 0;
    if (!S.next(0, cur)) return;
    f32x4 acc[2][2][4][2];
#pragma unroll
    for (int a = 0; a < 2; ++a)
#pragma unroll
        for (int b = 0; b < 2; ++b)
#pragma unroll
            for (int m = 0; m < 4; ++m)
#pragma unroll
                for (int n = 0; n < 2; ++n) acc[a][b][m][n] = (f32x4){0.f, 0.f, 0.f, 0.f};
    bf16x8 At[4][2], B0[2][2], B1[2][2];
    const char* cA = (const char*)g.A + (size_t)cur.pm * tstepA + (Epi::BRANCH_A ? (size_t)branch_tile(cur.pn >> 2) * 512 : (size_t)0); const char* cB = (const char*)g.Bt + (size_t)cur.pn * tstepB;
    S.a_ready(cur);
    if constexpr (SP2) {
        PG8_STAGE(PG8_SB(0, 0), cB, voffB); PG8_STAGE(PG8_SB(0, 1), cB + hstepB, voffB); PG8_STAGE(PG8_SA(0, 0), cA, voffA); PG8_STAGE(PG8_SA(0, 1), cA + hstepA, voffA);
        if (wr == 1) PG8_BAR;
        PG8_WAIT_V(2); PG8_BAR;
        PG8_STAGE(PG8_SB(1, 0), cB + kstep, voffB); PG8_STAGE(PG8_SA(1, 0), cA + kstep, voffA); PG8_STAGE(PG8_SB(1, 1), cB + hstepB + kstep, voffB);
        PG8_WAIT_V(6); PG8_BAR;
    } else {
        PG8_STAGE(PG8_SB(0, 0), cB, voffB); PG8_STAGE(PG8_SA(0, 0), cA, voffA); PG8_STAGE(PG8_SB(0, 1), cB + hstepB, voffB); PG8_STAGE(PG8_SA(0, 1), cA + hstepA, voffA);
        if (wr == 1) PG8_BAR;
        PG8_WAIT_V(4); PG8_BAR;
        PG8_STAGE(PG8_SB(1, 0), cB + kstep, voffB); PG8_STAGE(PG8_SA(1, 0), cA + kstep, voffA); PG8_STAGE(PG8_SB(1, 1), cB + hstepB + kstep, voffB);
        PG8_WAIT_V(6); PG8_BAR;
    }
    for (;;) {
        const bool has_next = S.next(ui + 1, nxt);
        const char* nA = has_next ? (const char*)g.A + (size_t)nxt.pm * tstepA + (Epi::BRANCH_A ? (size_t)branch_tile(nxt.pn >> 2) * 512 : (size_t)0) : cA; const char* nB = has_next ? (const char*)g.Bt + (size_t)nxt.pn * tstepB : cB;
        for (int t = 0; t < nt; t += 2) {
            const bool last = (t == nt - 2);
            const char* a1 = cA + (size_t)(t + 1) * kstep;
            const char* a2 = last ? nA : cA + (size_t)(t + 2) * kstep; const char* b2 = last ? nB : cB + (size_t)(t + 2) * kstep;
            const char* a3 = a2 + kstep; const char* b3 = b2 + kstep;
            if (last && has_next) S.a_ready(nxt);
            if constexpr (SP2) {
            PG8_LDB(B0, 0, 0); PG8_LDB(B1, 0, 1); PG8_SCHED; PG8_LDA(At, 0, 0); PG8_STAGE(PG8_SA(1, 1), a1 + hstepA, voffA);
            PG8_WAIT_V(8); PG8_WAIT_L(0); PG8_BAR; PG8_MMA(0, 0, At, B0); PG8_MMA(0, 1, At, B1); PG8_BAR; PG8_SCHED;
            PG8_LDA(At, 0, 1); PG8_STAGE(PG8_SB(0, 0), b2, voffB); PG8_STAGE(PG8_SB(0, 1), b2 + hstepB, voffB); PG8_STAGE(PG8_SA(0, 0), a2, voffA);
            PG8_WAIT_V(8); PG8_WAIT_L(0); PG8_BAR; PG8_MMA(1, 0, At, B0); PG8_MMA(1, 1, At, B1); PG8_BAR; PG8_SCHED;
            PG8_LDB(B0, 1, 0); PG8_LDB(B1, 1, 1); PG8_SCHED; PG8_LDA(At, 1, 0); PG8_STAGE(PG8_SA(0, 1), a2 + hstepA, voffA);
            PG8_WAIT_V(8); PG8_WAIT_L(0); PG8_BAR; PG8_MMA(0, 0, At, B0); PG8_MMA(0, 1, At, B1); PG8_BAR; PG8_SCHED;
            PG8_LDA(At, 1, 1); PG8_STAGE(PG8_SB(1, 0), b3, voffB); PG8_STAGE(PG8_SB(1, 1), b3 + hstepB, voffB); PG8_STAGE(PG8_SA(1, 0), a3, voffA);
            PG8_WAIT_V(8); PG8_WAIT_L(0); PG8_BAR; PG8_MMA(1, 0, At, B0); PG8_MMA(1, 1, At, B1); PG8_BAR; PG8_SCHED;
            } else {
            PG8_LDB(B0, 0, 0); PG8_SCHED; PG8_LDA(At, 0, 0); PG8_STAGE(PG8_SA(1, 1), a1 + hstepA, voffA);
            PG8_WAIT_L(8); PG8_BAR; PG8_WAIT_L(0); PG8_MMA(0, 0, At, B0); PG8_BAR; PG8_SCHED;
            PG8_LDB(B1, 0, 1); PG8_STAGE(PG8_SB(0, 0), b2, voffB);
            PG8_BAR; PG8_WAIT_L(0); PG8_MMA(0, 1, At, B1); PG8_BAR;
            PG8_LDA(At, 0, 1); PG8_STAGE(PG8_SA(0, 0), a2, voffA);
            PG8_BAR; PG8_WAIT_L(0); PG8_MMA(1, 0, At, B0); PG8_BAR; PG8_SCHED;
            PG8_STAGE(PG8_SB(0, 1), b2 + hstepB, voffB);
            PG8_WAIT_V(6); PG8_BAR; PG8_MMA(1, 1, At, B1); PG8_BAR;
            PG8_LDB(B0, 1, 0); PG8_SCHED; PG8_LDA(At, 1, 0); PG8_STAGE(PG8_SA(0, 1), a2 + hstepA, voffA);
            PG8_WAIT_L(8); PG8_BAR; PG8_WAIT_L(0); PG8_MMA(0, 0, At, B0); PG8_BAR; PG8_SCHED;
            PG8_LDB(B1, 1, 1); PG8_STAGE(PG8_SB(1, 0), b3, voffB);
            PG8_BAR; PG8_WAIT_L(0); PG8_MMA(0, 1, At, B1); PG8_BAR;
            PG8_LDA(At, 1, 1); PG8_STAGE(PG8_SA(1, 0), a3, voffA);
            PG8_BAR; PG8_WAIT_L(0); PG8_MMA(1, 0, At, B0); PG8_BAR; PG8_SCHED;
            PG8_STAGE(PG8_SB(1, 1), b3 + hstepB, voffB);
            PG8_WAIT_V(6); PG8_BAR; PG8_MMA(1, 1, At, B1); PG8_BAR;
            }
        }
        if constexpr (ALIGN_EPI) { if (wr == 0) PG8_BAR; }
        if constexpr (!Epi::AFTER_DRAIN) { E(acc, cur, wr, wc, fr, fq); S.done(cur); }
        if (!has_next) break;
#pragma unroll
        for (int a = 0; a < 2; ++a)
#pragma unroll
            for (int b = 0; b < 2; ++b)
#pragma unroll
                for (int m = 0; m < 4; ++m)
#pragma unroll
                    for (int n = 0; n < 2; ++n) acc[a][b][m][n] = (f32x4){0.f, 0.f, 0.f, 0.f};
        cur = nxt; cA = nA; cB = nB; ++ui;
        if constexpr (ALIGN_EPI) { if (wr == 1) PG8_BAR; }
    }
    PG8_WAIT_V(0);
    if constexpr (!ALIGN_EPI) { if (wr == 0) PG8_BAR; }
    PG8_BAR;
    if constexpr (Epi::AFTER_DRAIN) { E.fused(acc, cur, wr, wc, fr, fq, lds, wid, lane); S.done(cur); }
#undef PG8_SA
#undef PG8_SB
#undef PG8_STAGE
#undef PG8_LDA
#undef PG8_LDB
#undef PG8_MMA
#undef PG8_WAIT_V
#undef PG8_WAIT_L
#undef PG8_BAR
#undef PG8_SCHED
}
}

namespace cg = cooperative_groups;
using pg8::bf16_t; using pg8::bf16x8; using pg8::f32x4; using pg8::u32x4; using pg8::f32x16;
typedef unsigned u32x2 __attribute__((ext_vector_type(2)));
#define LAS __attribute__((address_space(3)))
constexpr int NTHR = 512, NWAVES = 8;
constexpr int DM = 1024, T_ALL = 98304, T_PROMPT = 32768, GROUP = 16384, NGROUP = 6;
constexpr int PW = 3072;
constexpr int DFF = 2816;
constexpr float EPS = 1e-6f;
constexpr float QSCALE = 0.125f * 1.4426950408889634f;
constexpr size_t MiB = 1u << 20;
constexpr size_t WS_WIN = 0 * MiB, WS_WG = 6 * MiB, WS_WB = 14 * MiB, WS_WO = 16 * MiB, WS_WFI = 18 * MiB, WS_WFO = 29 * MiB, WS_MISC = 35 * MiB;
constexpr size_t WS_XN = 40 * MiB, WS_P = 72 * MiB, WS_S = 648 * MiB;
constexpr size_t S_HRAW = 0, S_HW8 = 20 * MiB, S_HW2 = 84 * MiB, S_KV = 100 * MiB;
constexpr size_t S_GATE = 0, S_ACT = 0, S_MF = 128 * MiB, S_MB = 192 * MiB;
constexpr size_t WS_CTL = 36 * MiB, CTL_BYTES = 131072;
constexpr size_t WS_NEED = 648 * MiB + 312 * MiB;
constexpr int LDS_BYTES = 147456;
#ifndef ENABLE
#define ENABLE 0xffff
#endif
constexpr int EN = ENABLE;
#ifndef PROBE_T
#define PROBE_T 0
#endif
#if PROBE_T
#define TMARK(c) do { const unsigned long long tn_ = __builtin_amdgcn_s_memrealtime(); if (PROBE_T == (c)) tacc += tn_ - tprev; tprev = tn_; } while (0)
#else
#define TMARK(c) do {} while (0)
#endif
#ifndef PROBE_DUP
#define PROBE_DUP 0
#endif

#define GSYNC() xcd_barrier(xbar)
struct Args { const float* in[20]; float* out; unsigned char* ws; };

__device__ __forceinline__ float wave_sum(float v) {
#pragma unroll
    for (int o = 1; o < 64; o <<= 1) v += pg8::shx(v, o);
    return v;
}
__device__ __forceinline__ unsigned cvtpk(float lo, float hi) { return pg8::cvt_pk_bf16(lo, hi); }
__device__ __forceinline__ float bf2f(unsigned h) { return __uint_as_float(h << 16); }
__device__ __forceinline__ unsigned f2bf1(float f) { return cvtpk(f, 0.f) & 0xffffu; }
__device__ __forceinline__ int pi_slot(int s) { return (s & ~31) | (((s >> 2) & 1) << 4) | (((s >> 3) & 3) << 2) | (s & 3); }
__device__ __forceinline__ f32x16 mfma32(bf16x8 a, bf16x8 b, f32x16 c) { return __builtin_amdgcn_mfma_f32_32x32x16_bf16(a, b, c, 0, 0, 0); }
__device__ __forceinline__ int crow(int r, int hi) { return (r & 3) + 8 * (r >> 2) + 4 * hi; }
__device__ __forceinline__ bf16x8 mk8(u32x2 lo, u32x2 hi) { u32x4 w; w.x = lo.x; w.y = lo.y; w.z = hi.x; w.w = hi.y; return __builtin_bit_cast(bf16x8, w); }
__device__ __forceinline__ bf16x8 pack8r(const f32x16& p, int b) { u32x4 w; w.x = cvtpk(p[b], p[b + 1]); w.y = cvtpk(p[b + 2], p[b + 3]); w.z = cvtpk(p[b + 4], p[b + 5]); w.w = cvtpk(p[b + 6], p[b + 7]); return __builtin_bit_cast(bf16x8, w); }
__device__ __forceinline__ unsigned short u16at(const u32x4& w, int e) { return (unsigned short)((w[e >> 1] >> (16 * (e & 1))) & 0xffffu); }

template <int MAP, bool KPERM>
__device__ __forceinline__ void transpose_item(const float* W, int ld, int K, int nblk, bf16_t* WT, float* scr, int item, int lane) {
    const int kb = item / nblk, nb = item % nblk, k0 = 64 * kb, n0 = 32 * nb;
#pragma unroll
    for (int i = 0; i < 8; ++i) { const int kk = 8 * i + (lane >> 3); const f32x4 v = *(const f32x4*)(W + (size_t)(k0 + kk) * ld + n0 + 4 * (lane & 7));
        float* sp = scr + kk * 33 + 4 * (lane & 7); sp[0] = v[0]; sp[1] = v[1]; sp[2] = v[2]; sp[3] = v[3]; }
    asm volatile("s_waitcnt lgkmcnt(0)" ::: "memory");
    const int c = lane & 7;
#pragma unroll
    for (int j = 0; j < 4; ++j) {
        const int n = (lane >> 3) + 8 * j; const int ns = n0 + n; int dr;
        if (MAP == 0) dr = ns;
        else if (MAP == 1) { const int lc = ns & 255; dr = (ns & ~255) + 128 * ((lc >> 5) & 1) + 32 * ((lc >> 6) & 3) + 8 * ((lc >> 2) & 3) + 4 * ((lc >> 4) & 1) + (lc & 3); }
        else if (MAP == 3) { const int br = ns >> 10, ch = ns & 1023; dr = (ch >> 6) * 256 + 128 * (br >> 1) + 32 * ((ch >> 4) & 3) + 8 * ((ch >> 2) & 3) + 4 * (br & 1) + (ch & 3); }
        else { const int up = ns >= DFF ? 1 : 0; const int jj = ns - DFF * up; dr = (jj >> 7) * 256 + 128 * up + (jj & 127); }
        float s[8];
#pragma unroll
        for (int e = 0; e < 8; ++e) { const int kl = KPERM ? pi_slot(8 * c + e) : (8 * c + e); s[e] = scr[kl * 33 + n]; }
        u32x4 o; o.x = cvtpk(s[0], s[1]); o.y = cvtpk(s[2], s[3]); o.z = cvtpk(s[4], s[5]); o.w = cvtpk(s[6], s[7]);
        *(u32x4*)(WT + (size_t)dr * K + k0 + 8 * c) = o;
    }
    asm volatile("s_waitcnt lgkmcnt(0)" ::: "memory");
}

__device__ __forceinline__ void prep_weights(const Args& a, int layer, unsigned char* lds, const int wave0) {
    const int tid = (wave0 * 64 + pg8::lane_now()), lane = tid & 63, wave = wave0; const int gw = blockIdx.x * NWAVES + wave, NGW = gridDim.x * NWAVES;
    unsigned char* ws = a.ws;
    float* scr = (float*)(lds + wave * 16384);
    const float* w_in = a.in[3] + (size_t)layer * 1024 * 7168;
    const float* wbr = a.in[16] + (size_t)layer * 4 * 256 * 1024;
    const float* wo = a.in[17] + (size_t)layer * 1024 * 1024;
    const float* wfi = a.in[18] + (size_t)layer * 1024 * 5632;
    const float* wfo = a.in[19] + (size_t)layer * 2816 * 1024;
    constexpr int I_IN = 16 * 96, I_G = 16 * 128, I_B = 4 * 32, I_O = 16 * 32, I_FI = 16 * 176, I_FO = 44 * 32;
    constexpr int NIT = I_IN + I_G + 4 * I_B + I_O + I_FI + I_FO;
    for (int it = gw; it < NIT; it += NGW) {
        int r = it;
        if (r < I_IN) { transpose_item<1, false>(w_in, 7168, 1024, 96, (bf16_t*)(ws + WS_WIN), scr, r, lane); continue; } r -= I_IN;
        if (r < I_G) { transpose_item<3, false>(w_in + 3072, 7168, 1024, 128, (bf16_t*)(ws + WS_WG), scr, r, lane); continue; } r -= I_G;
        if (r < 4 * I_B) { const int n = r / I_B; transpose_item<0, true>(wbr + (size_t)n * 256 * 1024, 1024, 256, 32, (bf16_t*)(ws + WS_WB) + (size_t)n * 1024 * 256, scr, r % I_B, lane); continue; } r -= 4 * I_B;
        if (r < I_O) { transpose_item<0, false>(wo, 1024, 1024, 32, (bf16_t*)(ws + WS_WO), scr, r, lane); continue; } r -= I_O;
        if (r < I_FI) { transpose_item<2, false>(wfi, 5632, 1024, 176, (bf16_t*)(ws + WS_WFI), scr, r, lane); continue; } r -= I_FI;
        transpose_item<0, false>(wfo, 1024, 2816, 32, (bf16_t*)(ws + WS_WFO), scr, r, lane);
    }
}

__device__ __forceinline__ const float* xrow_ptr(const Args& a, int layer, int R) {
    if (layer == 0) return R < T_PROMPT ? a.in[0] + (size_t)R * DM : a.in[1] + (size_t)(R - T_PROMPT) * DM;
    return a.out + (size_t)R * DM;
}
__device__ __forceinline__ void norm_x_rows(const Args& a, int layer, int g, const float* gain, bf16_t* XN, const int wave0) {
    const int tid = (wave0 * 64 + pg8::lane_now()), lane = tid & 63, wave = wave0; const int gw = blockIdx.x * NWAVES + wave, NGW = gridDim.x * NWAVES;
    for (int row = gw; row < GROUP; row += 2 * NGW) {
        const int row2 = row + NGW;
        const float* xr = xrow_ptr(a, layer, g * GROUP + row); const float* xr2 = xrow_ptr(a, layer, g * GROUP + row2);
        f32x4 v[4], w[4]; float ss = 0.f, ss2 = 0.f;
#pragma unroll
        for (int j = 0; j < 4; ++j) { v[j] = *(const f32x4*)(xr + 4 * lane + 256 * j); w[j] = *(const f32x4*)(xr2 + 4 * lane + 256 * j); }
#pragma unroll
        for (int j = 0; j < 4; ++j) { ss += (v[j][0] * v[j][0] + v[j][1] * v[j][1]) + (v[j][2] * v[j][2] + v[j][3] * v[j][3]); ss2 += (w[j][0] * w[j][0] + w[j][1] * w[j][1]) + (w[j][2] * w[j][2] + w[j][3] * w[j][3]); }
        const float rn = 1.0f / sqrtf(wave_sum(ss) * (1.0f / DM) + EPS), rn2 = 1.0f / sqrtf(wave_sum(ss2) * (1.0f / DM) + EPS);
#pragma unroll
        for (int j = 0; j < 4; ++j) { const f32x4 gv = *(const f32x4*)(gain + 4 * lane + 256 * j); const f32x4 o = v[j] * rn * gv, o2 = w[j] * rn2 * gv;
            u32x2 p; p.x = cvtpk(o[0], o[1]); p.y = cvtpk(o[2], o[3]); *(u32x2*)(XN + (size_t)row * DM + 4 * lane + 256 * j) = p;
            u32x2 p2; p2.x = cvtpk(o2[0], o2[1]); p2.y = cvtpk(o2[2], o2[3]); *(u32x2*)(XN + (size_t)row2 * DM + 4 * lane + 256 * j) = p2; }
    }
}
__device__ __forceinline__ void norm_res_rows(const Args& a, const float* TMP, int g, bool base_is_x0, const float* gain, const float* gain2, bf16_t* HN, const int wave0) {
    const int tid = (wave0 * 64 + pg8::lane_now()), lane = tid & 63, wave = wave0; const int gw = blockIdx.x * NWAVES + wave, NGW = gridDim.x * NWAVES;
    for (int row = gw; row < GROUP; row += NGW) {
        const int R = g * GROUP + row;
        const float* br = base_is_x0 ? xrow_ptr(a, 0, R) : a.out + (size_t)R * DM;
        const float* tr = TMP + (size_t)row * DM;
        f32x4 v[4], b[4]; float ss = 0.f;
#pragma unroll
        for (int j = 0; j < 4; ++j) { v[j] = *(const f32x4*)(tr + 4 * lane + 256 * j); b[j] = *(const f32x4*)(br + 4 * lane + 256 * j); ss += (v[j][0] * v[j][0] + v[j][1] * v[j][1]) + (v[j][2] * v[j][2] + v[j][3] * v[j][3]); }
        const float rn = 1.0f / sqrtf(wave_sum(ss) * (1.0f / DM) + EPS);
        float s2 = 0.f;
#pragma unroll
        for (int j = 0; j < 4; ++j) { const f32x4 gv = *(const f32x4*)(gain + 4 * lane + 256 * j); v[j] = b[j] + v[j] * rn * gv;
            *(f32x4*)(a.out + (size_t)R * DM + 4 * lane + 256 * j) = v[j]; s2 += (v[j][0] * v[j][0] + v[j][1] * v[j][1]) + (v[j][2] * v[j][2] + v[j][3] * v[j][3]); }
        if (HN) {
            const float r2 = 1.0f / sqrtf(wave_sum(s2) * (1.0f / DM) + EPS);
#pragma unroll
            for (int j = 0; j < 4; ++j) { const f32x4 gv = *(const f32x4*)(gain2 + 4 * lane + 256 * j); const f32x4 o = v[j] * r2 * gv;
                u32x2 w; w.x = cvtpk(o[0], o[1]); w.y = cvtpk(o[2], o[3]); *(u32x2*)(HN + (size_t)row * DM + 4 * lane + 256 * j) = w; }
        }
    }
}

__device__ __forceinline__ void rope_table(float* rcos, float* rsin, const int wave0) {
    for (int i = (wave0 * 64 + pg8::lane_now()); i < 128 * 16; i += NTHR) {
        const int pos = i >> 4, f = i & 15;
        const float inv = powf(10000.0f, -(float)f / 16.0f);
        const float ang = (float)pos * inv;
        rcos[i] = cosf(ang); rsin[i] = sinf(ang);
    }
}

__device__ __forceinline__ void hy_filter_item(const Args& a, int layer, int item, unsigned char* lds, const int wave0) {
    const int tid = (wave0 * 64 + pg8::lane_now());
    const bool big = item < 512; const int L = big ? 8192 : 2048; const int t0 = (big ? item : item - 512) * 16;
    float* hraw = (float*)(a.ws + WS_S + S_HRAW) + (big ? 0 : (size_t)2 * 256 * 8192);
    const float* w1 = a.in[7] + layer * 33 * 64; const float* b1 = a.in[8] + layer * 64; const float* w2 = a.in[9] + layer * 64 * 64; const float* b2 = a.in[10] + layer * 64;
    const float* w3 = a.in[11] + (size_t)layer * 64 * 512; const float* fr = a.in[12] + layer * 128;
    float* zf = (float*)lds; float* h1 = zf + 16 * 33; float* h2 = h1 + 16 * 65;
    for (int idx = tid; idx < 16 * 33; idx += NTHR) {
        const int p = idx / 33, f = idx - p * 33; const int t = t0 + p; float v;
        if (f == 0) v = (float)t / (float)(L - 1);
        else { const int k = (f - 1) & 15; const float fk = 1e-4f + (float)k * ((15.0f - 1e-4f) / 15.0f); float x = ((float)t * fk) / (float)L; x = x - floorf(x); v = f <= 16 ? __builtin_amdgcn_cosf(x) : -__builtin_amdgcn_sinf(x); }
        zf[idx] = v;
    }
    __syncthreads();
    for (int idx = tid; idx < 1024; idx += NTHR) { const int p = idx >> 6, u = idx & 63; float s = b1[u];
#pragma unroll 11
        for (int f = 0; f < 33; ++f) s += zf[p * 33 + f] * w1[f * 64 + u];
        h1[p * 65 + u] = sinf(fr[u] * s); }
    __syncthreads();
    for (int idx = tid; idx < 1024; idx += NTHR) { const int p = idx >> 6, u = idx & 63; float s = b2[u];
#pragma unroll 16
        for (int k = 0; k < 64; ++k) s += h1[p * 65 + k] * w2[k * 64 + u];
        h2[p * 65 + u] = sinf(fr[64 + u] * s); }
    __syncthreads();
    {
        const int p = tid & 15, c0 = (tid >> 4) * 16; const int t = t0 + p; const float tl = (float)t / (float)(L - 1);
        f32x4 ac[4] = {f32x4{}, f32x4{}, f32x4{}, f32x4{}};
#pragma unroll 4
        for (int k = 0; k < 64; ++k) { const float h = h2[p * 65 + k]; const float* wp = w3 + k * 512 + c0;
#pragma unroll
            for (int j = 0; j < 4; ++j) ac[j] += h * *(const f32x4*)(wp + 4 * j); }
        const float dlo = -4.605170185988091f / 1.5f, dhi = -4.605170185988091f / 0.3f;
#pragma unroll
        for (int j = 0; j < 4; ++j)
#pragma unroll
            for (int i = 0; i < 4; ++i) { const int col = c0 + 4 * j + i; const int dir = col >> 8, c = col & 255; const float delta = fabsf(dlo + (float)c * ((dhi - dlo) / 255.0f));
                hraw[((size_t)dir * 256 + c) * L + t] = ac[j][i] * expf(-tl * delta); }
    }
    __syncthreads();
}
__device__ __forceinline__ void hy_window_item(const Args& a, int item, unsigned char* lds, const int wave0) {
    const int tid = (wave0 * 64 + pg8::lane_now()), lane = tid & 63, wave = wave0;
    const bool big = item < 256; const int L = big ? 8192 : 2048; const int c = big ? item : item - 256;
    const float* hraw = (const float*)(a.ws + WS_S + S_HRAW) + (big ? 0 : (size_t)2 * 256 * 8192);
    const float* hf = hraw + (size_t)c * L; const float* hb = hraw + ((size_t)256 + c) * L;
    bf16_t* W = (bf16_t*)(a.ws + WS_S + (big ? S_HW8 : S_HW2)) + (size_t)c * (2 * L * 8);
    float* red = (float*)lds;
    float ss = 0.f;
    for (int t = tid; t < L; t += NTHR) { const float x = hf[t]; ss += x * x; if (t > 0) { const float y = hb[t]; ss += y * y; } }
    ss = wave_sum(ss);
    if (lane == 0) red[wave] = ss;
    __syncthreads();
    float tot = 0.f;
#pragma unroll
    for (int w = 0; w < NWAVES; ++w) tot += red[w];
    const float nrm = 1.0f / sqrtf(tot + EPS);
    for (int idx = tid; idx < 2 * L; idx += NTHR) {
        const int o = idx - L; float s[8];
#pragma unroll
        for (int e = 0; e < 8; ++e) { const int l = o - e; float v = 0.f; if (l >= 0) { if (l < L) v = hf[l]; } else { if (-l < L) v = hb[-l]; } s[e] = v * nrm; }
        u32x4 w; w.x = cvtpk(s[0], s[1]); w.y = cvtpk(s[2], s[3]); w.z = cvtpk(s[4], s[5]); w.w = cvtpk(s[6], s[7]);
        *(u32x4*)(W + (size_t)idx * 8) = w;
    }
    __syncthreads();
}

__device__ __forceinline__ int zidx(int t) { return (t & ~31) | ((((t >> 3) & 3) ^ ((t >> 7) & 3)) << 3) | (t & 7); }
template <int NQ, int QLO, int QHI>
__device__ __forceinline__ void hy_seg(f32x16 (&acc)[NQ], const int dlo, const int dhi, const int dmax, const bf16_t* Wc, const int abase, const bf16_t* zw, const bf16_t* zero, const int r32, const int hi,
                                       bf16x8& a0, bf16x8& a1, bf16x8& a2, bf16x8& a3) {
    constexpr int nb = NQ * 32;
    for (int d = dlo; d <= dhi; ++d) {
#pragma unroll
        for (int ks = 0; ks < 2; ++ks) {
            const bf16x8 cur = a0; a0 = a1; a1 = a2; a2 = a3;
            { int dn = d + 2; dn = dn <= dmax ? dn : dmax; a3 = *(const bf16x8*)(Wc + (size_t)(abase + 32 * dn - 16 * ks) * 8); }
            bf16x8 bf[NQ];
#pragma unroll
            for (int q = QLO; q <= QHI; ++q) { const int j = 32 * q + r32 - d;
                const bf16_t* bp = ((unsigned)j < (unsigned)nb) ? (zw + 32 * j + 8 * ((2 * ks + hi) ^ ((j >> 2) & 3))) : zero; bf[q] = *(const bf16x8*)bp; }
            __builtin_amdgcn_sched_barrier(0);
#pragma unroll
            for (int q = QLO; q <= QHI; ++q) acc[q] = mfma32(cur, bf[q], acc[q]);
            __builtin_amdgcn_sched_barrier(0);
        }
    }
}
template <int NQ, int S> struct HySegs {
    static __device__ __forceinline__ void run(f32x16 (&acc)[NQ], const bf16_t* Wc, const int abase, const bf16_t* zw, const bf16_t* zero, const int r32, const int hi, bf16x8& a0, bf16x8& a1, bf16x8& a2, bf16x8& a3) {
        constexpr int nb = NQ * 32;
        constexpr int QLO = S < NQ ? 0 : S - NQ + 1, QHI = S < NQ ? S : NQ - 1;
        constexpr int dlo = S < NQ ? 32 * S - nb + 1 : 32 * (S - NQ + 1);
        constexpr int dhi = S == NQ - 1 ? 31 : dlo + 31;
        hy_seg<NQ, QLO, QHI>(acc, dlo, dhi, nb - 1, Wc, abase, zw, zero, r32, hi, a0, a1, a2, a3);
        if constexpr (S + 1 < 2 * NQ - 1) HySegs<NQ, S + 1>::run(acc, Wc, abase, zw, zero, r32, hi, a0, a1, a2, a3);
    }
};
template <int NQ>
__device__ __forceinline__ void hyena_item(const Args& a, int layer, int row0, int g, unsigned char* lds, const bool do_store, const int wave0) {
    constexpr int L = NQ * 1024, nb = L / 32;
    const int tid = (wave0 * 64 + pg8::lane_now()), lane = tid & 63, wave = wave0, r32 = lane & 31, hi = lane >> 5;
    bf16_t* P = (bf16_t*)(a.ws + WS_P);
    bf16_t* zs = (bf16_t*)lds;
    bf16_t* zero = zs + 8 * L;
    float* ptab = (float*)(lds + 8 * L * 2 + 64);
    const float* hcw = a.in[5] + layer * 3 * 768; const float* hcb = a.in[6] + layer * 768; const float* hbias = a.in[13] + layer * 256;
    if (tid < 16) ((unsigned*)zero)[tid] = 0u;
    if (tid < 128) { const int e = tid >> 4, q = tid & 15; const int lc = pi_slot(8 * g + e); float v = 0.f;
        if (q < 9) v = hcw[(q % 3) * 768 + (q / 3) * 256 + lc]; else if (q < 12) v = hcb[(q - 9) * 256 + lc]; else if (q == 12) v = hbias[lc];
        ptab[e * 16 + q] = v; }
    __syncthreads();
    for (int tu = tid; tu < L / 8; tu += NTHR) {
        const int t0 = 8 * tu;
        u32x4 x1r[10], hvr[10];
#pragma unroll
        for (int k = 0; k < 10; ++k) { const int t = t0 - 1 + k; const bool ok = (t >= 0) && (t < L);
            const bf16_t* pr = P + (size_t)(row0 + (ok ? t : t0)) * PW + 3 * 256 + 8 * g;
            const u32x4 a_ = *(const u32x4*)pr, b_ = *(const u32x4*)(pr + 256); const u32x4 zz = (u32x4){0u, 0u, 0u, 0u};
            x1r[k] = ok ? a_ : zz; hvr[k] = ok ? b_ : zz; }
        const int zt = zidx(t0);
#pragma unroll
        for (int e = 0; e < 8; ++e) { const float* pt = ptab + e * 16; float z[8];
#pragma unroll
            for (int i = 0; i < 8; ++i) {
                const float u1 = pt[3] * bf2f(u16at(x1r[i], e)) + pt[4] * bf2f(u16at(x1r[i + 1], e)) + pt[5] * bf2f(u16at(x1r[i + 2], e)) + pt[10];
                const float uv = pt[6] * bf2f(u16at(hvr[i], e)) + pt[7] * bf2f(u16at(hvr[i + 1], e)) + pt[8] * bf2f(u16at(hvr[i + 2], e)) + pt[11];
                z[i] = uv * u1; }
            u32x4 w; w.x = cvtpk(z[0], z[1]); w.y = cvtpk(z[2], z[3]); w.z = cvtpk(z[4], z[5]); w.w = cvtpk(z[6], z[7]);
            *(u32x4*)(zs + e * L + zt) = w; }
    }
    __syncthreads();
    {
        const int lc = pi_slot(8 * g + wave);
        const bf16_t* Wc = (const bf16_t*)(a.ws + WS_S + (NQ == 8 ? S_HW8 : S_HW2)) + (size_t)lc * (2 * L * 8);
        const bf16_t* zw = zs + wave * L;
        f32x16 acc[NQ];
#pragma unroll
        for (int q = 0; q < NQ; ++q) acc[q] = f32x16{};
        constexpr int dmin = -(nb - 1);
        const int abase = L + r32 - 8 * hi;
        bf16x8 a0 = *(const bf16x8*)(Wc + (size_t)(abase + 32 * dmin) * 8), a1 = *(const bf16x8*)(Wc + (size_t)(abase + 32 * dmin - 16) * 8);
        bf16x8 a2 = *(const bf16x8*)(Wc + (size_t)(abase + 32 * (dmin + 1)) * 8), a3 = *(const bf16x8*)(Wc + (size_t)(abase + 32 * (dmin + 1) - 16) * 8);
        HySegs<NQ, 0>::run(acc, Wc, abase, zw, zero, r32, hi, a0, a1, a2, a3);
        const float hb_ = ptab[wave * 16 + 12];
        bf16_t* zwm = zs + wave * L;
#pragma unroll
        for (int q = 0; q < NQ; ++q)
#pragma unroll
            for (int rg = 0; rg < 4; ++rg) {
                const int jb = 32 * q + r32; const int t0 = 32 * jb + 8 * (rg ^ ((jb >> 2) & 3)) + 4 * hi;
                const u32x2 zz = *(const u32x2*)(zwm + t0);
                const float y0 = acc[q][4 * rg + 0] + hb_ * bf2f(zz.x & 0xffffu), y1 = acc[q][4 * rg + 1] + hb_ * bf2f(zz.x >> 16);
                const float y2 = acc[q][4 * rg + 2] + hb_ * bf2f(zz.y & 0xffffu), y3 = acc[q][4 * rg + 3] + hb_ * bf2f(zz.y >> 16);
                u32x2 w; w.x = cvtpk(y0, y1); w.y = cvtpk(y2, y3); *(u32x2*)(zwm + t0) = w;
            }
    }
    __syncthreads();
    for (int tu = tid; tu < L / 8; tu += NTHR) {
        const int t0 = 8 * tu;
        u32x4 xr[10], yr[8];
#pragma unroll
        for (int k = 0; k < 10; ++k) { const int t = t0 - 1 + k; const bool ok = (t >= 0) && (t < L);
            const u32x4 a_ = *(const u32x4*)(P + (size_t)(row0 + (ok ? t : t0)) * PW + 2 * 256 + 8 * g); const u32x4 zz = (u32x4){0u, 0u, 0u, 0u};
            xr[k] = ok ? a_ : zz; }
        const int zt = zidx(t0);
#pragma unroll
        for (int e = 0; e < 8; ++e) yr[e] = *(const u32x4*)(zs + e * L + zt);
#pragma unroll
        for (int i = 0; i < 8; ++i) { float o[8];
#pragma unroll
            for (int e = 0; e < 8; ++e) { const float* pt = ptab + e * 16;
                const float u0 = pt[0] * bf2f(u16at(xr[i], e)) + pt[1] * bf2f(u16at(xr[i + 1], e)) + pt[2] * bf2f(u16at(xr[i + 2], e)) + pt[9];
                o[e] = u0 * bf2f(u16at(yr[e], i)); }
            u32x4 w; w.x = cvtpk(o[0], o[1]); w.y = cvtpk(o[2], o[3]); w.z = cvtpk(o[4], o[5]); w.w = cvtpk(o[6], o[7]);
            if (do_store) *(u32x4*)(P + (size_t)(row0 + t0 + i) * PW + 3 * 256 + 8 * g) = w; }
    }
    __syncthreads();
}

typedef short v4i16_t __attribute__((ext_vector_type(4)));
__device__ __forceinline__ u32x2 vtr64(const bf16_t* p) {
    return __builtin_bit_cast(u32x2, __builtin_amdgcn_ds_read_tr16_b64_v4i16((__attribute__((address_space(3))) v4i16_t*)(uintptr_t)p));
}

__device__ __forceinline__ void attn_unit(bf16_t* P, int row0, int L, int kvh, int qb, unsigned char* lds, const bool do_store, const int wave0) {
    const int tid = (wave0 * 64 + pg8::lane_now()), lane = tid & 63, wave = wave0, r32 = lane & 31, hi = lane >> 5;
    const int head = 2 * kvh + (wave >> 2);
    bf16_t* qp0 = P + (size_t)(row0 + qb * 256 + (wave & 3) * 64 + r32) * PW + head * 64;
    bf16x8 qf[2][4];
#pragma unroll
    for (int t = 0; t < 2; ++t)
#pragma unroll
        for (int ks = 0; ks < 4; ++ks) qf[t][ks] = *(const bf16x8*)(qp0 + (size_t)t * 32 * PW + 16 * ks + 8 * hi);
    bf16_t* Ks = (bf16_t*)lds; bf16_t* Vt = Ks + 2 * 64 * 72;
    const int skey = tid >> 3, sch = tid & 7;
    const bf16_t* kg = P + (size_t)(row0 + skey) * PW + 256 + kvh * 64 + sch * 8;
    u32x4 kreg = *(const u32x4*)kg, vreg = *(const u32x4*)(kg + 128);
#define ATT_PUT(buf) do { *(u32x4*)(Ks + (buf) * 64 * 72 + skey * 72 + sch * 8) = kreg; *(u32x4*)(Vt + (buf) * 64 * 72 + skey * 72 + sch * 8) = vreg; } while (0)
    ATT_PUT(0);
    __syncthreads();
    const int nt = L / 64;
    const int vtb = (4 * hi + ((lane & 15) >> 2)) * 72 + 16 * ((lane >> 4) & 1) + 4 * (lane & 3);
    float mhat[2] = {0.f, 0.f}, l_run[2] = {0.f, 0.f}; f32x16 o[2][2], negm[2];
#pragma unroll
    for (int t = 0; t < 2; ++t) { o[t][0] = f32x16{}; o[t][1] = f32x16{}; negm[t] = f32x16{}; }
    for (int kt = 0; kt < nt; ++kt) {
        const int buf = kt & 1;
        if (kt + 1 < nt) { const bf16_t* kn = kg + (size_t)(kt + 1) * 64 * PW; kreg = *(const u32x4*)kn; vreg = *(const u32x4*)(kn + 128); }
        const bf16_t* kb = Ks + buf * 64 * 72; const bf16_t* vb = Vt + buf * 64 * 72;
#pragma unroll
        for (int h = 0; h < 2; ++h) {
            bf16x8 ka[4], va[4];
#pragma unroll
            for (int ks = 0; ks < 4; ++ks) ka[ks] = *(const bf16x8*)(kb + (32 * h + r32) * 72 + 16 * ks + 8 * hi);
#pragma unroll
            for (int jj = 0; jj < 2; ++jj) { const int j = 2 * h + jj;
                va[2 * jj] = mk8(vtr64(vb + vtb + (16 * j) * 72), vtr64(vb + vtb + (16 * j + 8) * 72));
                va[2 * jj + 1] = mk8(vtr64(vb + vtb + (16 * j) * 72 + 32), vtr64(vb + vtb + (16 * j + 8) * 72 + 32)); }
            __builtin_amdgcn_sched_barrier(0);
#pragma unroll
            for (int t = 0; t < 2; ++t) {
                f32x16 sc = mfma32(ka[0], qf[t][0], negm[t]);
#pragma unroll
                for (int ks = 1; ks < 4; ++ks) sc = mfma32(ka[ks], qf[t][ks], sc);
                float mx = sc[0];
#pragma unroll
                for (int r = 1; r < 16; ++r) mx = fmaxf(mx, sc[r]);
                mx = fmaxf(mx, pg8::shx(mx, 32));
                if ((kt == 0 && h == 0) || __any(mx > 8.0f)) {
                    const float dl = (kt == 0 && h == 0) ? mx : fmaxf(mx, 0.f);
                    mhat[t] += dl; const float alpha = __builtin_amdgcn_exp2f(-dl);
#pragma unroll
                    for (int r = 0; r < 16; ++r) { sc[r] -= dl; o[t][0][r] *= alpha; o[t][1][r] *= alpha; negm[t][r] = -mhat[t]; }
                    l_run[t] *= alpha;
                }
                float ps = 0.f;
#pragma unroll
                for (int r = 0; r < 16; ++r) { sc[r] = __builtin_amdgcn_exp2f(sc[r]); ps += sc[r]; }
                l_run[t] += ps;
                const bf16x8 pb0 = pack8r(sc, 0), pb1 = pack8r(sc, 8);
                o[t][0] = mfma32(va[0], pb0, o[t][0]); o[t][1] = mfma32(va[1], pb0, o[t][1]);
                o[t][0] = mfma32(va[2], pb1, o[t][0]); o[t][1] = mfma32(va[3], pb1, o[t][1]);
            }
        }
        if (kt + 1 < nt) ATT_PUT(buf ^ 1);
        __syncthreads();
    }
#undef ATT_PUT
#pragma unroll
    for (int t = 0; t < 2; ++t) {
        const float inv = 1.0f / (l_run[t] + pg8::shx(l_run[t], 32));
        bf16_t* qp = qp0 + (size_t)t * 32 * PW;
#pragma unroll
        for (int rg = 0; rg < 4; ++rg) {
            u32x2 w0, w1;
            w0.x = cvtpk(o[t][0][4 * rg] * inv, o[t][0][4 * rg + 1] * inv); w0.y = cvtpk(o[t][0][4 * rg + 2] * inv, o[t][0][4 * rg + 3] * inv);
            w1.x = cvtpk(o[t][1][4 * rg] * inv, o[t][1][4 * rg + 1] * inv); w1.y = cvtpk(o[t][1][4 * rg + 2] * inv, o[t][1][4 * rg + 3] * inv);
            if (do_store) { *(u32x2*)(qp + 8 * rg + 4 * hi) = w0; *(u32x2*)(qp + 32 + 8 * rg + 4 * hi) = w1; }
        }
    }
}

__device__ __forceinline__ float ret_lg2(const Args& a, int layer, int dir, int head) {
    const float rde = a.in[14][layer * 8 + dir * 4 + head];
    return log1pf(-exp2f(-rde)) * 1.4426950408889634f;
}
__device__ __forceinline__ void ret_kv_item(const Args& a, int layer, int cgi, int hp, unsigned char* lds, const int wave0) {
    const int tid = (wave0 * 64 + pg8::lane_now()), lane = tid & 63, wave = wave0, r32 = lane & 31, hi = lane >> 5;
    const bf16_t* P = (const bf16_t*)(a.ws + WS_P);
    bf16_t* KV = (bf16_t*)(a.ws + WS_S + S_KV);
    constexpr int PT = 136;
    bf16_t* Ktf = (bf16_t*)lds; bf16_t* Ktb = Ktf + 2 * 64 * PT; bf16_t* Vt = Ktb + 2 * 64 * PT;
#pragma unroll
    for (int i = 0; i < 4; ++i) {
        const int pc = tid + NTHR * i; const int h = pc >> 10, j = (pc >> 3) & 127, ch = pc & 7; const int head = 2 * hp + h;
        const bf16_t* src = P + (size_t)(cgi * 128 + j) * PW + 6 * 256 + head * 64 + ch * 8;
        const u32x4 kr = *(const u32x4*)src, vr = *(const u32x4*)(src + 256);
        const float wf = exp2f((float)(127 - j) * ret_lg2(a, layer, 0, head)), wb = exp2f((float)j * ret_lg2(a, layer, 1, head));
#pragma unroll
        for (int e = 0; e < 8; ++e) { const float kv = bf2f(u16at(kr, e)); const int o = (h * 64 + ch * 8 + e) * PT + j;
            Ktf[o] = (bf16_t)f2bf1(kv * wf); Ktb[o] = (bf16_t)f2bf1(kv * wb); Vt[o] = u16at(vr, e); }
    }
    __syncthreads();
    {
        const int h = wave >> 2, sub = wave & 3, dir = sub >> 1, e0 = sub & 1; const int head = 2 * hp + h;
        const bf16_t* kt = (dir ? Ktb : Ktf) + h * 64 * PT; const bf16_t* vt = Vt + h * 64 * PT;
        f32x16 c0 = f32x16{}, c1 = f32x16{};
#pragma unroll
        for (int ks = 0; ks < 8; ++ks) {
            const bf16x8 av = *(const bf16x8*)(vt + (32 * e0 + r32) * PT + 16 * ks + 8 * hi);
            const bf16x8 b0 = *(const bf16x8*)(kt + r32 * PT + 16 * ks + 8 * hi), b1 = *(const bf16x8*)(kt + (32 + r32) * PT + 16 * ks + 8 * hi);
            c0 = mfma32(av, b0, c0); c1 = mfma32(av, b1, c1);
        }
        bf16_t* dst = KV + ((size_t)(cgi * 4 + head) * 2 + dir) * 4096;
#pragma unroll
        for (int r = 0; r < 16; ++r) { const int e = 32 * e0 + crow(r, hi); dst[e * 64 + r32] = (bf16_t)f2bf1(c0[r]); dst[e * 64 + 32 + r32] = (bf16_t)f2bf1(c1[r]); }
    }
    __syncthreads();
}
__device__ __forceinline__ void ret_scan(const Args& a, int layer, const int wave0) {
    const int gtid = blockIdx.x * NTHR + (wave0 * 64 + pg8::lane_now()), gthreads = gridDim.x * NTHR;
    bf16_t* KV = (bf16_t*)(a.ws + WS_S + S_KV);
    for (int idx = gtid; idx < 24 * 4 * 2 * 4096; idx += gthreads) {
        const int el = idx & 4095, dir = (idx >> 12) & 1, head = (idx >> 13) & 3, s = idx >> 15;
        const int chunk0 = s < 16 ? 16 * s : 256 + 64 * (s - 16), nc = s < 16 ? 16 : 64;
        const float gch = exp2f(128.0f * ret_lg2(a, layer, dir, head));
        float S = 0.f;
        bf16_t* base = KV + ((size_t)(chunk0 * 4 + head) * 2 + dir) * 4096 + el;
        for (int b = 0; b < nc; b += 16) {
            float tmp[16];
#pragma unroll
            for (int k = 0; k < 16; ++k) { const int n = b + k; const int cn = dir == 0 ? n : nc - 1 - n; tmp[k] = bf2f(base[(size_t)cn * 32768]); }
#pragma unroll
            for (int k = 0; k < 16; ++k) { const int n = b + k; const int cn = dir == 0 ? n : nc - 1 - n; base[(size_t)cn * 32768] = (bf16_t)f2bf1(S); S = gch * S + tmp[k]; }
        }
    }
}
__device__ __forceinline__ void ret_out_item(const Args& a, int layer, int cgi, int hp, unsigned char* lds, const int wave0) {
    const int tid = (wave0 * 64 + pg8::lane_now()), lane = tid & 63, wave = wave0, r32 = lane & 31, hi = lane >> 5;
    bf16_t* P = (bf16_t*)(a.ws + WS_P);
    const bf16_t* KV = (const bf16_t*)(a.ws + WS_S + S_KV);
    constexpr int PK = 72, PT = 136;
    bf16_t* Kr = (bf16_t*)lds;
    bf16_t* Vt = Kr + 2 * 128 * PK;
    bf16_t* St = Vt + 2 * 64 * PT;
#pragma unroll
    for (int i = 0; i < 4; ++i) {
        const int pc = tid + NTHR * i; const int h = pc >> 10, j = (pc >> 3) & 127, ch = pc & 7; const int head = 2 * hp + h;
        const bf16_t* src = P + (size_t)(cgi * 128 + j) * PW + 6 * 256 + head * 64 + ch * 8;
        const u32x4 kr = *(const u32x4*)src, vr = *(const u32x4*)(src + 256);
        *(u32x4*)(Kr + (h * 128 + j) * PK + ch * 8) = kr;
#pragma unroll
        for (int e = 0; e < 8; ++e) Vt[(h * 64 + ch * 8 + e) * PT + j] = u16at(vr, e);
        const int hd = pc >> 9, e_ = (pc >> 3) & 63;
        const int h2 = hd >> 1, dir = hd & 1;
        const u32x4 sr = *(const u32x4*)(KV + ((size_t)(cgi * 4 + 2 * hp + h2) * 2 + dir) * 4096 + e_ * 64 + ch * 8);
        *(u32x4*)(St + (hd * 64 + e_) * PK + ch * 8) = sr;
    }
    const int h = wave >> 2, isub = wave & 3; const int head = 2 * hp + h;
    const int irow = cgi * 128 + isub * 32 + r32;
    bf16_t* qp = P + (size_t)irow * PW + 5 * 256 + head * 64;
    bf16x8 qf[4];
#pragma unroll
    for (int ks = 0; ks < 4; ++ks) qf[ks] = *(const bf16x8*)(qp + 16 * ks + 8 * hi);
    __syncthreads();
    const float lgf = ret_lg2(a, layer, 0, head), lgb = ret_lg2(a, layer, 1, head);
    const int ipos = isub * 32 + r32;
    f32x16 o0 = f32x16{}, o1 = f32x16{};
    const bf16_t* kb = Kr + h * 128 * PK; const bf16_t* vb = Vt + h * 64 * PT;
#pragma nounroll
    for (int jt = 0; jt < 4; ++jt) {
        f32x16 s = f32x16{};
#pragma unroll
        for (int ks = 0; ks < 4; ++ks) s = mfma32(*(const bf16x8*)(kb + (32 * jt + r32) * PK + 16 * ks + 8 * hi), qf[ks], s);
#pragma unroll
        for (int r = 0; r < 16; ++r) { const int j = 32 * jt + crow(r, hi); const int dist = ipos - j;
            const float w = dist >= 0 ? __builtin_amdgcn_exp2f((float)dist * lgf) : __builtin_amdgcn_exp2f((float)(-dist) * lgb); s[r] *= w; }
        const bf16x8 pb0 = pack8r(s, 0), pb1 = pack8r(s, 8);
#pragma unroll
        for (int jj = 0; jj < 2; ++jj) {
            const int j16 = 32 * jt + 16 * jj; const bf16x8 pb = jj ? pb1 : pb0;
            const bf16x8 A0 = mk8(*(const u32x2*)(vb + r32 * PT + j16 + 4 * hi), *(const u32x2*)(vb + r32 * PT + j16 + 8 + 4 * hi));
            const bf16x8 A1 = mk8(*(const u32x2*)(vb + (32 + r32) * PT + j16 + 4 * hi), *(const u32x2*)(vb + (32 + r32) * PT + j16 + 8 + 4 * hi));
            o0 = mfma32(A0, pb, o0); o1 = mfma32(A1, pb, o1);
        }
    }
#pragma nounroll
    for (int dir = 0; dir < 2; ++dir) {
        const bf16_t* sb = St + ((h * 2 + dir) * 64) * PK;
        f32x16 x0 = f32x16{}, x1 = f32x16{};
#pragma unroll
        for (int ks = 0; ks < 4; ++ks) {
            x0 = mfma32(*(const bf16x8*)(sb + r32 * PK + 16 * ks + 8 * hi), qf[ks], x0);
            x1 = mfma32(*(const bf16x8*)(sb + (32 + r32) * PK + 16 * ks + 8 * hi), qf[ks], x1);
        }
        const float wq = dir == 0 ? exp2f((float)(ipos + 1) * lgf) : exp2f((float)(128 - ipos) * lgb);
#pragma unroll
        for (int r = 0; r < 16; ++r) { o0[r] += wq * x0[r]; o1[r] += wq * x1[r]; }
    }
    float ss = 0.f;
#pragma unroll
    for (int r = 0; r < 16; ++r) ss += o0[r] * o0[r] + o1[r] * o1[r];
    ss += pg8::shx(ss, 32);
    const float rn = 1.0f / sqrtf(ss * (1.0f / 64.0f) + EPS);
    const bf16_t* gp = P + (size_t)irow * PW + 8 * 256 + head * 64;
#pragma unroll
    for (int rg = 0; rg < 4; ++rg) {
        const u32x2 g0 = *(const u32x2*)(gp + 8 * rg + 4 * hi), g1 = *(const u32x2*)(gp + 32 + 8 * rg + 4 * hi);
        u32x2 w0, w1;
        w0.x = cvtpk(o0[4 * rg] * rn * bf2f(g0.x & 0xffffu), o0[4 * rg + 1] * rn * bf2f(g0.x >> 16)); w0.y = cvtpk(o0[4 * rg + 2] * rn * bf2f(g0.y & 0xffffu), o0[4 * rg + 3] * rn * bf2f(g0.y >> 16));
        w1.x = cvtpk(o1[4 * rg] * rn * bf2f(g1.x & 0xffffu), o1[4 * rg + 1] * rn * bf2f(g1.x >> 16)); w1.y = cvtpk(o1[4 * rg + 2] * rn * bf2f(g1.y & 0xffffu), o1[4 * rg + 3] * rn * bf2f(g1.y >> 16));
        *(u32x2*)(qp + 8 * rg + 4 * hi) = w0; *(u32x2*)(qp + 32 + 8 * rg + 4 * hi) = w1;
    }
    __syncthreads();
}

__device__ __forceinline__ void sc_rows(const Args& a, int layer, const int wave0) {
    const int gtid = blockIdx.x * NTHR + (wave0 * 64 + pg8::lane_now()), gthreads = gridDim.x * NTHR;
    bf16_t* P = (bf16_t*)(a.ws + WS_P);
    const float* scw = a.in[15] + layer * 3 * 256;
    for (int idx = gtid; idx < T_ALL * 32; idx += gthreads) {
        const int R = idx >> 5, cg8 = idx & 31;
        const int L = R < T_PROMPT ? 2048 : 8192, t = R & (L - 1);
        bf16_t* pr = P + (size_t)R * PW + 9 * 256 + 8 * cg8;
        const u32x4 zz = (u32x4){0u, 0u, 0u, 0u};
        const u32x4 sb = *(const u32x4*)pr;
        const u32x4 cc = *(const u32x4*)(pr + 256), hc = *(const u32x4*)(pr + 512);
        const u32x4 cm = t > 0 ? *(const u32x4*)(pr + 256 - PW) : zz, hm = t > 0 ? *(const u32x4*)(pr + 512 - PW) : zz;
        const u32x4 cp = t < L - 1 ? *(const u32x4*)(pr + 256 + PW) : zz, hp = t < L - 1 ? *(const u32x4*)(pr + 512 + PW) : zz;
        float o[8];
#pragma unroll
        for (int e = 0; e < 8; ++e) { const int lc = pi_slot(8 * cg8 + e);
            const float y = scw[lc] * (bf2f(u16at(cm, e)) * bf2f(u16at(hm, e))) + scw[256 + lc] * (bf2f(u16at(cc, e)) * bf2f(u16at(hc, e))) + scw[512 + lc] * (bf2f(u16at(cp, e)) * bf2f(u16at(hp, e)));
            o[e] = bf2f(u16at(sb, e)) * y; }
        u32x4 w; w.x = cvtpk(o[0], o[1]); w.y = cvtpk(o[2], o[3]); w.z = cvtpk(o[4], o[5]); w.w = cvtpk(o[6], o[7]);
        *(u32x4*)pr = w;
    }
}


#ifndef STOP_AFTER
#define STOP_AFTER 0
#endif
__device__ __forceinline__ void dbg_fold(const Args& a, const bf16_t* src, int ld, int ncol3, const int wave0) {
    const int gtid = blockIdx.x * NTHR + (wave0 * 64 + pg8::lane_now()), gthreads = gridDim.x * NTHR;
    for (int idx = gtid; idx < T_ALL * 1024; idx += gthreads) { const int r = idx >> 10, c = idx & 1023; float v = 0.f;
        for (int k = 0; k < ncol3; ++k) v += bf2f(src[(size_t)r * ld + c + 1024 * k]);
        a.out[idx] = v; }
}

#define GAS __attribute__((address_space(1)))
#define XB_TMO      128
#define XB_XCNT(j)  (256  + 64 * (j))
#define XB_XSUB(j)  (1280 + 64 * (j))
#define XB_XGEN(j)  (2304 + 64 * (j))
#define XB_TOP      3328
#define XB_TOPGEN   3392
#define XCD_BAR_WORDS 3456
#define XB_SPIN_CAP (1u << 18)

__device__ __forceinline__ unsigned xb_ld(unsigned* p)              { return __hip_atomic_load(p, __ATOMIC_RELAXED, __HIP_MEMORY_SCOPE_AGENT); }
__device__ __forceinline__ unsigned xb_add(unsigned* p, unsigned v) { return __hip_atomic_fetch_add(p, v, __ATOMIC_RELAXED, __HIP_MEMORY_SCOPE_AGENT); }
__device__ __forceinline__ unsigned xb_xcc_id() { return (unsigned)__builtin_amdgcn_s_getreg((3 << 11) | 20) & 0xFu; }
#define XB_SPIN(cond, bar) do { unsigned _sp = 0; while (cond) { __builtin_amdgcn_s_sleep(1); \
    if ((++_sp & 255u) == 0u) { if (xb_ld(&(bar)[XB_TMO])) break; if (_sp > XB_SPIN_CAP) { atomicAdd(&(bar)[XB_TMO], 1u); break; } } } } while (0)

struct XcdBarrier {
    unsigned* bar; unsigned x; int w0;
    volatile LAS unsigned* st;
};

__device__ __forceinline__ XcdBarrier xcd_barrier_post(unsigned* bar, volatile LAS unsigned* st, int w0) {
    XcdBarrier b; b.bar = bar; b.x = xb_xcc_id(); b.st = st; b.w0 = w0;
    if (w0 == 0 && pg8::lane_now() == 0) (void)xb_add(&bar[XB_XCNT(b.x)], 1u);
    return b;
}
__device__ __forceinline__ void xcd_barrier_complete(unsigned* bar, unsigned x, unsigned& nloc, unsigned& nx) {
    const unsigned G = gridDim.x * gridDim.y * gridDim.z;
    unsigned sum, cnt, mine, sp = 0u;
    for (;;) {
        sum = 0u; cnt = 0u; mine = 0u;
#pragma unroll
        for (unsigned j = 0; j < 16; ++j) { const unsigned c = xb_ld(&bar[XB_XCNT(j)]); sum += c; cnt += (c > 0u) ? 1u : 0u; mine = (j == x) ? c : mine; }
        if (sum == G) break;
        __builtin_amdgcn_s_sleep(1);
        if ((++sp & 255u) == 0u) { if (xb_ld(&bar[XB_TMO])) break; if (sp > XB_SPIN_CAP) { atomicAdd(&bar[XB_TMO], 1u); break; } }
    }
    nloc = mine > 0u ? mine : 1u; nx = cnt > 0u ? cnt : 1u;
}

__device__ __forceinline__ void xcd_barrier(const XcdBarrier& b) {
    asm volatile("s_waitcnt vmcnt(0)" ::: "memory");
    __syncthreads();
    if (b.w0 == 0 && pg8::lane_now() == 0) {
        unsigned* bar = b.bar;
        __builtin_amdgcn_s_waitcnt(0);
        unsigned nloc = b.st[0], nx = b.st[1];
        if (nloc == 0u) { xcd_barrier_complete(bar, b.x, nloc, nx); b.st[0] = nloc; b.st[1] = nx; }
        const unsigned old = xb_add(&bar[XB_XSUB(b.x)], 1u);
        const unsigned gen = old / nloc;
        if (old + 1u == (gen + 1u) * nloc) {
            __builtin_amdgcn_fence(__ATOMIC_RELEASE, "agent");
            asm volatile("s_waitcnt vmcnt(0)" ::: "memory");
            const unsigned og = xb_add(&bar[XB_TOP], 1u);
            const unsigned tg = og / nx;
            if (og + 1u == (tg + 1u) * nx) xb_add(&bar[XB_TOPGEN], 1u);
            else XB_SPIN(xb_ld(&bar[XB_TOPGEN]) == tg, bar);
            __builtin_amdgcn_fence(__ATOMIC_ACQUIRE, "agent");
            xb_add(&bar[XB_XGEN(b.x)], 1u);
            asm volatile("s_waitcnt vmcnt(0)" ::: "memory");
        } else {
            XB_SPIN(xb_ld(&bar[XB_XGEN(b.x)]) == gen, bar);
            __builtin_amdgcn_fence(__ATOMIC_ACQUIRE, "agent");
            asm volatile("s_waitcnt vmcnt(0)" ::: "memory");
        }
    }
    __syncthreads();
}

template <class Epi>
__device__ __forceinline__ void run_gemm(unsigned char* lds, const bf16_t* A, const bf16_t* Bt, int M, int N, int K, int lda, int ldb, const Epi& E, const int wave0) {
    pg8::Gemm g{A, Bt, M, N, K, lda, ldb}; pg8::StaticOrder S; S.init(M, N, (int)gridDim.x, (int)blockIdx.x);
    pg8::gemm_phase<Epi, pg8::StaticOrder, true, true>((PG8_LAS unsigned char*)lds, g, S, E, wave0);
}

__global__ void __launch_bounds__(NTHR, 2) fwd_megakernel(Args a) {
    extern __shared__ __attribute__((aligned(16))) unsigned char lds[];
    cg::grid_group grid = cg::this_grid();
    const int wave0 = __builtin_amdgcn_readfirstlane((int)threadIdx.x >> 6);
    const int G = gridDim.x, bx = blockIdx.x;
    volatile LAS unsigned* xst = (volatile LAS unsigned*)((LAS unsigned char*)lds + (LDS_BYTES - 64));
    if (wave0 == 0 && pg8::lane_now() == 0) { xst[0] = 0u; xst[1] = 0u; }
    __syncthreads();
    XcdBarrier xbar = xcd_barrier_post((unsigned*)(a.ws + WS_CTL), xst, wave0);
    grid.sync();
    unsigned char* ws = a.ws;
    bf16_t* P = (bf16_t*)(ws + WS_P); bf16_t* XN = (bf16_t*)(ws + WS_XN);
    float* rcos = (float*)(ws + WS_MISC); float* rsin = rcos + 2048;
    bf16_t* YB = (bf16_t*)(ws + WS_S + S_GATE); bf16_t* XN2 = (bf16_t*)(ws + WS_S + 160 * MiB); bf16_t* ACT = (bf16_t*)(ws + WS_S + 224 * MiB); float* XB = (float*)(ws + 37 * MiB); unsigned* CNT = (unsigned*)(ws + WS_CTL) + 8192;
    float* MF = (float*)(ws + WS_S + S_MF); bf16_t* MB = (bf16_t*)(ws + WS_S + S_MB);

#if PROBE_T
    unsigned long long tprev = __builtin_amdgcn_s_memrealtime(), tacc = 0;
#endif
    for (int layer = 0; layer < 2; ++layer) {
        const float* ng = a.in[2] + layer * 4 * DM;
        if (EN & 1) prep_weights(a, layer, lds, wave0);
        __syncthreads();
        if (layer == 0 && bx == G - 1) rope_table(rcos, rsin, wave0);
        if (EN & 2) for (int it = bx; it < 640; it += G) hy_filter_item(a, layer, it, lds, wave0);
        GSYNC(); TMARK(1);
        if (EN & 2) for (int it = bx; it < 512; it += G) hy_window_item(a, it, lds, wave0);
        norm_x_rows(a, layer, 0, ng, XN, wave0);
        GSYNC(); TMARK(2);
        for (int g = 0; g < NGROUP; ++g) {
            bf16_t* xa = (g & 1) ? XN2 : XN; bf16_t* xb = (g & 1) ? XN : XN2;
            pg8::EpiIn E{P, g * GROUP, a.in[4] + layer * 128, rcos, rsin, QSCALE};
            if (EN & 4) run_gemm(lds, xa, (const bf16_t*)(ws + WS_WIN), GROUP, PW, DM, DM, DM, E, wave0);
#if PROBE_DUP & 4
            run_gemm(lds, xa, (const bf16_t*)(ws + WS_WIN), GROUP, PW, DM, DM, DM, E, wave0);
#endif
            if (g + 1 < NGROUP) norm_x_rows(a, layer, g + 1, ng, xb, wave0);
            GSYNC(); TMARK(2);
        }
        if (STOP_AFTER == 1) { dbg_fold(a, P, PW, 3, wave0); return; }
        if (EN & 8) for (int it = bx; it < 768 * 2; it += G) ret_kv_item(a, layer, it >> 1, it & 1, lds, wave0);
        GSYNC(); TMARK(3);
        if (EN & 8) ret_scan(a, layer, wave0);
        GSYNC(); TMARK(3);
        if (EN & 16) for (int it = bx; it < 256; it += G) hyena_item<8>(a, layer, T_PROMPT + (it >> 5) * 8192, it & 31, lds, true, wave0);
        if (EN & 32) for (int it = bx; it < 512; it += G) hyena_item<2>(a, layer, (it >> 5) * 2048, it & 31, lds, true, wave0);
        if (EN & 64) for (int it = bx; it < 512; it += G) { const int pair = it & 15, qb = it >> 4; attn_unit(P, T_PROMPT + (pair >> 1) * 8192, 8192, pair & 1, qb, lds, true, wave0); }
        if (EN & 64) for (int it = bx; it < 256; it += G) { const int pair = it & 31, qb = it >> 5; attn_unit(P, (pair >> 1) * 2048, 2048, pair & 1, qb, lds, true, wave0); }
#if PROBE_DUP & 1
        { const bool never = (a.out == nullptr);
        for (int it = bx; it < 512; it += G) { const int pair = it & 15, qb = it >> 4; attn_unit(P, T_PROMPT + (pair >> 1) * 8192, 8192, pair & 1, qb, lds, never, wave0); }
        for (int it = bx; it < 256; it += G) { const int pair = it & 31, qb = it >> 5; attn_unit(P, (pair >> 1) * 2048, 2048, pair & 1, qb, lds, never, wave0); } }
#endif
#if PROBE_DUP & 2
        { const bool never = (a.out == nullptr);
        for (int it = bx; it < 256; it += G) hyena_item<8>(a, layer, T_PROMPT + (it >> 5) * 8192, it & 31, lds, never, wave0);
        for (int it = bx; it < 512; it += G) hyena_item<2>(a, layer, (it >> 5) * 2048, it & 31, lds, never, wave0); }
#endif
        if (EN & 128) for (int it = bx; it < 768 * 2; it += G) ret_out_item(a, layer, it >> 1, it & 1, lds, wave0);
        if (EN & 256) sc_rows(a, layer, wave0);
        GSYNC(); TMARK(3);
        if (STOP_AFTER == 2) { dbg_fold(a, P, PW, 3, wave0); return; }
        norm_x_rows(a, layer, 0, ng, XN, wave0);
        { pg8::EpiY E{YB}; run_gemm(lds, P, (const bf16_t*)(ws + WS_WB), GROUP, 4096, 256, PW, 256, E, wave0); }
        GSYNC(); TMARK(5);
        for (int g = 0; g < NGROUP; ++g) {
            const unsigned inst = (unsigned)(layer * NGROUP + g);
            float* outg = a.out + (size_t)g * GROUP * DM;
            const float* xg = layer == 0 ? (g < 2 ? a.in[0] + (size_t)g * GROUP * DM : a.in[1] + (size_t)(g - 2) * GROUP * DM) : outg;
            { pg8::EpiMerge E{YB, MB}; run_gemm(lds, XN, (const bf16_t*)(ws + WS_WG), GROUP, 4096, DM, DM, DM, E, wave0); }
            GSYNC(); TMARK(6);
            { pg8::RmsStats s1{XB, CNT, 16u * (inst + 1u)}, s2{XB + 65536, CNT + 4096, 16u * (inst + 1u)};
              pg8::EpiRmsResRms E{xg, outg, XN, ng + DM, ng + 2 * DM, s1, s2}; run_gemm(lds, MB, (const bf16_t*)(ws + WS_WO), GROUP, DM, DM, DM, DM, E, wave0); }
            GSYNC(); TMARK(7);
            { pg8::EpiSwiglu E{ACT}; run_gemm(lds, XN, (const bf16_t*)(ws + WS_WFI), GROUP, 2 * DFF, DM, DM, DM, E, wave0); }
#if PROBE_DUP & 8
            { pg8::EpiSwiglu E{ACT}; run_gemm(lds, XN, (const bf16_t*)(ws + WS_WFI), GROUP, 2 * DFF, DM, DM, DM, E, wave0); }
#endif
            GSYNC(); TMARK(6);
            { pg8::RmsStats s3{XB + 2 * 65536, CNT + 2 * 4096, 16u * (inst + 1u)};
              pg8::EpiRmsRes E{outg, outg, ng + 3 * DM, s3}; run_gemm(lds, ACT, (const bf16_t*)(ws + WS_WFO), GROUP, DM, DFF, DFF, DFF, E, wave0); }
            if (g + 1 < NGROUP) {
                norm_x_rows(a, layer, g + 1, ng, XN, wave0);
                pg8::EpiY E{YB}; run_gemm(lds, P + (size_t)(g + 1) * GROUP * PW, (const bf16_t*)(ws + WS_WB), GROUP, 4096, 256, PW, 256, E, wave0);
#if PROBE_DUP & 16
                run_gemm(lds, P + (size_t)(g + 1) * GROUP * PW, (const bf16_t*)(ws + WS_WB), GROUP, 4096, 256, PW, 256, E, wave0);
#endif
            }
            GSYNC(); TMARK(5);
        }
    }
#if PROBE_T
    if (bx == 0 && wave0 == 0 && pg8::lane_now() == 0) a.out[0] += (float)tacc * 0.0005f;
#endif
}

extern "C" void kernel_launch(void* const* d_in, const int* in_sizes, int n_in, void* d_out, int out_size, void* d_ws, size_t ws_size, hipStream_t stream) {
    static int grid = 0;
    if (grid == 0) {
        if (n_in != 20 || out_size != T_ALL * DM || ws_size < WS_NEED) { fprintf(stderr, "kernel_launch: unexpected shapes: n_in %d out %d ws %zu (need %zu)\n", n_in, out_size, ws_size, (size_t)WS_NEED); grid = -1; return; }
        int dev = 0, cus = 0, per_cu = 0;
        hipGetDevice(&dev); hipDeviceGetAttribute(&cus, hipDeviceAttributeMultiprocessorCount, dev);
        hipFuncSetAttribute((const void*)fwd_megakernel, hipFuncAttributeMaxDynamicSharedMemorySize, LDS_BYTES);
        hipOccupancyMaxActiveBlocksPerMultiprocessor(&per_cu, (const void*)fwd_megakernel, NTHR, LDS_BYTES);
        (void)hipGetLastError();
        if (per_cu < 1) per_cu = 1;
        grid = cus * 1;
        fprintf(stderr, "kernel_launch: cus %d per_cu %d grid %d\n", cus, per_cu, grid);
    }
    if (grid < 0) return;
    Args a{};
    for (int i = 0; i < 20; ++i) a.in[i] = (const float*)d_in[i];
    a.out = (float*)d_out; a.ws = (unsigned char*)d_ws;
    if (hipMemsetAsync((char*)d_ws + WS_CTL, 0, CTL_BYTES, stream) != hipSuccess) { fprintf(stderr, "memset failed\n"); return; }
    void* args[] = {&a};
    hipError_t e = hipLaunchCooperativeKernel((const void*)fwd_megakernel, dim3(grid), dim3(NTHR), args, LDS_BYTES, stream);
    if (e != hipSuccess) fprintf(stderr, "cooperative launch failed: %s (grid %d)\n", hipGetErrorString(e), grid);
}
```

```cpp
#include <hip/hip_runtime.h>
#include <hip/hip_cooperative_groups.h>
#include <cstdio>
#include <cstdint>
namespace pg8 {
#define PG8_LAS __attribute__((address_space(3)))
typedef unsigned short bf16_t;
typedef short bf16x8 __attribute__((ext_vector_type(8)));
typedef float f32x4 __attribute__((ext_vector_type(4)));
typedef unsigned u32x4 __attribute__((ext_vector_type(4)));
__device__ __forceinline__ int opq(int x) { asm volatile("" : "+v"(x)); return x; }
__device__ __forceinline__ int lane_now() { int l; asm volatile("v_mbcnt_lo_u32_b32 %0, -1, 0\n\tv_mbcnt_hi_u32_b32 %0, -1, %0" : "=v"(l)); return l; }
__device__ __forceinline__ float shx(float v, int o) { return __builtin_bit_cast(float, __builtin_amdgcn_ds_bpermute((lane_now() ^ o) << 2, __builtin_bit_cast(int, v))); }
constexpr int BM = 256, BK = 64, HALF = 128, HTB = HALF * BK * 2  , STAGE_BYTES = 8 * HTB, NXCD = 8, WGM = 8;

__host__ __device__ __forceinline__ int lds_byte(int r, int c) { const int st = (r >> 4) * 2 + (c >> 5), rr = r & 15, cc = c & 31, ob = rr * 64 + cc * 2; return st * 1024 + (ob ^ (((ob >> 9) & 1) << 5)); }
__host__ __device__ __forceinline__ void stage_rc(int b, int& R, int& C) { const int st = b / 1024, sb = b % 1024, swz = sb ^ (((sb >> 9) & 1) << 5); R = (st >> 1) * 16 + swz / 64; C = (st & 1) * 32 + (swz % 64) / 2; }
__host__ __device__ __forceinline__ int perm32(int rho) { const int n = rho >> 4, i = rho & 15; return 8 * (i >> 2) + 4 * n + (i & 3); }

struct Unit { int pm, pn; };
struct Gemm { const bf16_t* A; const bf16_t* Bt; int M, N, K, lda, ldb; };

struct StaticOrder {
    int nM, nN, nwg, G, c;
    __host__ __device__ void init(int M, int N, int G_, int c_) { nM = M / BM; nN = N / BM; nwg = nM * nN; G = G_; c = c_; }
    __host__ __device__ bool next(int i, Unit& u) const {
        const long L = (long)i * G + c; if (L >= nwg) return false;
        int wgid = (int)L; { const int q = nwg / NXCD, r = nwg % NXCD, xcd = wgid % NXCD, off = wgid / NXCD; wgid = (xcd < r ? xcd * (q + 1) : r * (q + 1) + (xcd - r) * q) + off; }
        const int nig = WGM * nN, gid = wgid / nig, fm = gid * WGM, gsz = (nM - fm) < WGM ? (nM - fm) : WGM;
        u.pm = fm + ((wgid % nig) % gsz); u.pn = (wgid % nig) / gsz; return true;
    }
    __device__ __forceinline__ void a_ready(const Unit&) const {}
    __device__ __forceinline__ void done(const Unit&) const {}
};

typedef float f32x2 __attribute__((ext_vector_type(2)));
typedef __bf16 bf16x2_t __attribute__((ext_vector_type(2)));
__device__ __forceinline__ unsigned cvt_pk_bf16(float lo, float hi) { f32x2 v = {lo, hi}; bf16x2_t b = __builtin_convertvector(v, bf16x2_t); return __builtin_bit_cast(unsigned, b); }
typedef float f32x16 __attribute__((ext_vector_type(16)));
__device__ __forceinline__ f32x4 ldg4(const float* p) { return *(const f32x4*)p; }
__device__ __forceinline__ u32x4 pack8(const f32x4 a, const f32x4 b) { u32x4 w; w.x = cvt_pk_bf16(a[0], a[1]); w.y = cvt_pk_bf16(a[2], a[3]); w.z = cvt_pk_bf16(b[0], b[1]); w.w = cvt_pk_bf16(b[2], b[3]); return w; }
__device__ __forceinline__ float bf2f(unsigned h) { return __uint_as_float(h << 16); }
__device__ __forceinline__ f32x4 unpack_lo(const u32x4 w) { return (f32x4){__uint_as_float(w.x << 16), __uint_as_float(w.x & 0xffff0000u), __uint_as_float(w.y << 16), __uint_as_float(w.y & 0xffff0000u)}; }
__device__ __forceinline__ f32x4 unpack_hi(const u32x4 w) { return (f32x4){__uint_as_float(w.z << 16), __uint_as_float(w.z & 0xffff0000u), __uint_as_float(w.w << 16), __uint_as_float(w.w & 0xffff0000u)}; }
__device__ __forceinline__ int branch_tile(int n) { return n == 0 ? 0 : (n == 1 ? 3 : (n == 2 ? 5 : 9)); }
__device__ __forceinline__ float sigm(float v) { return __builtin_amdgcn_rcpf(1.0f + __builtin_amdgcn_exp2f(-1.4426950408889634f * v)); }

struct EpiIn {
    static constexpr bool PERM = true, AFTER_DRAIN = false, BRANCH_A = false;
    bf16_t* P; int row_base; const float* qkn; const float* rcos; const float* rsin; float qscale;
    __device__ __forceinline__ void operator()(const f32x4 (&acc)[2][2][4][2], const Unit& u, int wr, int wc, int fr_, int fq_) const {
        const int ln_ = lane_now(); const int fr = ln_ & 15, fq = ln_ >> 4; (void)fr_; (void)fq_;
        const int pn = u.pn;
        const bool is_k = (pn == 1 && wc < 2);
        const bool do_norm = (pn == 0) || is_k;
        const bool do_rope = do_norm || pn == 5 || pn == 6;
        const float scale = (pn == 0) ? qscale : (pn == 6 ? 0.125f : 1.0f);
        const bool do_silu = (pn == 8);
        const float* gp = qkn + (is_k ? 64 : 0) + 4 * fq;
#pragma unroll
        for (int ai = 0; ai < 2; ++ai)
#pragma unroll
            for (int m = 0; m < 4; ++m) {
                const int row = row_base + u.pm * BM + ai * HALF + wr * 64 + m * 16 + fr;
                f32x4 v[2][2];
#pragma unroll
                for (int bj = 0; bj < 2; ++bj)
#pragma unroll
                    for (int n = 0; n < 2; ++n) v[bj][n] = acc[ai][bj][m][n];
                if (do_norm) {
                    float ss = 0.f;
#pragma unroll
                    for (int bj = 0; bj < 2; ++bj)
#pragma unroll
                        for (int n = 0; n < 2; ++n) ss += (v[bj][n][0] * v[bj][n][0] + v[bj][n][1] * v[bj][n][1]) + (v[bj][n][2] * v[bj][n][2] + v[bj][n][3] * v[bj][n][3]);
                    ss += shx(ss, 16); ss += shx(ss, 32);
                    const float rn = 1.0f / sqrtf(ss * (1.0f / 64.0f) + 1e-6f);
#pragma unroll
                    for (int bj = 0; bj < 2; ++bj)
#pragma unroll
                        for (int n = 0; n < 2; ++n) v[bj][n] = v[bj][n] * rn * ldg4(gp + 32 * bj + 16 * n);
                }
                if (do_rope) {
                    const int L = row < 32768 ? 2048 : 8192; const int t = row & (L - 1);
#pragma unroll
                    for (int bj = 0; bj < 2; ++bj) {
                        const int pos = bj == 0 ? (t >> 6) : (t & 63);
                        const f32x4 c = ldg4(rcos + pos * 16 + 4 * fq), s = ldg4(rsin + pos * 16 + 4 * fq);
                        const f32x4 a = v[bj][0], b = v[bj][1];
                        v[bj][0] = a * c - b * s; v[bj][1] = b * c + a * s;
                    }
                }
#pragma unroll
                for (int bj = 0; bj < 2; ++bj) {
                    f32x4 x0 = v[bj][0] * scale, x1 = v[bj][1] * scale;
                    if (do_silu) {
#pragma unroll
                        for (int i = 0; i < 4; ++i) { x0[i] = x0[i] * sigm(x0[i]); x1[i] = x1[i] * sigm(x1[i]); }
                    }
                    *(u32x4*)(P + ((unsigned)row * 3072u + (unsigned)(pn * 256 + 64 * wc + 32 * bj + 8 * fq))) = pack8(x0, x1);
                }
                asm volatile("" ::: "memory");
            }
    }
};
struct EpiGate {
    static constexpr bool PERM = true, AFTER_DRAIN = false, BRANCH_A = false;
    bf16_t* O; int ldc;
    __device__ __forceinline__ void operator()(const f32x4 (&acc)[2][2][4][2], const Unit& u, int wr, int wc, int fr_, int fq_) const {
        const int ln_ = lane_now(); const int fr = ln_ & 15, fq = ln_ >> 4; (void)fr_; (void)fq_;
#pragma unroll
        for (int ai = 0; ai < 2; ++ai)
#pragma unroll
            for (int m = 0; m < 4; ++m) {
                const int row = u.pm * BM + ai * HALF + wr * 64 + m * 16 + fr;
#pragma unroll
                for (int bj = 0; bj < 2; ++bj) {
                    f32x4 x0 = acc[ai][bj][m][0], x1 = acc[ai][bj][m][1];
#pragma unroll
                    for (int i = 0; i < 4; ++i) { x0[i] = sigm(x0[i]); x1[i] = sigm(x1[i]); }
                    *(u32x4*)(O + ((unsigned)row * (unsigned)ldc + (unsigned)(u.pn * BM + bj * HALF + wc * 32 + 8 * fq))) = pack8(x0, x1);
                }
            }
    }
};
struct EpiBranch {
    static constexpr bool PERM = true, AFTER_DRAIN = false, BRANCH_A = false;
    const bf16_t* G; float* MF; bf16_t* MB; int nbr;
    __device__ __forceinline__ void operator()(const f32x4 (&acc)[2][2][4][2], const Unit& u, int wr, int wc, int fr_, int fq_) const {
        const int ln_ = lane_now(); const int fr = ln_ & 15, fq = ln_ >> 4; (void)fr_; (void)fq_;
#pragma unroll
        for (int ai = 0; ai < 2; ++ai)
#pragma unroll
            for (int m = 0; m < 4; ++m) {
                const int row = u.pm * BM + ai * HALF + wr * 64 + m * 16 + fr;
#pragma unroll
                for (int bj = 0; bj < 2; ++bj) {
                    const int col = u.pn * BM + bj * HALF + wc * 32 + 8 * fq;
                    const u32x4 gw = *(const u32x4*)(G + ((unsigned)row * 4096u + (unsigned)(nbr * 1024 + col)));
                    f32x4 x0 = acc[ai][bj][m][0] * unpack_lo(gw), x1 = acc[ai][bj][m][1] * unpack_hi(gw);
                    float* mp = MF + ((unsigned)row * 1024u + (unsigned)col);
                    if (nbr != 0) { x0 = x0 + ldg4(mp); x1 = x1 + ldg4(mp + 4); }
                    if (nbr == 3) *(u32x4*)(MB + ((unsigned)row * 1024u + (unsigned)col)) = pack8(x0, x1);
                    else { *(f32x4*)mp = x0; *(f32x4*)(mp + 4) = x1; }
                    asm volatile("" ::: "memory");
                }
            }
    }
};
struct EpiF32 {
    static constexpr bool PERM = true, AFTER_DRAIN = false, BRANCH_A = false;
    float* O; int ldc;
    __device__ __forceinline__ void operator()(const f32x4 (&acc)[2][2][4][2], const Unit& u, int wr, int wc, int fr_, int fq_) const {
        const int ln_ = lane_now(); const int fr = ln_ & 15, fq = ln_ >> 4; (void)fr_; (void)fq_;
#pragma unroll
        for (int ai = 0; ai < 2; ++ai)
#pragma unroll
            for (int m = 0; m < 4; ++m) {
                const int row = u.pm * BM + ai * HALF + wr * 64 + m * 16 + fr;
#pragma unroll
                for (int bj = 0; bj < 2; ++bj) {
                    float* op = O + ((unsigned)row * (unsigned)ldc + (unsigned)(u.pn * BM + bj * HALF + wc * 32 + 8 * fq));
                    *(f32x4*)op = acc[ai][bj][m][0]; *(f32x4*)(op + 4) = acc[ai][bj][m][1];
                }
            }
    }
};
struct EpiSwiglu {
    static constexpr bool PERM = true, AFTER_DRAIN = false, BRANCH_A = false;
    bf16_t* O;
    __device__ __forceinline__ void operator()(const f32x4 (&acc)[2][2][4][2], const Unit& u, int wr, int wc, int fr_, int fq_) const {
        const int ln_ = lane_now(); const int fr = ln_ & 15, fq = ln_ >> 4; (void)fr_; (void)fq_;
#pragma unroll
        for (int ai = 0; ai < 2; ++ai)
#pragma unroll
            for (int m = 0; m < 4; ++m) {
                const int row = u.pm * BM + ai * HALF + wr * 64 + m * 16 + fr;
                f32x4 x0 = acc[ai][0][m][0], x1 = acc[ai][0][m][1];
                const f32x4 u0 = acc[ai][1][m][0], u1 = acc[ai][1][m][1];
#pragma unroll
                for (int i = 0; i < 4; ++i) { x0[i] = x0[i] * sigm(x0[i]) * u0[i]; x1[i] = x1[i] * sigm(x1[i]) * u1[i]; }
                *(u32x4*)(O + ((unsigned)row * 2816u + (unsigned)(u.pn * HALF + wc * 32 + 8 * fq))) = pack8(x0, x1);
            }
    }
};

struct EpiY {
    static constexpr bool PERM = true, AFTER_DRAIN = false, BRANCH_A = true;
    bf16_t* Y;
    __device__ __forceinline__ void operator()(const f32x4 (&acc)[2][2][4][2], const Unit& u, int wr, int wc, int fr_, int fq_) const {
        const int ln_ = lane_now(); const int fr = ln_ & 15, fq = ln_ >> 4; (void)fr_; (void)fq_;
        const int br = u.pn >> 2, ct = u.pn & 3;
#pragma unroll
        for (int ai = 0; ai < 2; ++ai)
#pragma unroll
            for (int m = 0; m < 4; ++m) {
                const int row = u.pm * BM + ai * HALF + wr * 64 + m * 16 + fr;
#pragma unroll
                for (int bj = 0; bj < 2; ++bj) {
                    const int ch0 = 256 * ct + 128 * bj + 32 * wc + 8 * fq;
                    *(u32x4*)(Y + ((unsigned)row * 4096u + (unsigned)(br * 1024 + ch0))) = pack8(acc[ai][bj][m][0], acc[ai][bj][m][1]);
                }
            }
    }
};
struct EpiMerge {
    static constexpr bool PERM = true, AFTER_DRAIN = false, BRANCH_A = false;
    const bf16_t* Y; bf16_t* MB;
    __device__ __forceinline__ void operator()(const f32x4 (&acc)[2][2][4][2], const Unit& u, int wr, int wc, int fr_, int fq_) const {
        const int ln_ = lane_now(); const int fr = ln_ & 15, fq = ln_ >> 4; (void)fr_; (void)fq_;
        const int ch0 = 64 * u.pn + 16 * wc + 4 * fq;
#pragma unroll
        for (int ai = 0; ai < 2; ++ai)
#pragma unroll
            for (int m = 0; m < 4; ++m) {
                const int row = u.pm * BM + ai * HALF + wr * 64 + m * 16 + fr;
                typedef unsigned u32x2_t __attribute__((ext_vector_type(2)));
                const bf16_t* yp = Y + ((unsigned)row * 4096u + (unsigned)ch0);
                const u32x2_t ya = *(const u32x2_t*)yp, yb = *(const u32x2_t*)(yp + 1024), yc = *(const u32x2_t*)(yp + 2048), yd = *(const u32x2_t*)(yp + 3072);
                const u32x4 yab = (u32x4){ya.x, ya.y, yb.x, yb.y}, ycd = (u32x4){yc.x, yc.y, yd.x, yd.y};
                const f32x4 y0 = unpack_lo(yab), y1 = unpack_hi(yab), y2 = unpack_lo(ycd), y3 = unpack_hi(ycd);
                f32x4 o;
#pragma unroll
                for (int i = 0; i < 4; ++i) o[i] = sigm(acc[ai][0][m][0][i]) * y0[i] + sigm(acc[ai][0][m][1][i]) * y1[i] + sigm(acc[ai][1][m][0][i]) * y2[i] + sigm(acc[ai][1][m][1][i]) * y3[i];
                u32x2_t w; w.x = cvt_pk_bf16(o[0], o[1]); w.y = cvt_pk_bf16(o[2], o[3]);
                *(u32x2_t*)(MB + ((unsigned)row * 1024u + (unsigned)ch0)) = w;
                asm volatile("" ::: "memory");
            }
    }
};

struct RmsStats {
    float* xbuf;
    unsigned* cnt;
    unsigned want;
    __device__ __forceinline__ void run(const f32x4 (&v)[2][2][4][2], const Unit& u, int wr, int wc, PG8_LAS unsigned char* lds, int wid) const {
        const int lane = lane_now(), fr = lane & 15, fq = lane >> 4;
        PG8_LAS float* Pp = (PG8_LAS float*)lds; PG8_LAS float* S = (PG8_LAS float*)(lds + 4096);
#pragma unroll
        for (int ai = 0; ai < 2; ++ai)
#pragma unroll
            for (int m = 0; m < 4; ++m) {
                float s = 0.f;
#pragma unroll
                for (int bj = 0; bj < 2; ++bj)
#pragma unroll
                    for (int n = 0; n < 2; ++n) { const f32x4 x = v[ai][bj][m][n]; s += (x[0] * x[0] + x[1] * x[1]) + (x[2] * x[2] + x[3] * x[3]); }
                s += shx(s, 16); s += shx(s, 32);
                if (fq == 0) Pp[(ai * HALF + wr * 64 + m * 16 + fr) * 4 + wc] = s;
            }
        asm volatile("s_waitcnt lgkmcnt(0)" ::: "memory"); __builtin_amdgcn_s_barrier(); asm volatile("" ::: "memory");
        const int row = wid * 64 + lane;
        if (wid < 4) {
            const float t = (Pp[row * 4 + 0] + Pp[row * 4 + 1]) + (Pp[row * 4 + 2] + Pp[row * 4 + 3]);
            __hip_atomic_store(xbuf + ((size_t)(u.pm * BM + row) * 4 + u.pn), t, __ATOMIC_RELAXED, __HIP_MEMORY_SCOPE_AGENT);
            asm volatile("s_waitcnt vmcnt(0)" ::: "memory");
            if (lane == 0) __hip_atomic_fetch_add(cnt + 64 * u.pm, 1u, __ATOMIC_RELAXED, __HIP_MEMORY_SCOPE_AGENT);
        }
        if (wid == 0) {
            unsigned sp = 0;
            while ((unsigned)__builtin_amdgcn_readfirstlane(__hip_atomic_load(cnt + 64 * u.pm, __ATOMIC_RELAXED, __HIP_MEMORY_SCOPE_AGENT)) < want) { __builtin_amdgcn_s_sleep(2); if (++sp > (1u << 22)) break; }
            __builtin_amdgcn_fence(__ATOMIC_ACQUIRE, "agent");
        }
        asm volatile("s_waitcnt vmcnt(0) lgkmcnt(0)" ::: "memory"); __builtin_amdgcn_s_barrier(); asm volatile("" ::: "memory");
        if (wid < 4) {
            const float* sl = xbuf + (size_t)(u.pm * BM + row) * 4; float t = 0.f;
#pragma unroll
            for (int k = 0; k < 4; ++k) t += __hip_atomic_load(sl + k, __ATOMIC_RELAXED, __HIP_MEMORY_SCOPE_AGENT);
            S[row] = 1.0f / sqrtf(t * (1.0f / 1024.0f) + 1e-6f);
        }
        asm volatile("s_waitcnt lgkmcnt(0)" ::: "memory"); __builtin_amdgcn_s_barrier(); asm volatile("" ::: "memory");
    }
};
struct EpiRmsRes {
    static constexpr bool PERM = true, AFTER_DRAIN = true, BRANCH_A = false;
    const float* base; float* out; const float* gain; RmsStats st;
    __device__ __forceinline__ void fused(f32x4 (&acc)[2][2][4][2], const Unit& u, int wr, int wc, int fr_, int fq_, PG8_LAS unsigned char* lds, int wid, int lane_) const {
        (void)fr_; (void)fq_; (void)lane_;
        st.run(acc, u, wr, wc, lds, wid);
        const int lane = lane_now(), fr = lane & 15, fq = lane >> 4;
        const PG8_LAS float* S = (const PG8_LAS float*)(lds + 4096);
#pragma unroll
        for (int ai = 0; ai < 2; ++ai)
#pragma unroll
            for (int m = 0; m < 4; ++m) {
                const int r = ai * HALF + wr * 64 + m * 16 + fr; const float rs = S[r];
#pragma unroll
                for (int bj = 0; bj < 2; ++bj) {
                    const int col = u.pn * BM + bj * HALF + wc * 32 + 8 * fq;
                    const unsigned off = (unsigned)(u.pm * BM + r) * 1024u + (unsigned)col;
                    const f32x4 g0 = ldg4(gain + col), g1 = ldg4(gain + col + 4);
                    const f32x4 b0 = ldg4(base + off), b1 = ldg4(base + off + 4);
                    *(f32x4*)(out + off) = b0 + acc[ai][bj][m][0] * rs * g0; *(f32x4*)(out + off + 4) = b1 + acc[ai][bj][m][1] * rs * g1;
                }
                asm volatile("" ::: "memory");
            }
    }
};
struct EpiRmsResRms {
    static constexpr bool PERM = true, AFTER_DRAIN = true, BRANCH_A = false;
    const float* base; float* out; bf16_t* XN; const float* gain; const float* gain2; RmsStats st1, st2;
    __device__ __forceinline__ void fused(f32x4 (&acc)[2][2][4][2], const Unit& u, int wr, int wc, int fr_, int fq_, PG8_LAS unsigned char* lds, int wid, int lane_) const {
        (void)fr_; (void)fq_; (void)lane_;
        st1.run(acc, u, wr, wc, lds, wid);
        const PG8_LAS float* S = (const PG8_LAS float*)(lds + 4096);
        {
            const int lane = lane_now(), fr = lane & 15, fq = lane >> 4;
#pragma unroll
            for (int ai = 0; ai < 2; ++ai)
#pragma unroll
                for (int m = 0; m < 4; ++m) {
                    const int r = ai * HALF + wr * 64 + m * 16 + fr; const float rs = S[r];
#pragma unroll
                    for (int bj = 0; bj < 2; ++bj) {
                        const int col = u.pn * BM + bj * HALF + wc * 32 + 8 * fq;
                        const unsigned off = (unsigned)(u.pm * BM + r) * 1024u + (unsigned)col;
                        const f32x4 g0 = ldg4(gain + col), g1 = ldg4(gain + col + 4);
                        const f32x4 b0 = ldg4(base + off), b1 = ldg4(base + off + 4);
                        acc[ai][bj][m][0] = b0 + acc[ai][bj][m][0] * rs * g0; acc[ai][bj][m][1] = b1 + acc[ai][bj][m][1] * rs * g1;
                        *(f32x4*)(out + off) = acc[ai][bj][m][0]; *(f32x4*)(out + off + 4) = acc[ai][bj][m][1];
                    }
                    asm volatile("" : "+v"(acc[ai][0][m][0]), "+v"(acc[ai][0][m][1]), "+v"(acc[ai][1][m][0]), "+v"(acc[ai][1][m][1]));
                    asm volatile("" ::: "memory");
                }
        }
        st2.run(acc, u, wr, wc, lds, wid);
        {
            const int lane = lane_now(), fr = lane & 15, fq = lane >> 4;
#pragma unroll
            for (int ai = 0; ai < 2; ++ai)
#pragma unroll
                for (int m = 0; m < 4; ++m) {
                    const int r = ai * HALF + wr * 64 + m * 16 + fr; const float rs = S[r];
#pragma unroll
                    for (int bj = 0; bj < 2; ++bj) {
                        const int col = u.pn * BM + bj * HALF + wc * 32 + 8 * fq;
                        const unsigned off = (unsigned)(u.pm * BM + r) * 1024u + (unsigned)col;
                        const f32x4 g0 = ldg4(gain2 + col), g1 = ldg4(gain2 + col + 4);
                        *(u32x4*)(XN + off) = pack8(acc[ai][bj][m][0] * rs * g0, acc[ai][bj][m][1] * rs * g1);
                    }
                    asm volatile("" ::: "memory");
                }
        }
    }
};
template <class Epi, class Sched, bool ALIGN_EPI = false, bool SP2 = false>
__device__ __forceinline__ void gemm_phase(PG8_LAS unsigned char* lds, const Gemm g, const Sched& S, const Epi& E, const int wave0) {
    const int tid = wave0 * 64 + lane_now(), wid = wave0, lane = tid & 63, wr = wid >> 2, wc = wid & 3, fr = lane & 15, fq = lane >> 4;
    const int K = g.K, nt = K / BK, lda = g.lda, ldb = g.ldb;
    unsigned voffA[2], voffB[2];
#pragma unroll
    for (int i = 0; i < 2; ++i) { int R, C; stage_rc(tid * 16 + i * 8192, R, C); const int Rb = Epi::PERM ? ((R & ~31) + perm32(R & 31)) : R;
        voffA[i] = (unsigned)(R * lda + C) * 2u; voffB[i] = (unsigned)(Rb * ldb + C) * 2u; }
    const size_t kstep = (size_t)(BK * 2);
    const size_t hstepA = (size_t)HALF * lda * 2, hstepB = (size_t)HALF * ldb * 2;
    const size_t tstepA = 2 * hstepA, tstepB = 2 * hstepB;
    const unsigned ldsw = (unsigned)wid * 1024u;
    const int aoff = lds_byte(wr * 64 + fr, fq * 8), boff = lds_byte(wc * 32 + fr, fq * 8);
#define PG8_SA(b, h) (((b) * 2 + (h)) * HTB)
#define PG8_SB(b, h) ((4 + (b) * 2 + (h)) * HTB)
#define PG8_STAGE(bufoff, gbase, voff) do { _Pragma("unroll") for (int _i = 0; _i < 2; ++_i) \
        __builtin_amdgcn_global_load_lds((const unsigned*)((const char*)(gbase) + (voff)[_i]), (PG8_LAS unsigned*)(lds + (bufoff) + ldsw + _i * 8192), 16, 0, 0); } while (0)
#define PG8_LDA(dst, b, h) do { _Pragma("unroll") for (int m = 0; m < 4; ++m) _Pragma("unroll") for (int k = 0; k < 2; ++k) dst[m][k] = *(const PG8_LAS bf16x8*)(lds + PG8_SA(b, h) + aoff + m * 2048 + k * 1024); } while (0)
#define PG8_LDB(dst, b, h) do { _Pragma("unroll") for (int n = 0; n < 2; ++n) _Pragma("unroll") for (int k = 0; k < 2; ++k) dst[n][k] = *(const PG8_LAS bf16x8*)(lds + PG8_SB(b, h) + boff + n * 2048 + k * 1024); } while (0)
#define PG8_MMA(ai, bj, At, Bt) do { __builtin_amdgcn_s_setprio(1); _Pragma("unroll") for (int m = 0; m < 4; ++m) _Pragma("unroll") for (int n = 0; n < 2; ++n) _Pragma("unroll") for (int k = 0; k < 2; ++k) \
        acc[ai][bj][m][n] = __builtin_amdgcn_mfma_f32_16x16x32_bf16(Bt[n][k], At[m][k], acc[ai][bj][m][n], 0, 0, 0); __builtin_amdgcn_s_setprio(0); } while (0)
#define PG8_WAIT_V(n) asm volatile("s_waitcnt vmcnt(" #n ")" ::: "memory")
#define PG8_WAIT_L(n) asm volatile("s_waitcnt lgkmcnt(" #n ")" ::: "memory")
#define PG8_BAR __builtin_amdgcn_s_barrier()
#define PG8_SCHED __builtin_amdgcn_sched_barrier(0)
    Unit cur, nxt; int ui = 0;
    if (!S.next(0, cur)) return;
    f32x4 acc[2][2][4][2];
#pragma unroll
    for (int a = 0; a < 2; ++a)
#pragma unroll
        for (int b = 0; b < 2; ++b)
#pragma unroll
            for (int m = 0; m < 4; ++m)
#pragma unroll
                for (int n = 0; n < 2; ++n) acc[a][b][m][n] = (f32x4){0.f, 0.f, 0.f, 0.f};
    bf16x8 At[4][2], B0[2][2], B1[2][2];
    const char* cA = (const char*)g.A + (size_t)cur.pm * tstepA + (Epi::BRANCH_A ? (size_t)branch_tile(cur.pn >> 2) * 512 : (size_t)0); const char* cB = (const char*)g.Bt + (size_t)cur.pn * tstepB;
    S.a_ready(cur);
    if constexpr (SP2) {
        PG8_STAGE(PG8_SB(0, 0), cB, voffB); PG8_STAGE(PG8_SB(0, 1), cB + hstepB, voffB); PG8_STAGE(PG8_SA(0, 0), cA, voffA); PG8_STAGE(PG8_SA(0, 1), cA + hstepA, voffA);
        if (wr == 1) PG8_BAR;
        PG8_WAIT_V(2); PG8_BAR;
        PG8_STAGE(PG8_SB(1, 0), cB + kstep, voffB); PG8_STAGE(PG8_SA(1, 0), cA + kstep, voffA); PG8_STAGE(PG8_SB(1, 1), cB + hstepB + kstep, voffB);
        PG8_WAIT_V(6); PG8_BAR;
    } else {
        PG8_STAGE(PG8_SB(0, 0), cB, voffB); PG8_STAGE(PG8_SA(0, 0), cA, voffA); PG8_STAGE(PG8_SB(0, 1), cB + hstepB, voffB); PG8_STAGE(PG8_SA(0, 1), cA + hstepA, voffA);
        if (wr == 1) PG8_BAR;
        PG8_WAIT_V(4); PG8_BAR;
        PG8_STAGE(PG8_SB(1, 0), cB + kstep, voffB); PG8_STAGE(PG8_SA(1, 0), cA + kstep, voffA); PG8_STAGE(PG8_SB(1, 1), cB + hstepB + kstep, voffB);
        PG8_WAIT_V(6); PG8_BAR;
    }
    for (;;) {
        const bool has_next = S.next(ui + 1, nxt);
        const char* nA = has_next ? (const char*)g.A + (size_t)nxt.pm * tstepA + (Epi::BRANCH_A ? (size_t)branch_tile(nxt.pn >> 2) * 512 : (size_t)0) : cA; const char* nB = has_next ? (const char*)g.Bt + (size_t)nxt.pn * tstepB : cB;
        for (int t = 0; t < nt; t += 2) {
            const bool last = (t == nt - 2);
            const char* a1 = cA + (size_t)(t + 1) * kstep;
            const char* a2 = last ? nA : cA + (size_t)(t + 2) * kstep; const char* b2 = last ? nB : cB + (size_t)(t + 2) * kstep;
            const char* a3 = a2 + kstep; const char* b3 = b2 + kstep;
            if (last && has_next) S.a_ready(nxt);
            if constexpr (SP2) {
            PG8_LDB(B0, 0, 0); PG8_LDB(B1, 0, 1); PG8_SCHED; PG8_LDA(At, 0, 0); PG8_STAGE(PG8_SA(1, 1), a1 + hstepA, voffA);
            PG8_WAIT_V(8); PG8_WAIT_L(0); PG8_BAR; PG8_MMA(0, 0, At, B0); PG8_MMA(0, 1, At, B1); PG8_BAR; PG8_SCHED;
            PG8_LDA(At, 0, 1); PG8_STAGE(PG8_SB(0, 0), b2, voffB); PG8_STAGE(PG8_SB(0, 1), b2 + hstepB, voffB); PG8_STAGE(PG8_SA(0, 0), a2, voffA);
            PG8_WAIT_V(8); PG8_WAIT_L(0); PG8_BAR; PG8_MMA(1, 0, At, B0); PG8_MMA(1, 1, At, B1); PG8_BAR; PG8_SCHED;
            PG8_LDB(B0, 1, 0); PG8_LDB(B1, 1, 1); PG8_SCHED; PG8_LDA(At, 1, 0); PG8_STAGE(PG8_SA(0, 1), a2 + hstepA, voffA);
            PG8_WAIT_V(8); PG8_WAIT_L(0); PG8_BAR; PG8_MMA(0, 0, At, B0); PG8_MMA(0, 1, At, B1); PG8_BAR; PG8_SCHED;
            PG8_LDA(At, 1, 1); PG8_STAGE(PG8_SB(1, 0), b3, voffB); PG8_STAGE(PG8_SB(1, 1), b3 + hstepB, voffB); PG8_STAGE(PG8_SA(1, 0), a3, voffA);
            PG8_WAIT_V(8); PG8_WAIT_L(0); PG8_BAR; PG8_MMA(1, 0, At, B0); PG8_MMA(1, 1, At, B1); PG8_BAR; PG8_SCHED;
            } else {
            PG8_LDB(B0, 0, 0); PG8_SCHED; PG8_LDA(At, 0, 0); PG8_STAGE(PG8_SA(1, 1), a1 + hstepA, voffA);
            PG8_WAIT_L(8); PG8_BAR; PG8_WAIT_L(0); PG8_MMA(0, 0, At, B0); PG8_BAR; PG8_SCHED;
            PG8_LDB(B1, 0, 1); PG8_STAGE(PG8_SB(0, 0), b2, voffB);
            PG8_BAR; PG8_WAIT_L(0); PG8_MMA(0, 1, At, B1); PG8_BAR;
            PG8_LDA(At, 0, 1); PG8_STAGE(PG8_SA(0, 0), a2, voffA);
            PG8_BAR; PG8_WAIT_L(0); PG8_MMA(1, 0, At, B0); PG8_BAR; PG8_SCHED;
            PG8_STAGE(PG8_SB(0, 1), b2 + hstepB, voffB);
            PG8_WAIT_V(6); PG8_BAR; PG8_MMA(1, 1, At, B1); PG8_BAR;
            PG8_LDB(B0, 1, 0); PG8_SCHED; PG8_LDA(At, 1, 0); PG8_STAGE(PG8_SA(0, 1), a2 + hstepA, voffA);
            PG8_WAIT_L(8); PG8_BAR; PG8_WAIT_L(0); PG8_MMA(0, 0, At, B0); PG8_BAR; PG8_SCHED;
            PG8_LDB(B1, 1, 1); PG8_STAGE(PG8_SB(1, 0), b3, voffB);
            PG8_BAR; PG8_WAIT_L(0); PG8_MMA(0, 1, At, B1); PG8_BAR;
            PG8_LDA(At, 1, 1); PG8_STAGE(PG8_SA(1, 0), a3, voffA);
            PG8_BAR; PG8_WAIT_L(0); PG8_MMA(1, 0, At, B0); PG8_BAR; PG8_SCHED;
            PG8_STAGE(PG8_SB(1, 1), b3 + hstepB, voffB);
            PG8_WAIT_V(6); PG8_BAR; PG8_MMA(1, 1, At, B1); PG8_BAR;
            }
        }
        if constexpr (ALIGN_EPI) { if (wr == 0) PG8_BAR; }
        if constexpr (!Epi::AFTER_DRAIN) { E(acc, cur, wr, wc, fr, fq); S.done(cur); }
        if (!has_next) break;
#pragma unroll
        for (int a = 0; a < 2; ++a)
#pragma unroll
            for (int b = 0; b < 2; ++b)
#pragma unroll
                for (int m = 0; m < 4; ++m)
#pragma unroll
                    for (int n = 0; n < 2; ++n) acc[a][b][m][n] = (f32x4){0.f, 0.f, 0.f, 0.f};
        cur = nxt; cA = nA; cB = nB; ++ui;
        if constexpr (ALIGN_EPI) { if (wr == 1) PG8_BAR; }
    }
    PG8_WAIT_V(0);
    if constexpr (!ALIGN_EPI) { if (wr == 0) PG8_BAR; }
    PG8_BAR;
    if constexpr (Epi::AFTER_DRAIN) { E.fused(acc, cur, wr, wc, fr, fq, lds, wid, lane); S.done(cur); }
#undef PG8_SA
#undef PG8_SB
#undef PG8_STAGE
#undef PG8_LDA
#undef PG8_LDB
#undef PG8_MMA
#undef PG8_WAIT_V
#undef PG8_WAIT_L
#undef PG8_BAR
#undef PG8_SCHED
}
}

namespace cg = cooperative_groups;
using pg8::bf16_t; using pg8::bf16x8; using pg8::f32x4; using pg8::u32x4; using pg8::f32x16;
typedef unsigned u32x2 __attribute__((ext_vector_type(2)));
#define LAS __attribute__((address_space(3)))
constexpr int NTHR = 512, NWAVES = 8;
constexpr int DM = 1024, T_ALL = 98304, T_PROMPT = 32768, GROUP = 16384, NGROUP = 6;
constexpr int PW = 3072;
constexpr int DFF = 2816;
constexpr float EPS = 1e-6f;
constexpr float QSCALE = 0.125f * 1.4426950408889634f;
constexpr size_t MiB = 1u << 20;
constexpr size_t WS_WIN = 0 * MiB, WS_WG = 6 * MiB, WS_WB = 14 * MiB, WS_WO = 16 * MiB, WS_WFI = 18 * MiB, WS_WFO = 29 * MiB, WS_MISC = 35 * MiB;
constexpr size_t WS_XN = 40 * MiB, WS_P = 72 * MiB, WS_S = 648 * MiB;
constexpr size_t S_HRAW = 0, S_HW8 = 20 * MiB, S_HW2 = 84 * MiB, S_KV = 100 * MiB;
constexpr size_t S_GATE = 0, S_ACT = 0, S_MF = 128 * MiB, S_MB = 192 * MiB;
constexpr size_t WS_CTL = 36 * MiB, CTL_BYTES = 131072;
constexpr size_t WS_NEED = 648 * MiB + 312 * MiB;
constexpr int LDS_BYTES = 147456;
#ifndef ENABLE
#define ENABLE 0xffff
#endif
constexpr int EN = ENABLE;
#ifndef PROBE_T
#define PROBE_T 0
#endif
#if PROBE_T
#define TMARK(c) do { const unsigned long long tn_ = __builtin_amdgcn_s_memrealtime(); if (PROBE_T == (c)) tacc += tn_ - tprev; tprev = tn_; } while (0)
#else
#define TMARK(c) do {} while (0)
#endif
#ifndef PROBE_DUP
#define PROBE_DUP 0
#endif

#define GSYNC() xcd_barrier(xbar)
struct Args { const float* in[20]; float* out; unsigned char* ws; };

__device__ __forceinline__ float wave_sum(float v) {
#pragma unroll
    for (int o = 1; o < 64; o <<= 1) v += pg8::shx(v, o);
    return v;
}
__device__ __forceinline__ unsigned cvtpk(float lo, float hi) { return pg8::cvt_pk_bf16(lo, hi); }
__device__ __forceinline__ float bf2f(unsigned h) { return __uint_as_float(h << 16); }
__device__ __forceinline__ unsigned f2bf1(float f) { return cvtpk(f, 0.f) & 0xffffu; }
__device__ __forceinline__ int pi_slot(int s) { return (s & ~31) | (((s >> 2) & 1) << 4) | (((s >> 3) & 3) << 2) | (s & 3); }
__device__ __forceinline__ f32x16 mfma32(bf16x8 a, bf16x8 b, f32x16 c) { return __builtin_amdgcn_mfma_f32_32x32x16_bf16(a, b, c, 0, 0, 0); }
__device__ __forceinline__ int crow(int r, int hi) { return (r & 3) + 8 * (r >> 2) + 4 * hi; }
__device__ __forceinline__ bf16x8 mk8(u32x2 lo, u32x2 hi) { u32x4 w; w.x = lo.x; w.y = lo.y; w.z = hi.x; w.w = hi.y; return __builtin_bit_cast(bf16x8, w); }
__device__ __forceinline__ bf16x8 pack8r(const f32x16& p, int b) { u32x4 w; w.x = cvtpk(p[b], p[b + 1]); w.y = cvtpk(p[b + 2], p[b + 3]); w.z = cvtpk(p[b + 4], p[b + 5]); w.w = cvtpk(p[b + 6], p[b + 7]); return __builtin_bit_cast(bf16x8, w); }
__device__ __forceinline__ unsigned short u16at(const u32x4& w, int e) { return (unsigned short)((w[e >> 1] >> (16 * (e & 1))) & 0xffffu); }

template <int MAP, bool KPERM>
__device__ __forceinline__ void transpose_item(const float* W, int ld, int K, int nblk, bf16_t* WT, float* scr, int item, int lane) {
    const int kb = item / nblk, nb = item % nblk, k0 = 64 * kb, n0 = 32 * nb;
#pragma unroll
    for (int i = 0; i < 8; ++i) { const int kk = 8 * i + (lane >> 3); const f32x4 v = *(const f32x4*)(W + (size_t)(k0 + kk) * ld + n0 + 4 * (lane & 7));
        float* sp = scr + kk * 33 + 4 * (lane & 7); sp[0] = v[0]; sp[1] = v[1]; sp[2] = v[2]; sp[3] = v[3]; }
    asm volatile("s_waitcnt lgkmcnt(0)" ::: "memory");
    const int c = lane & 7;
#pragma unroll
    for (int j = 0; j < 4; ++j) {
        const int n = (lane >> 3) + 8 * j; const int ns = n0 + n; int dr;
        if (MAP == 0) dr = ns;
        else if (MAP == 1) { const int lc = ns & 255; dr = (ns & ~255) + 128 * ((lc >> 5) & 1) + 32 * ((lc >> 6) & 3) + 8 * ((lc >> 2) & 3) + 4 * ((lc >> 4) & 1) + (lc & 3); }
        else if (MAP == 3) { const int br = ns >> 10, ch = ns & 1023; dr = (ch >> 6) * 256 + 128 * (br >> 1) + 32 * ((ch >> 4) & 3) + 8 * ((ch >> 2) & 3) + 4 * (br & 1) + (ch & 3); }
        else { const int up = ns >= DFF ? 1 : 0; const int jj = ns - DFF * up; dr = (jj >> 7) * 256 + 128 * up + (jj & 127); }
        float s[8];
#pragma unroll
        for (int e = 0; e < 8; ++e) { const int kl = KPERM ? pi_slot(8 * c + e) : (8 * c + e); s[e] = scr[kl * 33 + n]; }
        u32x4 o; o.x = cvtpk(s[0], s[1]); o.y = cvtpk(s[2], s[3]); o.z = cvtpk(s[4], s[5]); o.w = cvtpk(s[6], s[7]);
        *(u32x4*)(WT + (size_t)dr * K + k0 + 8 * c) = o;
    }
    asm volatile("s_waitcnt lgkmcnt(0)" ::: "memory");
}

__device__ __forceinline__ void prep_weights(const Args& a, int layer, unsigned char* lds, const int wave0) {
    const int tid = (wave0 * 64 + pg8::lane_now()), lane = tid & 63, wave = wave0; const int gw = blockIdx.x * NWAVES + wave, NGW = gridDim.x * NWAVES;
    unsigned char* ws = a.ws;
    float* scr = (float*)(lds + wave * 16384);
    const float* w_in = a.in[3] + (size_t)layer * 1024 * 7168;
    const float* wbr = a.in[16] + (size_t)layer * 4 * 256 * 1024;
    const float* wo = a.in[17] + (size_t)layer * 1024 * 1024;
    const float* wfi = a.in[18] + (size_t)layer * 1024 * 5632;
    const float* wfo = a.in[19] + (size_t)layer * 2816 * 1024;
    constexpr int I_IN = 16 * 96, I_G = 16 * 128, I_B = 4 * 32, I_O = 16 * 32, I_FI = 16 * 176, I_FO = 44 * 32;
    constexpr int NIT = I_IN + I_G + 4 * I_B + I_O + I_FI + I_FO;
    for (int it = gw; it < NIT; it += NGW) {
        int r = it;
        if (r < I_IN) { transpose_item<1, false>(w_in, 7168, 1024, 96, (bf16_t*)(ws + WS_WIN), scr, r, lane); continue; } r -= I_IN;
        if (r < I_G) { transpose_item<3, false>(w_in + 3072, 7168, 1024, 128, (bf16_t*)(ws + WS_WG), scr, r, lane); continue; } r -= I_G;
        if (r < 4 * I_B) { const int n = r / I_B; transpose_item<0, true>(wbr + (size_t)n * 256 * 1024, 1024, 256, 32, (bf16_t*)(ws + WS_WB) + (size_t)n * 1024 * 256, scr, r % I_B, lane); continue; } r -= 4 * I_B;
        if (r < I_O) { transpose_item<0, false>(wo, 1024, 1024, 32, (bf16_t*)(ws + WS_WO), scr, r, lane); continue; } r -= I_O;
        if (r < I_FI) { transpose_item<2, false>(wfi, 5632, 1024, 176, (bf16_t*)(ws + WS_WFI), scr, r, lane); continue; } r -= I_FI;
        transpose_item<0, false>(wfo, 1024, 2816, 32, (bf16_t*)(ws + WS_WFO), scr, r, lane);
    }
}

__device__ __forceinline__ const float* xrow_ptr(const Args& a, int layer, int R) {
    if (layer == 0) return R < T_PROMPT ? a.in[0] + (size_t)R * DM : a.in[1] + (size_t)(R - T_PROMPT) * DM;
    return a.out + (size_t)R * DM;
}
__device__ __forceinline__ void norm_x_rows(const Args& a, int layer, int g, const float* gain, bf16_t* XN, const int wave0) {
    const int tid = (wave0 * 64 + pg8::lane_now()), lane = tid & 63, wave = wave0; const int gw = blockIdx.x * NWAVES + wave, NGW = gridDim.x * NWAVES;
    for (int row = gw; row < GROUP; row += 2 * NGW) {
        const int row2 = row + NGW;
        const float* xr = xrow_ptr(a, layer, g * GROUP + row); const float* xr2 = xrow_ptr(a, layer, g * GROUP + row2);
        f32x4 v[4], w[4]; float ss = 0.f, ss2 = 0.f;
#pragma unroll
        for (int j = 0; j < 4; ++j) { v[j] = *(const f32x4*)(xr + 4 * lane + 256 * j); w[j] = *(const f32x4*)(xr2 + 4 * lane + 256 * j); }
#pragma unroll
        for (int j = 0; j < 4; ++j) { ss += (v[j][0] * v[j][0] + v[j][1] * v[j][1]) + (v[j][2] * v[j][2] + v[j][3] * v[j][3]); ss2 += (w[j][0] * w[j][0] + w[j][1] * w[j][1]) + (w[j][2] * w[j][2] + w[j][3] * w[j][3]); }
        const float rn = 1.0f / sqrtf(wave_sum(ss) * (1.0f / DM) + EPS), rn2 = 1.0f / sqrtf(wave_sum(ss2) * (1.0f / DM) + EPS);
#pragma unroll
        for (int j = 0; j < 4; ++j) { const f32x4 gv = *(const f32x4*)(gain + 4 * lane + 256 * j); const f32x4 o = v[j] * rn * gv, o2 = w[j] * rn2 * gv;
            u32x2 p; p.x = cvtpk(o[0], o[1]); p.y = cvtpk(o[2], o[3]); *(u32x2*)(XN + (size_t)row * DM + 4 * lane + 256 * j) = p;
            u32x2 p2; p2.x = cvtpk(o2[0], o2[1]); p2.y = cvtpk(o2[2], o2[3]); *(u32x2*)(XN + (size_t)row2 * DM + 4 * lane + 256 * j) = p2; }
    }
}
__device__ __forceinline__ void norm_res_rows(const Args& a, const float* TMP, int g, bool base_is_x0, const float* gain, const float* gain2, bf16_t* HN, const int wave0) {
    const int tid = (wave0 * 64 + pg8::lane_now()), lane = tid & 63, wave = wave0; const int gw = blockIdx.x * NWAVES + wave, NGW = gridDim.x * NWAVES;
    for (int row = gw; row < GROUP; row += NGW) {
        const int R = g * GROUP + row;
        const float* br = base_is_x0 ? xrow_ptr(a, 0, R) : a.out + (size_t)R * DM;
        const float* tr = TMP + (size_t)row * DM;
        f32x4 v[4], b[4]; float ss = 0.f;
#pragma unroll
        for (int j = 0; j < 4; ++j) { v[j] = *(const f32x4*)(tr + 4 * lane + 256 * j); b[j] = *(const f32x4*)(br + 4 * lane + 256 * j); ss += (v[j][0] * v[j][0] + v[j][1] * v[j][1]) + (v[j][2] * v[j][2] + v[j][3] * v[j][3]); }
        const float rn = 1.0f / sqrtf(wave_sum(ss) * (1.0f / DM) + EPS);
        float s2 = 0.f;
#pragma unroll
        for (int j = 0; j < 4; ++j) { const f32x4 gv = *(const f32x4*)(gain + 4 * lane + 256 * j); v[j] = b[j] + v[j] * rn * gv;
            *(f32x4*)(a.out + (size_t)R * DM + 4 * lane + 256 * j) = v[j]; s2 += (v[j][0] * v[j][0] + v[j][1] * v[j][1]) + (v[j][2] * v[j][2] + v[j][3] * v[j][3]); }
        if (HN) {
            const float r2 = 1.0f / sqrtf(wave_sum(s2) * (1.0f / DM) + EPS);
#pragma unroll
            for (int j = 0; j < 4; ++j) { const f32x4 gv = *(const f32x4*)(gain2 + 4 * lane + 256 * j); const f32x4 o = v[j] * r2 * gv;
                u32x2 w; w.x = cvtpk(o[0], o[1]); w.y = cvtpk(o[2], o[3]); *(u32x2*)(HN + (size_t)row * DM + 4 * lane + 256 * j) = w; }
        }
    }
}

__device__ __forceinline__ void rope_table(float* rcos, float* rsin, const int wave0) {
    for (int i = (wave0 * 64 + pg8::lane_now()); i < 128 * 16; i += NTHR) {
        const int pos = i >> 4, f = i & 15;
        const float inv = powf(10000.0f, -(float)f / 16.0f);
        const float ang = (float)pos * inv;
        rcos[i] = cosf(ang); rsin[i] = sinf(ang);
    }
}

__device__ __forceinline__ void hy_filter_item(const Args& a, int layer, int item, unsigned char* lds, const int wave0) {
    const int tid = (wave0 * 64 + pg8::lane_now());
    const bool big = item < 512; const int L = big ? 8192 : 2048; const int t0 = (big ? item : item - 512) * 16;
    float* hraw = (float*)(a.ws + WS_S + S_HRAW) + (big ? 0 : (size_t)2 * 256 * 8192);
    const float* w1 = a.in[7] + layer * 33 * 64; const float* b1 = a.in[8] + layer * 64; const float* w2 = a.in[9] + layer * 64 * 64; const float* b2 = a.in[10] + layer * 64;
    const float* w3 = a.in[11] + (size_t)layer * 64 * 512; const float* fr = a.in[12] + layer * 128;
    float* zf = (float*)lds; float* h1 = zf + 16 * 33; float* h2 = h1 + 16 * 65;
    for (int idx = tid; idx < 16 * 33; idx += NTHR) {
        const int p = idx / 33, f = idx - p * 33; const int t = t0 + p; float v;
        if (f == 0) v = (float)t / (float)(L - 1);
        else { const int k = (f - 1) & 15; const float fk = 1e-4f + (float)k * ((15.0f - 1e-4f) / 15.0f); float x = ((float)t * fk) / (float)L; x = x - floorf(x); v = f <= 16 ? __builtin_amdgcn_cosf(x) : -__builtin_amdgcn_sinf(x); }
        zf[idx] = v;
    }
    __syncthreads();
    for (int idx = tid; idx < 1024; idx += NTHR) { const int p = idx >> 6, u = idx & 63; float s = b1[u];
#pragma unroll 11
        for (int f = 0; f < 33; ++f) s += zf[p * 33 + f] * w1[f * 64 + u];
        h1[p * 65 + u] = sinf(fr[u] * s); }
    __syncthreads();
    for (int idx = tid; idx < 1024; idx += NTHR) { const int p = idx >> 6, u = idx & 63; float s = b2[u];
#pragma unroll 16
        for (int k = 0; k < 64; ++k) s += h1[p * 65 + k] * w2[k * 64 + u];
        h2[p * 65 + u] = sinf(fr[64 + u] * s); }
    __syncthreads();
    {
        const int p = tid & 15, c0 = (tid >> 4) * 16; const int t = t0 + p; const float tl = (float)t / (float)(L - 1);
        f32x4 ac[4] = {f32x4{}, f32x4{}, f32x4{}, f32x4{}};
#pragma unroll 4
        for (int k = 0; k < 64; ++k) { const float h = h2[p * 65 + k]; const float* wp = w3 + k * 512 + c0;
#pragma unroll
            for (int j = 0; j < 4; ++j) ac[j] += h * *(const f32x4*)(wp + 4 * j); }
        const float dlo = -4.605170185988091f / 1.5f, dhi = -4.605170185988091f / 0.3f;
#pragma unroll
        for (int j = 0; j < 4; ++j)
#pragma unroll
            for (int i = 0; i < 4; ++i) { const int col = c0 + 4 * j + i; const int dir = col >> 8, c = col & 255; const float delta = fabsf(dlo + (float)c * ((dhi - dlo) / 255.0f));
                hraw[((size_t)dir * 256 + c) * L + t] = ac[j][i] * expf(-tl * delta); }
    }
    __syncthreads();
}
__device__ __forceinline__ void hy_window_item(const Args& a, int item, unsigned char* lds, const int wave0) {
    const int tid = (wave0 * 64 + pg8::lane_now()), lane = tid & 63, wave = wave0;
    const bool big = item < 256; const int L = big ? 8192 : 2048; const int c = big ? item : item - 256;
    const float* hraw = (const float*)(a.ws + WS_S + S_HRAW) + (big ? 0 : (size_t)2 * 256 * 8192);
    const float* hf = hraw + (size_t)c * L; const float* hb = hraw + ((size_t)256 + c) * L;
    bf16_t* W = (bf16_t*)(a.ws + WS_S + (big ? S_HW8 : S_HW2)) + (size_t)c * (2 * L * 8);
    float* red = (float*)lds;
    float ss = 0.f;
    for (int t = tid; t < L; t += NTHR) { const float x = hf[t]; ss += x * x; if (t > 0) { const float y = hb[t]; ss += y * y; } }
    ss = wave_sum(ss);
    if (lane == 0) red[wave] = ss;
    __syncthreads();
    float tot = 0.f;
#pragma unroll
    for (int w = 0; w < NWAVES; ++w) tot += red[w];
    const float nrm = 1.0f / sqrtf(tot + EPS);
    for (int idx = tid; idx < 2 * L; idx += NTHR) {
        const int o = idx - L; float s[8];
#pragma unroll
        for (int e = 0; e < 8; ++e) { const int l = o - e; float v = 0.f; if (l >= 0) { if (l < L) v = hf[l]; } else { if (-l < L) v = hb[-l]; } s[e] = v * nrm; }
        u32x4 w; w.x = cvtpk(s[0], s[1]); w.y = cvtpk(s[2], s[3]); w.z = cvtpk(s[4], s[5]); w.w = cvtpk(s[6], s[7]);
        *(u32x4*)(W + (size_t)idx * 8) = w;
    }
    __syncthreads();
}

__device__ __forceinline__ int zidx(int t) { return (t & ~31) | ((((t >> 3) & 3) ^ ((t >> 7) & 3)) << 3) | (t & 7); }
template <int NQ, int QLO, int QHI>
__device__ __forceinline__ void hy_seg(f32x16 (&acc)[NQ], const int dlo, const int dhi, const int dmax, const bf16_t* Wc, const int abase, const bf16_t* zw, const bf16_t* zero, const int r32, const int hi,
                                       bf16x8& a0, bf16x8& a1, bf16x8& a2, bf16x8& a3) {
    constexpr int nb = NQ * 32;
    for (int d = dlo; d <= dhi; ++d) {
#pragma unroll
        for (int ks = 0; ks < 2; ++ks) {
            const bf16x8 cur = a0; a0 = a1; a1 = a2; a2 = a3;
            { int dn = d + 2; dn = dn <= dmax ? dn : dmax; a3 = *(const bf16x8*)(Wc + (size_t)(abase + 32 * dn - 16 * ks) * 8); }
            bf16x8 bf[NQ];
#pragma unroll
            for (int q = QLO; q <= QHI; ++q) { const int j = 32 * q + r32 - d;
                const bf16_t* bp = ((unsigned)j < (unsigned)nb) ? (zw + 32 * j + 8 * ((2 * ks + hi) ^ ((j >> 2) & 3))) : zero; bf[q] = *(const bf16x8*)bp; }
            __builtin_amdgcn_sched_barrier(0);
#pragma unroll
            for (int q = QLO; q <= QHI; ++q) acc[q] = mfma32(cur, bf[q], acc[q]);
            __builtin_amdgcn_sched_barrier(0);
        }
    }
}
template <int NQ, int S> struct HySegs {
    static __device__ __forceinline__ void run(f32x16 (&acc)[NQ], const bf16_t* Wc, const int abase, const bf16_t* zw, const bf16_t* zero, const int r32, const int hi, bf16x8& a0, bf16x8& a1, bf16x8& a2, bf16x8& a3) {
        constexpr int nb = NQ * 32;
        constexpr int QLO = S < NQ ? 0 : S - NQ + 1, QHI = S < NQ ? S : NQ - 1;
        constexpr int dlo = S < NQ ? 32 * S - nb + 1 : 32 * (S - NQ + 1);
        constexpr int dhi = S == NQ - 1 ? 31 : dlo + 31;
        hy_seg<NQ, QLO, QHI>(acc, dlo, dhi, nb - 1, Wc, abase, zw, zero, r32, hi, a0, a1, a2, a3);
        if constexpr (S + 1 < 2 * NQ - 1) HySegs<NQ, S + 1>::run(acc, Wc, abase, zw, zero, r32, hi, a0, a1, a2, a3);
    }
};
template <int NQ>
__device__ __forceinline__ void hyena_item(const Args& a, int layer, int row0, int g, unsigned char* lds, const bool do_store, const int wave0) {
    constexpr int L = NQ * 1024, nb = L / 32;
    const int tid = (wave0 * 64 + pg8::lane_now()), lane = tid & 63, wave = wave0, r32 = lane & 31, hi = lane >> 5;
    bf16_t* P = (bf16_t*)(a.ws + WS_P);
    bf16_t* zs = (bf16_t*)lds;
    bf16_t* zero = zs + 8 * L;
    float* ptab = (float*)(lds + 8 * L * 2 + 64);
    const float* hcw = a.in[5] + layer * 3 * 768; const float* hcb = a.in[6] + layer * 768; const float* hbias = a.in[13] + layer * 256;
    if (tid < 16) ((unsigned*)zero)[tid] = 0u;
    if (tid < 128) { const int e = tid >> 4, q = tid & 15; const int lc = pi_slot(8 * g + e); float v = 0.f;
        if (q < 9) v = hcw[(q % 3) * 768 + (q / 3) * 256 + lc]; else if (q < 12) v = hcb[(q - 9) * 256 + lc]; else if (q == 12) v = hbias[lc];
        ptab[e * 16 + q] = v; }
    __syncthreads();
    for (int tu = tid; tu < L / 8; tu += NTHR) {
        const int t0 = 8 * tu;
        u32x4 x1r[10], hvr[10];
#pragma unroll
        for (int k = 0; k < 10; ++k) { const int t = t0 - 1 + k; const bool ok = (t >= 0) && (t < L);
            const bf16_t* pr = P + (size_t)(row0 + (ok ? t : t0)) * PW + 3 * 256 + 8 * g;
            const u32x4 a_ = *(const u32x4*)pr, b_ = *(const u32x4*)(pr + 256); const u32x4 zz = (u32x4){0u, 0u, 0u, 0u};
            x1r[k] = ok ? a_ : zz; hvr[k] = ok ? b_ : zz; }
        const int zt = zidx(t0);
#pragma unroll
        for (int e = 0; e < 8; ++e) { const float* pt = ptab + e * 16; float z[8];
#pragma unroll
            for (int i = 0; i < 8; ++i) {
                const float u1 = pt[3] * bf2f(u16at(x1r[i], e)) + pt[4] * bf2f(u16at(x1r[i + 1], e)) + pt[5] * bf2f(u16at(x1r[i + 2], e)) + pt[10];
                const float uv = pt[6] * bf2f(u16at(hvr[i], e)) + pt[7] * bf2f(u16at(hvr[i + 1], e)) + pt[8] * bf2f(u16at(hvr[i + 2], e)) + pt[11];
                z[i] = uv * u1; }
            u32x4 w; w.x = cvtpk(z[0], z[1]); w.y = cvtpk(z[2], z[3]); w.z = cvtpk(z[4], z[5]); w.w = cvtpk(z[6], z[7]);
            *(u32x4*)(zs + e * L + zt) = w; }
    }
    __syncthreads();
    {
        const int lc = pi_slot(8 * g + wave);
        const bf16_t* Wc = (const bf16_t*)(a.ws + WS_S + (NQ == 8 ? S_HW8 : S_HW2)) + (size_t)lc * (2 * L * 8);
        const bf16_t* zw = zs + wave * L;
        f32x16 acc[NQ];
#pragma unroll
        for (int q = 0; q < NQ; ++q) acc[q] = f32x16{};
        constexpr int dmin = -(nb - 1);
        const int abase = L + r32 - 8 * hi;
        bf16x8 a0 = *(const bf16x8*)(Wc + (size_t)(abase + 32 * dmin) * 8), a1 = *(const bf16x8*)(Wc + (size_t)(abase + 32 * dmin - 16) * 8);
        bf16x8 a2 = *(const bf16x8*)(Wc + (size_t)(abase + 32 * (dmin + 1)) * 8), a3 = *(const bf16x8*)(Wc + (size_t)(abase + 32 * (dmin + 1) - 16) * 8);
        HySegs<NQ, 0>::run(acc, Wc, abase, zw, zero, r32, hi, a0, a1, a2, a3);
        const float hb_ = ptab[wave * 16 + 12];
        bf16_t* zwm = zs + wave * L;
#pragma unroll
        for (int q = 0; q < NQ; ++q)
#pragma unroll
            for (int rg = 0; rg < 4; ++rg) {
                const int jb = 32 * q + r32; const int t0 = 32 * jb + 8 * (rg ^ ((jb >> 2) & 3)) + 4 * hi;
                const u32x2 zz = *(const u32x2*)(zwm + t0);
                const float y0 = acc[q][4 * rg + 0] + hb_ * bf2f(zz.x & 0xffffu), y1 = acc[q][4 * rg + 1] + hb_ * bf2f(zz.x >> 16);
                const float y2 = acc[q][4 * rg + 2] + hb_ * bf2f(zz.y & 0xffffu), y3 = acc[q][4 * rg + 3] + hb_ * bf2f(zz.y >> 16);
                u32x2 w; w.x = cvtpk(y0, y1); w.y = cvtpk(y2, y3); *(u32x2*)(zwm + t0) = w;
            }
    }
    __syncthreads();
    for (int tu = tid; tu < L / 8; tu += NTHR) {
        const int t0 = 8 * tu;
        u32x4 xr[10], yr[8];
#pragma unroll
        for (int k = 0; k < 10; ++k) { const int t = t0 - 1 + k; const bool ok = (t >= 0) && (t < L);
            const u32x4 a_ = *(const u32x4*)(P + (size_t)(row0 + (ok ? t : t0)) * PW + 2 * 256 + 8 * g); const u32x4 zz = (u32x4){0u, 0u, 0u, 0u};
            xr[k] = ok ? a_ : zz; }
        const int zt = zidx(t0);
#pragma unroll
        for (int e = 0; e < 8; ++e) yr[e] = *(const u32x4*)(zs + e * L + zt);
#pragma unroll
        for (int i = 0; i < 8; ++i) { float o[8];
#pragma unroll
            for (int e = 0; e < 8; ++e) { const float* pt = ptab + e * 16;
                const float u0 = pt[0] * bf2f(u16at(xr[i], e)) + pt[1] * bf2f(u16at(xr[i + 1], e)) + pt[2] * bf2f(u16at(xr[i + 2], e)) + pt[9];
                o[e] = u0 * bf2f(u16at(yr[e], i)); }
            u32x4 w; w.x = cvtpk(o[0], o[1]); w.y = cvtpk(o[2], o[3]); w.z = cvtpk(o[4], o[5]); w.w = cvtpk(o[6], o[7]);
            if (do_store) *(u32x4*)(P + (size_t)(row0 + t0 + i) * PW + 3 * 256 + 8 * g) = w; }
    }
    __syncthreads();
}

typedef short v4i16_t __attribute__((ext_vector_type(4)));
__device__ __forceinline__ u32x2 vtr64(const bf16_t* p) {
    return __builtin_bit_cast(u32x2, __builtin_amdgcn_ds_read_tr16_b64_v4i16((__attribute__((address_space(3))) v4i16_t*)(uintptr_t)p));
}

__device__ __forceinline__ void attn_unit(bf16_t* P, int row0, int L, int kvh, int qb, unsigned char* lds, const bool do_store, const int wave0) {
    const int tid = (wave0 * 64 + pg8::lane_now()), lane = tid & 63, wave = wave0, r32 = lane & 31, hi = lane >> 5;
    const int head = 2 * kvh + (wave >> 2);
    bf16_t* qp0 = P + (size_t)(row0 + qb * 256 + (wave & 3) * 64 + r32) * PW + head * 64;
    bf16x8 qf[2][4];
#pragma unroll
    for (int t = 0; t < 2; ++t)
#pragma unroll
        for (int ks = 0; ks < 4; ++ks) qf[t][ks] = *(const bf16x8*)(qp0 + (size_t)t * 32 * PW + 16 * ks + 8 * hi);
    bf16_t* Ks = (bf16_t*)lds; bf16_t* Vt = Ks + 2 * 64 * 72;
    const int skey = tid >> 3, sch = tid & 7;
    const bf16_t* kg = P + (size_t)(row0 + skey) * PW + 256 + kvh * 64 + sch * 8;
    u32x4 kreg = *(const u32x4*)kg, vreg = *(const u32x4*)(kg + 128);
#define ATT_PUT(buf) do { *(u32x4*)(Ks + (buf) * 64 * 72 + skey * 72 + sch * 8) = kreg; *(u32x4*)(Vt + (buf) * 64 * 72 + skey * 72 + sch * 8) = vreg; } while (0)
    ATT_PUT(0);
    __syncthreads();
    const int nt = L / 64;
    const int vtb = (4 * hi + ((lane & 15) >> 2)) * 72 + 16 * ((lane >> 4) & 1) + 4 * (lane & 3);
    float mhat[2] = {0.f, 0.f}, l_run[2] = {0.f, 0.f}; f32x16 o[2][2], negm[2];
#pragma unroll
    for (int t = 0; t < 2; ++t) { o[t][0] = f32x16{}; o[t][1] = f32x16{}; negm[t] = f32x16{}; }
    for (int kt = 0; kt < nt; ++kt) {
        const int buf = kt & 1;
        if (kt + 1 < nt) { const bf16_t* kn = kg + (size_t)(kt + 1) * 64 * PW; kreg = *(const u32x4*)kn; vreg = *(const u32x4*)(kn + 128); }
        const bf16_t* kb = Ks + buf * 64 * 72; const bf16_t* vb = Vt + buf * 64 * 72;
#pragma unroll
        for (int h = 0; h < 2; ++h) {
            bf16x8 ka[4], va[4];
#pragma unroll
            for (int ks = 0; ks < 4; ++ks) ka[ks] = *(const bf16x8*)(kb + (32 * h + r32) * 72 + 16 * ks + 8 * hi);
#pragma unroll
            for (int jj = 0; jj < 2; ++jj) { const int j = 2 * h + jj;
                va[2 * jj] = mk8(vtr64(vb + vtb + (16 * j) * 72), vtr64(vb + vtb + (16 * j + 8) * 72));
                va[2 * jj + 1] = mk8(vtr64(vb + vtb + (16 * j) * 72 + 32), vtr64(vb + vtb + (16 * j + 8) * 72 + 32)); }
            __builtin_amdgcn_sched_barrier(0);
#pragma unroll
            for (int t = 0; t < 2; ++t) {
                f32x16 sc = mfma32(ka[0], qf[t][0], negm[t]);
#pragma unroll
                for (int ks = 1; ks < 4; ++ks) sc = mfma32(ka[ks], qf[t][ks], sc);
                float mx = sc[0];
#pragma unroll
                for (int r = 1; r < 16; ++r) mx = fmaxf(mx, sc[r]);
                mx = fmaxf(mx, pg8::shx(mx, 32));
                if ((kt == 0 && h == 0) || __any(mx > 8.0f)) {
                    const float dl = (kt == 0 && h == 0) ? mx : fmaxf(mx, 0.f);
                    mhat[t] += dl; const float alpha = __builtin_amdgcn_exp2f(-dl);
#pragma unroll
                    for (int r = 0; r < 16; ++r) { sc[r] -= dl; o[t][0][r] *= alpha; o[t][1][r] *= alpha; negm[t][r] = -mhat[t]; }
                    l_run[t] *= alpha;
                }
                float ps = 0.f;
#pragma unroll
                for (int r = 0; r < 16; ++r) { sc[r] = __builtin_amdgcn_exp2f(sc[r]); ps += sc[r]; }
                l_run[t] += ps;
                const bf16x8 pb0 = pack8r(sc, 0), pb1 = pack8r(sc, 8);
                o[t][0] = mfma32(va[0], pb0, o[t][0]); o[t][1] = mfma32(va[1], pb0, o[t][1]);
                o[t][0] = mfma32(va[2], pb1, o[t][0]); o[t][1] = mfma32(va[3], pb1, o[t][1]);
            }
        }
        if (kt + 1 < nt) ATT_PUT(buf ^ 1);
        __syncthreads();
    }
#undef ATT_PUT
#pragma unroll
    for (int t = 0; t < 2; ++t) {
        const float inv = 1.0f / (l_run[t] + pg8::shx(l_run[t], 32));
        bf16_t* qp = qp0 + (size_t)t * 32 * PW;
#pragma unroll
        for (int rg = 0; rg < 4; ++rg) {
            u32x2 w0, w1;
            w0.x = cvtpk(o[t][0][4 * rg] * inv, o[t][0][4 * rg + 1] * inv); w0.y = cvtpk(o[t][0][4 * rg + 2] * inv, o[t][0][4 * rg + 3] * inv);
            w1.x = cvtpk(o[t][1][4 * rg] * inv, o[t][1][4 * rg + 1] * inv); w1.y = cvtpk(o[t][1][4 * rg + 2] * inv, o[t][1][4 * rg + 3] * inv);
            if (do_store) { *(u32x2*)(qp + 8 * rg + 4 * hi) = w0; *(u32x2*)(qp + 32 + 8 * rg + 4 * hi) = w1; }
        }
    }
}

__device__ __forceinline__ float ret_lg2(const Args& a, int layer, int dir, int head) {
    const float rde = a.in[14][layer * 8 + dir * 4 + head];
    return log1pf(-exp2f(-rde)) * 1.4426950408889634f;
}
__device__ __forceinline__ void ret_kv_item(const Args& a, int layer, int cgi, int hp, unsigned char* lds, const int wave0) {
    const int tid = (wave0 * 64 + pg8::lane_now()), lane = tid & 63, wave = wave0, r32 = lane & 31, hi = lane >> 5;
    const bf16_t* P = (const bf16_t*)(a.ws + WS_P);
    bf16_t* KV = (bf16_t*)(a.ws + WS_S + S_KV);
    constexpr int PT = 136;
    bf16_t* Ktf = (bf16_t*)lds; bf16_t* Ktb = Ktf + 2 * 64 * PT; bf16_t* Vt = Ktb + 2 * 64 * PT;
    const float lgk[2][2] = {{ret_lg2(a, layer, 0, 2 * hp), ret_lg2(a, layer, 1, 2 * hp)}, {ret_lg2(a, layer, 0, 2 * hp + 1), ret_lg2(a, layer, 1, 2 * hp + 1)}};
#pragma unroll
    for (int i = 0; i < 4; ++i) {
        const int pc = tid + NTHR * i; const int h = pc >> 10, j = (pc >> 3) & 127, ch = pc & 7; const int head = 2 * hp + h;
        const bf16_t* src = P + (size_t)(cgi * 128 + j) * PW + 6 * 256 + head * 64 + ch * 8;
        const u32x4 kr = *(const u32x4*)src, vr = *(const u32x4*)(src + 256);
        const float wf = __builtin_amdgcn_exp2f((float)(127 - j) * lgk[i >> 1][0]), wb = __builtin_amdgcn_exp2f((float)j * lgk[i >> 1][1]);
#pragma unroll
        for (int e = 0; e < 8; ++e) { const float kv = bf2f(u16at(kr, e)); const int o = (h * 64 + ch * 8 + e) * PT + j;
            Ktf[o] = (bf16_t)f2bf1(kv * wf); Ktb[o] = (bf16_t)f2bf1(kv * wb); Vt[o] = u16at(vr, e); }
    }
    __syncthreads();
    {
        const int h = wave >> 2, sub = wave & 3, dir = sub >> 1, e0 = sub & 1; const int head = 2 * hp + h;
        const bf16_t* kt = (dir ? Ktb : Ktf) + h * 64 * PT; const bf16_t* vt = Vt + h * 64 * PT;
        f32x16 c0 = f32x16{}, c1 = f32x16{};
#pragma unroll
        for (int ks = 0; ks < 8; ++ks) {
            const bf16x8 av = *(const bf16x8*)(vt + (32 * e0 + r32) * PT + 16 * ks + 8 * hi);
            const bf16x8 b0 = *(const bf16x8*)(kt + r32 * PT + 16 * ks + 8 * hi), b1 = *(const bf16x8*)(kt + (32 + r32) * PT + 16 * ks + 8 * hi);
            c0 = mfma32(av, b0, c0); c1 = mfma32(av, b1, c1);
        }
        bf16_t* dst = KV + ((size_t)(cgi * 4 + head) * 2 + dir) * 4096;
#pragma unroll
        for (int r = 0; r < 16; ++r) { const int e = 32 * e0 + crow(r, hi); dst[e * 64 + r32] = (bf16_t)f2bf1(c0[r]); dst[e * 64 + 32 + r32] = (bf16_t)f2bf1(c1[r]); }
    }
    __syncthreads();
}
__device__ __forceinline__ void ret_scan(const Args& a, int layer, const int wave0) {
    const int gtid = blockIdx.x * NTHR + (wave0 * 64 + pg8::lane_now()), gthreads = gridDim.x * NTHR;
    bf16_t* KV = (bf16_t*)(a.ws + WS_S + S_KV);
    for (int idx = gtid; idx < 24 * 4 * 2 * 4096; idx += gthreads) {
        const int el = idx & 4095, dir = (idx >> 12) & 1, head = (idx >> 13) & 3, s = idx >> 15;
        const int chunk0 = s < 16 ? 16 * s : 256 + 64 * (s - 16), nc = s < 16 ? 16 : 64;
        const float gch = exp2f(128.0f * ret_lg2(a, layer, dir, head));
        float S = 0.f;
        bf16_t* base = KV + ((size_t)(chunk0 * 4 + head) * 2 + dir) * 4096 + el;
        for (int b = 0; b < nc; b += 16) {
            float tmp[16];
#pragma unroll
            for (int k = 0; k < 16; ++k) { const int n = b + k; const int cn = dir == 0 ? n : nc - 1 - n; tmp[k] = bf2f(base[(size_t)cn * 32768]); }
#pragma unroll
            for (int k = 0; k < 16; ++k) { const int n = b + k; const int cn = dir == 0 ? n : nc - 1 - n; base[(size_t)cn * 32768] = (bf16_t)f2bf1(S); S = gch * S + tmp[k]; }
        }
    }
}
__device__ __forceinline__ void ret_out_item(const Args& a, int layer, int cgi, int hp, unsigned char* lds, const int wave0) {
    const int tid = (wave0 * 64 + pg8::lane_now()), lane = tid & 63, wave = wave0, r32 = lane & 31, hi = lane >> 5;
    bf16_t* P = (bf16_t*)(a.ws + WS_P);
    const bf16_t* KV = (const bf16_t*)(a.ws + WS_S + S_KV);
    constexpr int PK = 72, PT = 136;
    bf16_t* Kr = (bf16_t*)lds;
    bf16_t* Vt = Kr + 2 * 128 * PK;
    bf16_t* St = Vt + 2 * 64 * PT;
#pragma unroll
    for (int i = 0; i < 4; ++i) {
        const int pc = tid + NTHR * i; const int h = pc >> 10, j = (pc >> 3) & 127, ch = pc & 7; const int head = 2 * hp + h;
        const bf16_t* src = P + (size_t)(cgi * 128 + j) * PW + 6 * 256 + head * 64 + ch * 8;
        const u32x4 kr = *(const u32x4*)src, vr = *(const u32x4*)(src + 256);
        *(u32x4*)(Kr + (h * 128 + j) * PK + ch * 8) = kr;
#pragma unroll
        for (int e = 0; e < 8; ++e) Vt[(h * 64 + ch * 8 + e) * PT + j] = u16at(vr, e);
        const int hd = pc >> 9, e_ = (pc >> 3) & 63;
        const int h2 = hd >> 1, dir = hd & 1;
        const u32x4 sr = *(const u32x4*)(KV + ((size_t)(cgi * 4 + 2 * hp + h2) * 2 + dir) * 4096 + e_ * 64 + ch * 8);
        *(u32x4*)(St + (hd * 64 + e_) * PK + ch * 8) = sr;
    }
    const int h = wave >> 2, isub = wave & 3; const int head = 2 * hp + h;
    const int irow = cgi * 128 + isub * 32 + r32;
    bf16_t* qp = P + (size_t)irow * PW + 5 * 256 + head * 64;
    bf16x8 qf[4];
#pragma unroll
    for (int ks = 0; ks < 4; ++ks) qf[ks] = *(const bf16x8*)(qp + 16 * ks + 8 * hi);
    __syncthreads();
    const float lgf = ret_lg2(a, layer, 0, head), lgb = ret_lg2(a, layer, 1, head);
    const int ipos = isub * 32 + r32;
    f32x16 o0 = f32x16{}, o1 = f32x16{};
    const bf16_t* kb = Kr + h * 128 * PK; const bf16_t* vb = Vt + h * 64 * PT;
#pragma nounroll
    for (int jt = 0; jt < 4; ++jt) {
        f32x16 s = f32x16{};
#pragma unroll
        for (int ks = 0; ks < 4; ++ks) s = mfma32(*(const bf16x8*)(kb + (32 * jt + r32) * PK + 16 * ks + 8 * hi), qf[ks], s);
#pragma unroll
        for (int r = 0; r < 16; ++r) { const int j = 32 * jt + crow(r, hi); const int dist = ipos - j;
            const float w = dist >= 0 ? __builtin_amdgcn_exp2f((float)dist * lgf) : __builtin_amdgcn_exp2f((float)(-dist) * lgb); s[r] *= w; }
        const bf16x8 pb0 = pack8r(s, 0), pb1 = pack8r(s, 8);
#pragma unroll
        for (int jj = 0; jj < 2; ++jj) {
            const int j16 = 32 * jt + 16 * jj; const bf16x8 pb = jj ? pb1 : pb0;
            const bf16x8 A0 = mk8(*(const u32x2*)(vb + r32 * PT + j16 + 4 * hi), *(const u32x2*)(vb + r32 * PT + j16 + 8 + 4 * hi));
            const bf16x8 A1 = mk8(*(const u32x2*)(vb + (32 + r32) * PT + j16 + 4 * hi), *(const u32x2*)(vb + (32 + r32) * PT + j16 + 8 + 4 * hi));
            o0 = mfma32(A0, pb, o0); o1 = mfma32(A1, pb, o1);
        }
    }
#pragma nounroll
    for (int dir = 0; dir < 2; ++dir) {
        const bf16_t* sb = St + ((h * 2 + dir) * 64) * PK;
        f32x16 x0 = f32x16{}, x1 = f32x16{};
#pragma unroll
        for (int ks = 0; ks < 4; ++ks) {
            x0 = mfma32(*(const bf16x8*)(sb + r32 * PK + 16 * ks + 8 * hi), qf[ks], x0);
            x1 = mfma32(*(const bf16x8*)(sb + (32 + r32) * PK + 16 * ks + 8 * hi), qf[ks], x1);
        }
        const float wq = dir == 0 ? exp2f((float)(ipos + 1) * lgf) : exp2f((float)(128 - ipos) * lgb);
#pragma unroll
        for (int r = 0; r < 16; ++r) { o0[r] += wq * x0[r]; o1[r] += wq * x1[r]; }
    }
    float ss = 0.f;
#pragma unroll
    for (int r = 0; r < 16; ++r) ss += o0[r] * o0[r] + o1[r] * o1[r];
    ss += pg8::shx(ss, 32);
    const float rn = 1.0f / sqrtf(ss * (1.0f / 64.0f) + EPS);
    const bf16_t* gp = P + (size_t)irow * PW + 8 * 256 + head * 64;
#pragma unroll
    for (int rg = 0; rg < 4; ++rg) {
        const u32x2 g0 = *(const u32x2*)(gp + 8 * rg + 4 * hi), g1 = *(const u32x2*)(gp + 32 + 8 * rg + 4 * hi);
        u32x2 w0, w1;
        w0.x = cvtpk(o0[4 * rg] * rn * bf2f(g0.x & 0xffffu), o0[4 * rg + 1] * rn * bf2f(g0.x >> 16)); w0.y = cvtpk(o0[4 * rg + 2] * rn * bf2f(g0.y & 0xffffu), o0[4 * rg + 3] * rn * bf2f(g0.y >> 16));
        w1.x = cvtpk(o1[4 * rg] * rn * bf2f(g1.x & 0xffffu), o1[4 * rg + 1] * rn * bf2f(g1.x >> 16)); w1.y = cvtpk(o1[4 * rg + 2] * rn * bf2f(g1.y & 0xffffu), o1[4 * rg + 3] * rn * bf2f(g1.y >> 16));
        *(u32x2*)(qp + 8 * rg + 4 * hi) = w0; *(u32x2*)(qp + 32 + 8 * rg + 4 * hi) = w1;
    }
    __syncthreads();
}

__device__ __forceinline__ void sc_rows(const Args& a, int layer, const int wave0) {
    const int gtid = blockIdx.x * NTHR + (wave0 * 64 + pg8::lane_now()), gthreads = gridDim.x * NTHR;
    bf16_t* P = (bf16_t*)(a.ws + WS_P);
    const float* scw = a.in[15] + layer * 3 * 256;
    for (int idx = gtid; idx < T_ALL * 32; idx += gthreads) {
        const int R = idx >> 5, cg8 = idx & 31;
        const int L = R < T_PROMPT ? 2048 : 8192, t = R & (L - 1);
        bf16_t* pr = P + (size_t)R * PW + 9 * 256 + 8 * cg8;
        const u32x4 zz = (u32x4){0u, 0u, 0u, 0u};
        const u32x4 sb = *(const u32x4*)pr;
        const u32x4 cc = *(const u32x4*)(pr + 256), hc = *(const u32x4*)(pr + 512);
        const u32x4 cm = t > 0 ? *(const u32x4*)(pr + 256 - PW) : zz, hm = t > 0 ? *(const u32x4*)(pr + 512 - PW) : zz;
        const u32x4 cp = t < L - 1 ? *(const u32x4*)(pr + 256 + PW) : zz, hp = t < L - 1 ? *(const u32x4*)(pr + 512 + PW) : zz;
        float o[8];
#pragma unroll
        for (int e = 0; e < 8; ++e) { const int lc = pi_slot(8 * cg8 + e);
            const float y = scw[lc] * (bf2f(u16at(cm, e)) * bf2f(u16at(hm, e))) + scw[256 + lc] * (bf2f(u16at(cc, e)) * bf2f(u16at(hc, e))) + scw[512 + lc] * (bf2f(u16at(cp, e)) * bf2f(u16at(hp, e)));
            o[e] = bf2f(u16at(sb, e)) * y; }
        u32x4 w; w.x = cvtpk(o[0], o[1]); w.y = cvtpk(o[2], o[3]); w.z = cvtpk(o[4], o[5]); w.w = cvtpk(o[6], o[7]);
        *(u32x4*)pr = w;
    }
}


#ifndef STOP_AFTER
#define STOP_AFTER 0
#endif
__device__ __forceinline__ void dbg_fold(const Args& a, const bf16_t* src, int ld, int ncol3, const int wave0) {
    const int gtid = blockIdx.x * NTHR + (wave0 * 64 + pg8::lane_now()), gthreads = gridDim.x * NTHR;
    for (int idx = gtid; idx < T_ALL * 1024; idx += gthreads) { const int r = idx >> 10, c = idx & 1023; float v = 0.f;
        for (int k = 0; k < ncol3; ++k) v += bf2f(src[(size_t)r * ld + c + 1024 * k]);
        a.out[idx] = v; }
}

#define GAS __attribute__((address_space(1)))
#define XB_TMO      128
#define XB_XCNT(j)  (256  + 64 * (j))
#define XB_XSUB(j)  (1280 + 64 * (j))
#define XB_XGEN(j)  (2304 + 64 * (j))
#define XB_TOP      3328
#define XB_TOPGEN   3392
#define XCD_BAR_WORDS 3456
#define XB_SPIN_CAP (1u << 18)

__device__ __forceinline__ unsigned xb_ld(unsigned* p)              { return __hip_atomic_load(p, __ATOMIC_RELAXED, __HIP_MEMORY_SCOPE_AGENT); }
__device__ __forceinline__ unsigned xb_add(unsigned* p, unsigned v) { return __hip_atomic_fetch_add(p, v, __ATOMIC_RELAXED, __HIP_MEMORY_SCOPE_AGENT); }
__device__ __forceinline__ unsigned xb_xcc_id() { return (unsigned)__builtin_amdgcn_s_getreg((3 << 11) | 20) & 0xFu; }
#define XB_SPIN(cond, bar) do { unsigned _sp = 0; while (cond) { __builtin_amdgcn_s_sleep(1); \
    if ((++_sp & 255u) == 0u) { if (xb_ld(&(bar)[XB_TMO])) break; if (_sp > XB_SPIN_CAP) { atomicAdd(&(bar)[XB_TMO], 1u); break; } } } } while (0)

struct XcdBarrier {
    unsigned* bar; unsigned x; int w0;
    volatile LAS unsigned* st;
};

__device__ __forceinline__ XcdBarrier xcd_barrier_post(unsigned* bar, volatile LAS unsigned* st, int w0) {
    XcdBarrier b; b.bar = bar; b.x = xb_xcc_id(); b.st = st; b.w0 = w0;
    if (w0 == 0 && pg8::lane_now() == 0) (void)xb_add(&bar[XB_XCNT(b.x)], 1u);
    return b;
}
__device__ __forceinline__ void xcd_barrier_complete(unsigned* bar, unsigned x, unsigned& nloc, unsigned& nx) {
    const unsigned G = gridDim.x * gridDim.y * gridDim.z;
    unsigned sum, cnt, mine, sp = 0u;
    for (;;) {
        sum = 0u; cnt = 0u; mine = 0u;
#pragma unroll
        for (unsigned j = 0; j < 16; ++j) { const unsigned c = xb_ld(&bar[XB_XCNT(j)]); sum += c; cnt += (c > 0u) ? 1u : 0u; mine = (j == x) ? c : mine; }
        if (sum == G) break;
        __builtin_amdgcn_s_sleep(1);
        if ((++sp & 255u) == 0u) { if (xb_ld(&bar[XB_TMO])) break; if (sp > XB_SPIN_CAP) { atomicAdd(&bar[XB_TMO], 1u); break; } }
    }
    nloc = mine > 0u ? mine : 1u; nx = cnt > 0u ? cnt : 1u;
}

__device__ __forceinline__ void xcd_barrier(const XcdBarrier& b) {
    asm volatile("s_waitcnt vmcnt(0)" ::: "memory");
    __syncthreads();
    if (b.w0 == 0 && pg8::lane_now() == 0) {
        unsigned* bar = b.bar;
        __builtin_amdgcn_s_waitcnt(0);
        unsigned nloc = b.st[0], nx = b.st[1];
        if (nloc == 0u) { xcd_barrier_complete(bar, b.x, nloc, nx); b.st[0] = nloc; b.st[1] = nx; }
        const unsigned old = xb_add(&bar[XB_XSUB(b.x)], 1u);
        const unsigned gen = old / nloc;
        if (old + 1u == (gen + 1u) * nloc) {
            __builtin_amdgcn_fence(__ATOMIC_RELEASE, "agent");
            asm volatile("s_waitcnt vmcnt(0)" ::: "memory");
            const unsigned og = xb_add(&bar[XB_TOP], 1u);
            const unsigned tg = og / nx;
            if (og + 1u == (tg + 1u) * nx) xb_add(&bar[XB_TOPGEN], 1u);
            else XB_SPIN(xb_ld(&bar[XB_TOPGEN]) == tg, bar);
            __builtin_amdgcn_fence(__ATOMIC_ACQUIRE, "agent");
            xb_add(&bar[XB_XGEN(b.x)], 1u);
            asm volatile("s_waitcnt vmcnt(0)" ::: "memory");
        } else {
            XB_SPIN(xb_ld(&bar[XB_XGEN(b.x)]) == gen, bar);
            __builtin_amdgcn_fence(__ATOMIC_ACQUIRE, "agent");
            asm volatile("s_waitcnt vmcnt(0)" ::: "memory");
        }
    }
    __syncthreads();
}

template <class Epi>
__device__ __forceinline__ void run_gemm(unsigned char* lds, const bf16_t* A, const bf16_t* Bt, int M, int N, int K, int lda, int ldb, const Epi& E, const int wave0) {
    pg8::Gemm g{A, Bt, M, N, K, lda, ldb}; pg8::StaticOrder S; S.init(M, N, (int)gridDim.x, (int)blockIdx.x);
    pg8::gemm_phase<Epi, pg8::StaticOrder, true, true>((PG8_LAS unsigned char*)lds, g, S, E, wave0);
}

__global__ void __launch_bounds__(NTHR, 2) fwd_megakernel(Args a) {
    extern __shared__ __attribute__((aligned(16))) unsigned char lds[];
    cg::grid_group grid = cg::this_grid();
    const int wave0 = __builtin_amdgcn_readfirstlane((int)threadIdx.x >> 6);
    const int G = gridDim.x, bx = blockIdx.x;
    volatile LAS unsigned* xst = (volatile LAS unsigned*)((LAS unsigned char*)lds + (LDS_BYTES - 64));
    if (wave0 == 0 && pg8::lane_now() == 0) { xst[0] = 0u; xst[1] = 0u; }
    __syncthreads();
    XcdBarrier xbar = xcd_barrier_post((unsigned*)(a.ws + WS_CTL), xst, wave0);
    grid.sync();
    unsigned char* ws = a.ws;
    bf16_t* P = (bf16_t*)(ws + WS_P); bf16_t* XN = (bf16_t*)(ws + WS_XN);
    float* rcos = (float*)(ws + WS_MISC); float* rsin = rcos + 2048;
    bf16_t* YB = (bf16_t*)(ws + WS_S + S_GATE); bf16_t* XN2 = (bf16_t*)(ws + WS_S + 160 * MiB); bf16_t* ACT = (bf16_t*)(ws + WS_S + 224 * MiB); float* XB = (float*)(ws + 37 * MiB); unsigned* CNT = (unsigned*)(ws + WS_CTL) + 8192;
    float* MF = (float*)(ws + WS_S + S_MF); bf16_t* MB = (bf16_t*)(ws + WS_S + S_MB);

#if PROBE_T
    unsigned long long tprev = __builtin_amdgcn_s_memrealtime(), tacc = 0;
#endif
    for (int layer = 0; layer < 2; ++layer) {
        const float* ng = a.in[2] + layer * 4 * DM;
        if (EN & 1) prep_weights(a, layer, lds, wave0);
        __syncthreads();
        if (layer == 0 && bx == G - 1) rope_table(rcos, rsin, wave0);
        if (EN & 2) for (int it = bx; it < 640; it += G) hy_filter_item(a, layer, it, lds, wave0);
        GSYNC(); TMARK(1);
        if (EN & 2) for (int it = bx; it < 512; it += G) hy_window_item(a, it, lds, wave0);
        norm_x_rows(a, layer, 0, ng, XN, wave0);
        GSYNC(); TMARK(2);
        for (int g = 0; g < NGROUP; ++g) {
            bf16_t* xa = (g & 1) ? XN2 : XN; bf16_t* xb = (g & 1) ? XN : XN2;
            pg8::EpiIn E{P, g * GROUP, a.in[4] + layer * 128, rcos, rsin, QSCALE};
            if (EN & 4) run_gemm(lds, xa, (const bf16_t*)(ws + WS_WIN), GROUP, PW, DM, DM, DM, E, wave0);
#if PROBE_DUP & 4
            run_gemm(lds, xa, (const bf16_t*)(ws + WS_WIN), GROUP, PW, DM, DM, DM, E, wave0);
#endif
            if (g + 1 < NGROUP) norm_x_rows(a, layer, g + 1, ng, xb, wave0);
            GSYNC(); TMARK(2);
        }
        if (STOP_AFTER == 1) { dbg_fold(a, P, PW, 3, wave0); return; }
        if (EN & 8) for (int it = bx; it < 768 * 2; it += G) ret_kv_item(a, layer, it >> 1, it & 1, lds, wave0);
        GSYNC(); TMARK(3);
        if (EN & 8) ret_scan(a, layer, wave0);
        GSYNC(); TMARK(3);
        if (EN & 16) for (int it = bx; it < 256; it += G) hyena_item<8>(a, layer, T_PROMPT + (it >> 5) * 8192, it & 31, lds, true, wave0);
        if (EN & 32) for (int it = bx; it < 512; it += G) hyena_item<2>(a, layer, (it >> 5) * 2048, it & 31, lds, true, wave0);
        if (EN & 64) for (int it = bx; it < 512; it += G) { const int pair = it & 15, qb = it >> 4; attn_unit(P, T_PROMPT + (pair >> 1) * 8192, 8192, pair & 1, qb, lds, true, wave0); }
        if (EN & 64) for (int it = bx; it < 256; it += G) { const int pair = it & 31, qb = it >> 5; attn_unit(P, (pair >> 1) * 2048, 2048, pair & 1, qb, lds, true, wave0); }
#if PROBE_DUP & 1
        { const bool never = (a.out == nullptr);
        for (int it = bx; it < 512; it += G) { const int pair = it & 15, qb = it >> 4; attn_unit(P, T_PROMPT + (pair >> 1) * 8192, 8192, pair & 1, qb, lds, never, wave0); }
        for (int it = bx; it < 256; it += G) { const int pair = it & 31, qb = it >> 5; attn_unit(P, (pair >> 1) * 2048, 2048, pair & 1, qb, lds, never, wave0); } }
#endif
#if PROBE_DUP & 2
        { const bool never = (a.out == nullptr);
        for (int it = bx; it < 256; it += G) hyena_item<8>(a, layer, T_PROMPT + (it >> 5) * 8192, it & 31, lds, never, wave0);
        for (int it = bx; it < 512; it += G) hyena_item<2>(a, layer, (it >> 5) * 2048, it & 31, lds, never, wave0); }
#endif
        if (EN & 128) for (int it = bx; it < 768 * 2; it += G) ret_out_item(a, layer, it >> 1, it & 1, lds, wave0);
        if (EN & 256) sc_rows(a, layer, wave0);
        GSYNC(); TMARK(3);
        if (STOP_AFTER == 2) { dbg_fold(a, P, PW, 3, wave0); return; }
        norm_x_rows(a, layer, 0, ng, XN, wave0);
        { pg8::EpiY E{YB}; run_gemm(lds, P, (const bf16_t*)(ws + WS_WB), GROUP, 4096, 256, PW, 256, E, wave0); }
        GSYNC(); TMARK(5);
        for (int g = 0; g < NGROUP; ++g) {
            const unsigned inst = (unsigned)(layer * NGROUP + g);
            float* outg = a.out + (size_t)g * GROUP * DM;
            const float* xg = layer == 0 ? (g < 2 ? a.in[0] + (size_t)g * GROUP * DM : a.in[1] + (size_t)(g - 2) * GROUP * DM) : outg;
            { pg8::EpiMerge E{YB, MB}; run_gemm(lds, XN, (const bf16_t*)(ws + WS_WG), GROUP, 4096, DM, DM, DM, E, wave0); }
            GSYNC(); TMARK(6);
            { pg8::RmsStats s1{XB, CNT, 16u * (inst + 1u)}, s2{XB + 65536, CNT + 4096, 16u * (inst + 1u)};
              pg8::EpiRmsResRms E{xg, outg, XN, ng + DM, ng + 2 * DM, s1, s2}; run_gemm(lds, MB, (const bf16_t*)(ws + WS_WO), GROUP, DM, DM, DM, DM, E, wave0); }
            GSYNC(); TMARK(7);
            { pg8::EpiSwiglu E{ACT}; run_gemm(lds, XN, (const bf16_t*)(ws + WS_WFI), GROUP, 2 * DFF, DM, DM, DM, E, wave0); }
#if PROBE_DUP & 8
            { pg8::EpiSwiglu E{ACT}; run_gemm(lds, XN, (const bf16_t*)(ws + WS_WFI), GROUP, 2 * DFF, DM, DM, DM, E, wave0); }
#endif
            GSYNC(); TMARK(6);
            { pg8::RmsStats s3{XB + 2 * 65536, CNT + 2 * 4096, 16u * (inst + 1u)};
              pg8::EpiRmsRes E{outg, outg, ng + 3 * DM, s3}; run_gemm(lds, ACT, (const bf16_t*)(ws + WS_WFO), GROUP, DM, DFF, DFF, DFF, E, wave0); }
            if (g + 1 < NGROUP) {
                norm_x_rows(a, layer, g + 1, ng, XN, wave0);
                pg8::EpiY E{YB}; run_gemm(lds, P + (size_t)(g + 1) * GROUP * PW, (const bf16_t*)(ws + WS_WB), GROUP, 4096, 256, PW, 256, E, wave0);
#if PROBE_DUP & 16
                run_gemm(lds, P + (size_t)(g + 1) * GROUP * PW, (const bf16_t*)(ws + WS_WB), GROUP, 4096, 256, PW, 256, E, wave0);
#endif
            }
            GSYNC(); TMARK(5);
        }
    }
#if PROBE_T
    if (bx == 0 && wave0 == 0 && pg8::lane_now() == 0) a.out[0] += (float)tacc * 0.0005f;
#endif
}

extern "C" void kernel_launch(void* const* d_in, const int* in_sizes, int n_in, void* d_out, int out_size, void* d_ws, size_t ws_size, hipStream_t stream) {
    static int grid = 0;
    if (grid == 0) {
        if (n_in != 20 || out_size != T_ALL * DM || ws_size < WS_NEED) { fprintf(stderr, "kernel_launch: unexpected shapes: n_in %d out %d ws %zu (need %zu)\n", n_in, out_size, ws_size, (size_t)WS_NEED); grid = -1; return; }
        int dev = 0, cus = 0, per_cu = 0;
        hipGetDevice(&dev); hipDeviceGetAttribute(&cus, hipDeviceAttributeMultiprocessorCount, dev);
        hipFuncSetAttribute((const void*)fwd_megakernel, hipFuncAttributeMaxDynamicSharedMemorySize, LDS_BYTES);
        hipOccupancyMaxActiveBlocksPerMultiprocessor(&per_cu, (const void*)fwd_megakernel, NTHR, LDS_BYTES);
        (void)hipGetLastError();
        if (per_cu < 1) per_cu = 1;
        grid = cus * 1;
        fprintf(stderr, "kernel_launch: cus %d per_cu %d grid %d\n", cus, per_cu, grid);
    }
    if (grid < 0) return;
    Args a{};
    for (int i = 0; i < 20; ++i) a.in[i] = (const float*)d_in[i];
    a.out = (float*)d_out; a.ws = (unsigned char*)d_ws;
    if (hipMemsetAsync((char*)d_ws + WS_CTL, 0, CTL_BYTES, stream) != hipSuccess) { fprintf(stderr, "memset failed\n"); return; }
    void* args[] = {&a};
    hipError_t e = hipLaunchCooperativeKernel((const void*)fwd_megakernel, dim3(grid), dim3(NTHR), args, LDS_BYTES, stream);
    if (e != hipSuccess) fprintf(stderr, "cooperative launch failed: %s (grid %d)\n", hipGetErrorString(e), grid);
}
```
